# Optimizing an MI355X kernel written in HIP

```python
import jax
import jax.numpy as jnp
from jax import lax
import numpy as np


D_MODEL = 1024
BATCH = 4
SEQ = 4096
DEPTH = 4

HEAD_DIM = 64
MIX_HEADS = 12
MIX_WIDTH = MIX_HEADS * HEAD_DIM
MEM_HEADS = 4
MEM_WIDTH = MEM_HEADS * HEAD_DIM
MEM_TOKENS = 256
DECAY_LORA = 64
ICLR_LORA = 64
VALUE_LORA = 32
GATE_LORA = 128
A_COLS_FIRST = 3 * MIX_WIDTH + DECAY_LORA + ICLR_LORA + GATE_LORA
A_COLS_REST = A_COLS_FIRST + VALUE_LORA
N_A_LAYERS = DEPTH // 2
N_B_LAYERS = DEPTH - N_A_LAYERS
N_DENSE = (DEPTH + 1) // 2
N_MOE = DEPTH // 2
D_FF = 2816
N_EXPERTS = 8
TOP_K = 2
Q_BLOCK = 128
LN_EPS = 1e-5
GN_EPS = 64e-5
DEEPNORM_ALPHA = (2 * DEPTH) ** 0.25
DEEPNORM_BETA = (8 * DEPTH) ** -0.25

kernel_name = 'hybrid_rwkv7_stickbreak_yoco_moe'


def _f32(t):
    return t.astype(jnp.float32)


def layer_norm(x, g, b):
    xf = _f32(x)
    mu = jnp.mean(xf, -1, keepdims=True)
    var = jnp.mean(jnp.square(xf - mu), -1, keepdims=True)
    y = (xf - mu) * lax.rsqrt(var + LN_EPS)
    return (y * _f32(g) + _f32(b)).astype(x.dtype)


def split_heads(t):
    return t.reshape(t.shape[0], t.shape[1], -1, HEAD_DIM)


def wkv7_scan(r, w, k, v, a, b):
    bsz, _, h, n = r.shape

    def step(S, inp):
        r_t, w_t, k_t, v_t, a_t, b_t = inp
        sa = jnp.einsum('bhij,bhj->bhi', S, a_t)
        S = S * w_t[:, :, None, :] + sa[..., None] * b_t[:, :, None, :] + v_t[..., None] * k_t[:, :, None, :]
        return S, jnp.einsum('bhij,bhj->bhi', S, r_t)

    xs = tuple(jnp.moveaxis(t, 1, 0) for t in (r, w, k, v, a, b))
    s0 = jnp.zeros((bsz, h, n, n), jnp.float32)
    _, ys = lax.scan(step, s0, xs)
    return jnp.moveaxis(ys, 0, 1)


def rwkv7_time_mix(proj, mu, vec, w_up, a_up, g_up, r_k, v_gate, v_first):
    has_vres = v_gate is not None
    bsz, seq, _ = proj.shape
    prev = jnp.pad(proj[:, :-1], ((0, 0), (1, 0), (0, 0)))
    xs = proj + mu * (prev - proj)
    sizes = [MIX_WIDTH] * 3 + [DECAY_LORA, ICLR_LORA] + ([VALUE_LORA] if has_vres else []) + [GATE_LORA]
    parts = jnp.split(xs, np.cumsum(sizes)[:-1].tolist(), axis=-1)
    r, k, v, wd, ad = parts[:5]
    gd = parts[-1]
    w0, a0, k_k, k_a, lnx_g, lnx_b = (vec[i] for i in range(6))
    log_w = -jax.nn.softplus(-(w0 + jnp.tanh(wd) @ w_up)) - 0.5
    decay = jnp.exp(-jnp.exp(_f32(log_w)))
    a = jax.nn.sigmoid(a0 + ad @ a_up)
    if has_vres:
        v0, v_up = v_gate
        v = v + (v_first - v) * jax.nn.sigmoid(v0 + parts[5] @ v_up)
    else:
        v_first = v
    g = jax.nn.sigmoid(gd) @ g_up
    kk = _f32(split_heads(k * k_k))
    kk = kk / jnp.maximum(jnp.linalg.norm(kk, axis=-1, keepdims=True), 1e-12)
    k = k * (1 + (a - 1) * k_a)
    rh, kh, vh = _f32(split_heads(r)), _f32(split_heads(k)), _f32(split_heads(v))
    ah = _f32(split_heads(a))
    y = wkv7_scan(rh, split_heads(decay), kh, vh, -kk, kk * ah)
    mu_y = jnp.mean(y, -1, keepdims=True)
    var_y = jnp.mean(jnp.square(y - mu_y), -1, keepdims=True)
    y = ((y - mu_y) * lax.rsqrt(var_y + GN_EPS)).reshape(bsz, seq, MIX_WIDTH)
    y = y * _f32(lnx_g) + _f32(lnx_b)
    bonus = jnp.sum(rh * kh * _f32(r_k), -1, keepdims=True) * vh
    y = y + bonus.reshape(bsz, seq, MIX_WIDTH)
    return y.astype(proj.dtype) * g, v_first


def stick_breaking_attention(q, k, v):
    bsz, seq, h, n = q.shape
    scale = n ** -0.5
    outs = []
    for blk in range(seq // Q_BLOCK):
        t0 = blk * Q_BLOCK
        kv_len = t0 + Q_BLOCK
        z = _f32(jnp.einsum('bqhd,bkhd->bhqk', q[:, t0:kv_len], k[:, :kv_len])) * scale
        q_pos = t0 + jnp.arange(Q_BLOCK)
        k_pos = jnp.arange(kv_len)
        causal = k_pos[None, :] < q_pos[:, None]
        log_1m = jnp.where(causal, jax.nn.log_sigmoid(-z), 0.0)
        log_rest = lax.cumsum(log_1m, axis=3, reverse=True) - log_1m
        wts = jnp.where(causal, jnp.exp(jax.nn.log_sigmoid(z) + log_rest), 0.0)
        outs.append(jnp.einsum('bhqk,bkhd->bqhd', wts.astype(v.dtype), v[:, :kv_len]))
    return jnp.concatenate(outs, axis=1).reshape(bsz, seq, h * n)


def memory_attention(q_mem, mem, w_mem_kv):
    mk, mv = jnp.split(mem @ w_mem_kv, 2, axis=-1)
    q, mk, mv = split_heads(q_mem), split_heads(mk), split_heads(mv)
    s = _f32(jnp.einsum('bthd,bmhd->bhtm', q, mk)) * (HEAD_DIM ** -0.5)
    p = jax.nn.softmax(s, axis=-1).astype(mv.dtype)
    o = jnp.einsum('bhtm,bmhd->bthd', p, mv)
    return o.reshape(q_mem.shape)


def swiglu(x, w_gate_up, w_down):
    gate, up = jnp.split(x @ w_gate_up, 2, axis=-1)
    return (jax.nn.silu(gate) * up) @ w_down


def moe_swiglu(x, w_router, w_gate_up, w_down):
    logits = _f32(x @ w_router)
    top_logits, top_idx = lax.top_k(logits, TOP_K)
    top_w = jax.nn.softmax(top_logits, axis=-1)
    combine = jnp.sum(jax.nn.one_hot(top_idx, N_EXPERTS, dtype=jnp.float32) * top_w[..., None], axis=-2).astype(x.dtype)
    y = jnp.zeros_like(x)
    for e in range(N_EXPERTS):
        y = y + combine[..., e:e + 1] * swiglu(x, w_gate_up[e], w_down[e])
    return y


def setup_inputs(seed: int = 0) -> dict:
    key = jax.random.key(seed)
    ks = iter(jax.random.split(key, 48))

    def nrm(shape, scale):
        return jax.random.normal(next(ks), shape, jnp.float32) * scale

    def unif(shape, lo, hi):
        return jax.random.uniform(next(ks), shape, jnp.float32, minval=lo, maxval=hi)

    d_in = D_MODEL ** -0.5
    x = nrm((BATCH, SEQ, D_MODEL), 1.0)
    mem = nrm((BATCH, MEM_TOKENS, D_MODEL), 1.0)
    a_w_in_first = nrm((D_MODEL, A_COLS_FIRST + MEM_WIDTH), d_in)
    a_w_in_rest = nrm((N_A_LAYERS - 1, D_MODEL, A_COLS_REST + MEM_WIDTH), d_in)
    a_mu_first = unif((A_COLS_FIRST,), 0.0, 1.0)
    a_mu_rest = unif((N_A_LAYERS - 1, A_COLS_REST), 0.0, 1.0)
    a_vec = jnp.stack([
        unif((N_A_LAYERS, MIX_WIDTH), -6.0, 1.0),
        nrm((N_A_LAYERS, MIX_WIDTH), 0.5),
        0.85 + nrm((N_A_LAYERS, MIX_WIDTH), 0.05),
        1.0 + nrm((N_A_LAYERS, MIX_WIDTH), 0.05),
        1.0 + nrm((N_A_LAYERS, MIX_WIDTH), 0.05),
        nrm((N_A_LAYERS, MIX_WIDTH), 0.01),
    ], axis=1)
    a_w_up = nrm((N_A_LAYERS, DECAY_LORA, MIX_WIDTH), 0.5 * DECAY_LORA ** -0.5)
    a_a_up = nrm((N_A_LAYERS, ICLR_LORA, MIX_WIDTH), ICLR_LORA ** -0.5)
    a_g_up = nrm((N_A_LAYERS, GATE_LORA, MIX_WIDTH), GATE_LORA ** -0.5)
    a_v0 = nrm((N_A_LAYERS - 1, MIX_WIDTH), 0.5)
    a_v_up = nrm((N_A_LAYERS - 1, VALUE_LORA, MIX_WIDTH), VALUE_LORA ** -0.5)
    a_r_k = nrm((N_A_LAYERS, MIX_HEADS, HEAD_DIM), 0.1)
    b_w_in = nrm((N_B_LAYERS, D_MODEL, MIX_WIDTH + MEM_WIDTH), d_in)
    w_kv_shared = nrm((D_MODEL, 2 * MIX_WIDTH), d_in)
    mem_kv = nrm((DEPTH, D_MODEL, 2 * MEM_WIDTH), d_in)
    w_o = nrm((DEPTH, MIX_WIDTH + MEM_WIDTH, D_MODEL), (MIX_WIDTH + MEM_WIDTH) ** -0.5 * DEEPNORM_BETA)
    ln = jnp.stack([
        1.0 + nrm((DEPTH, D_MODEL), 0.05), nrm((DEPTH, D_MODEL), 0.01),
        1.0 + nrm((DEPTH, D_MODEL), 0.05), nrm((DEPTH, D_MODEL), 0.01),
    ], axis=1)
    ffn_gate_up = nrm((N_DENSE, D_MODEL, 2 * D_FF), d_in)
    ffn_down = nrm((N_DENSE, D_FF, D_MODEL), D_FF ** -0.5 * DEEPNORM_BETA)
    router = nrm((N_MOE, D_MODEL, N_EXPERTS), d_in)
    exp_gate_up = nrm((N_MOE, N_EXPERTS, D_MODEL, 2 * D_FF), d_in)
    exp_down = nrm((N_MOE, N_EXPERTS, D_FF, D_MODEL), D_FF ** -0.5 * DEEPNORM_BETA)
    return {'x': x, 'mem': mem, 'a_w_in_first': a_w_in_first, 'a_w_in_rest': a_w_in_rest,
            'a_mu_first': a_mu_first, 'a_mu_rest': a_mu_rest, 'a_vec': a_vec, 'a_w_up': a_w_up,
            'a_a_up': a_a_up, 'a_g_up': a_g_up, 'a_v0': a_v0, 'a_v_up': a_v_up, 'a_r_k': a_r_k,
            'b_w_in': b_w_in, 'w_kv_shared': w_kv_shared, 'mem_kv': mem_kv, 'w_o': w_o, 'ln': ln,
            'ffn_gate_up': ffn_gate_up, 'ffn_down': ffn_down, 'router': router,
            'exp_gate_up': exp_gate_up, 'exp_down': exp_down}


def reference(x, mem, a_w_in_first, a_w_in_rest, a_mu_first, a_mu_rest, a_vec, a_w_up, a_a_up, a_g_up,
              a_v0, a_v_up, a_r_k, b_w_in, w_kv_shared, mem_kv, w_o, ln, ffn_gate_up, ffn_down,
              router, exp_gate_up, exp_down):
    v_first = None
    k_sh = None
    v_sh = None
    for l in range(DEPTH):
        if l < N_A_LAYERS:
            w_in = a_w_in_first if l == 0 else a_w_in_rest[l - 1]
            mu = a_mu_first if l == 0 else a_mu_rest[l - 1]
            v_gate = None if l == 0 else (a_v0[l - 1], a_v_up[l - 1])
            proj = x @ w_in
            n_cols = proj.shape[-1] - MEM_WIDTH
            q_mem = proj[..., n_cols:]
            tok, v_first = rwkv7_time_mix(proj[..., :n_cols], mu, a_vec[l], a_w_up[l], a_a_up[l],
                                          a_g_up[l], a_r_k[l], v_gate, v_first)
        else:
            proj = x @ b_w_in[l - N_A_LAYERS]
            q, q_mem = proj[..., :MIX_WIDTH], proj[..., MIX_WIDTH:]
            tok = stick_breaking_attention(split_heads(q), k_sh, v_sh)
        mo = memory_attention(q_mem, mem, mem_kv[l])
        mix = jnp.concatenate([tok, mo], axis=-1) @ w_o[l]
        x = layer_norm(DEEPNORM_ALPHA * x + mix, ln[l, 0], ln[l, 1])
        if l % 2 == 0:
            ff = swiglu(x, ffn_gate_up[l // 2], ffn_down[l // 2])
        else:
            ff = moe_swiglu(x, router[l // 2], exp_gate_up[l // 2], exp_down[l // 2])
        x = layer_norm(DEEPNORM_ALPHA * x + ff, ln[l, 2], ln[l, 3])
        if l == N_A_LAYERS - 1:
            kv = x @ w_kv_shared
            k_sh = split_heads(kv[..., :MIX_WIDTH])
            v_sh = split_heads(kv[..., MIX_WIDTH:])
    return x
```

```cpp
#include <hip/hip_runtime.h>
#include <cstdio>
#include <cstdint>
#include <cmath>
namespace pg8 {
#define PG8_LAS __attribute__((address_space(3)))
typedef unsigned short bf16_t;
typedef short bf16x8 __attribute__((ext_vector_type(8)));
typedef float f32x4 __attribute__((ext_vector_type(4)));
typedef float f32x2 __attribute__((ext_vector_type(2)));
typedef unsigned u32x4 __attribute__((ext_vector_type(4)));
typedef unsigned u32x2 __attribute__((ext_vector_type(2)));
constexpr int BM = 256, BK = 64, HALF = 128, HTB = HALF * BK * 2, STAGE_BYTES = 8 * HTB, NXCD = 8, WGM = 8;

__host__ __device__ __forceinline__ int lds_byte(int r, int c) { const int st = (r >> 4) * 2 + (c >> 5), rr = r & 15, cc = c & 31, ob = rr * 64 + cc * 2; return st * 1024 + (ob ^ (((ob >> 9) & 1) << 5)); }
__host__ __device__ __forceinline__ void stage_rc(int b, int& R, int& C) { const int st = b / 1024, sb = b % 1024, swz = sb ^ (((sb >> 9) & 1) << 5); R = (st >> 1) * 16 + swz / 64; C = (st & 1) * 32 + (swz % 64) / 2; }
__host__ __device__ __forceinline__ int perm32(int rho) { const int n = rho >> 4, i = rho & 15; return 8 * (i >> 2) + 4 * n + (i & 3); }

struct Unit { int pm, pn, bt; };
struct Gemm { const bf16_t* A; const bf16_t* Bt; int lda, ldb, K; };

__device__ __forceinline__ bool order_map(long L, int nM, int nN, int& pm, int& pn) {
    const int nwg = nM * nN; if (L >= nwg) return false;
    int wgid = (int)L; { const int q = nwg / NXCD, r = nwg % NXCD, xcd = wgid % NXCD, off = wgid / NXCD; wgid = (xcd < r ? xcd * (q + 1) : r * (q + 1) + (xcd - r) * q) + off; }
    const int nig = WGM * nN, gid = wgid / nig, fm = gid * WGM, gsz = (nM - fm) < WGM ? (nM - fm) : WGM;
    pm = fm + ((wgid % nig) % gsz); pn = (wgid % nig) / gsz; return true;
}
struct StaticOrder {
    int nM, nN, G, c;
    __device__ void init(int M, int N, int G_, int c_) { nM = M / BM; nN = N / BM; G = G_; c = c_; }
    __device__ __forceinline__ bool next(int i, Unit& u) const { if (!order_map((long)i * G + c, nM, nN, u.pm, u.pn)) return false; u.bt = u.pn; return true; }
};
struct MoeOrder {
    int nM, nN, G, c; const int* tile_e;
    __device__ __forceinline__ bool next(int i, Unit& u) const { if (!order_map((long)i * G + c, nM, nN, u.pm, u.pn)) return false;
        const int e = __builtin_amdgcn_readfirstlane(__hip_atomic_load(tile_e + u.pm, __ATOMIC_RELAXED, __HIP_MEMORY_SCOPE_AGENT)); u.bt = e * nN + u.pn; return true; }
};

__device__ __forceinline__ unsigned cvt_pk_bf16(float lo, float hi) { unsigned r; asm volatile("v_cvt_pk_bf16_f32 %0, %1, %2" : "=v"(r) : "v"(lo), "v"(hi)); return r; }

struct EpiStore {
    static constexpr bool PERM = true;
    bf16_t* O; int ldc; unsigned scale_mask; float scale;
    __device__ __forceinline__ void operator()(const f32x4 (&acc)[2][2][4][2], const Unit& u, int wr, int wc, int fr, int fq) const {
        const int row0 = u.pm * BM + wr * 64 + fr, col0 = u.pn * BM + wc * 32 + 8 * fq;
        const float sc = ((scale_mask >> u.pn) & 1u) ? scale : 1.f;
#pragma unroll
        for (int ai = 0; ai < 2; ++ai)
#pragma unroll
            for (int m = 0; m < 4; ++m) { bf16_t* rowp = O + (size_t)(row0 + ai * HALF + m * 16) * ldc + col0;
#pragma unroll
                for (int bj = 0; bj < 2; ++bj) { const f32x4 v0 = acc[ai][bj][m][0] * sc, v1 = acc[ai][bj][m][1] * sc;
                    u32x4 w; w.x = cvt_pk_bf16(v0[0], v0[1]); w.y = cvt_pk_bf16(v0[2], v0[3]); w.z = cvt_pk_bf16(v1[0], v1[1]); w.w = cvt_pk_bf16(v1[2], v1[3]);
                    *(u32x4*)(rowp + bj * HALF) = w; } }
    }
};
__device__ __forceinline__ float silu_mul(float g, float u) { return g * u * __builtin_amdgcn_rcpf(1.0f + __builtin_amdgcn_exp2f(-1.4426950408889634f * g)); }
struct EpiSwiglu {
    static constexpr bool PERM = true;
    bf16_t* H; int ldc;
    __device__ __forceinline__ void operator()(const f32x4 (&acc)[2][2][4][2], const Unit& u, int wr, int wc, int fr, int fq) const {
        const int row0 = u.pm * BM + wr * 64 + fr, col0 = u.pn * HALF + wc * 32 + 8 * fq;
#pragma unroll
        for (int ai = 0; ai < 2; ++ai)
#pragma unroll
            for (int m = 0; m < 4; ++m) { bf16_t* rowp = H + (size_t)(row0 + ai * HALF + m * 16) * ldc + col0;
                const f32x4 g0 = acc[ai][0][m][0], g1 = acc[ai][0][m][1], u0 = acc[ai][1][m][0], u1 = acc[ai][1][m][1];
                u32x4 w; w.x = cvt_pk_bf16(silu_mul(g0[0], u0[0]), silu_mul(g0[1], u0[1])); w.y = cvt_pk_bf16(silu_mul(g0[2], u0[2]), silu_mul(g0[3], u0[3]));
                w.z = cvt_pk_bf16(silu_mul(g1[0], u1[0]), silu_mul(g1[1], u1[1])); w.w = cvt_pk_bf16(silu_mul(g1[2], u1[2]), silu_mul(g1[3], u1[3]));
                *(u32x4*)rowp = w; }
    }
};
struct EpiResid {
    static constexpr bool PERM = false;
    const float* base; float* out; int ldc; float alpha;
    __device__ __forceinline__ void operator()(const f32x4 (&acc)[2][2][4][2], const Unit& u, int wr, int wc, int fr, int fq) const {
        const int row0 = u.pm * BM + wr * 64 + fr, col0 = u.pn * BM + wc * 32 + 4 * fq;
#pragma unroll
        for (int ai = 0; ai < 2; ++ai)
#pragma unroll
            for (int m = 0; m < 4; ++m) { const size_t off = (size_t)(row0 + ai * HALF + m * 16) * ldc + col0;
#pragma unroll
                for (int bj = 0; bj < 2; ++bj)
#pragma unroll
                    for (int n = 0; n < 2; ++n) { f32x4 o = acc[ai][bj][m][n];
                        if (base) { const f32x4 bs = *(const f32x4*)(base + off + bj * HALF + n * 16); o = o + bs * alpha; }
                        *(f32x4*)(out + off + bj * HALF + n * 16) = o; } }
    }
};
struct EpiLora {
    static constexpr bool PERM = false;
    float* out0; size_t blk_stride; const float* vec; const float* v0;
    __device__ __forceinline__ void operator()(const f32x4 (&acc)[2][2][4][2], const Unit& u, int wr, int wc, int fr, int fq) const {
        const int blk = u.pn / 3, cb0 = (u.pn - 3 * blk) * BM + wc * 32 + 4 * fq, row0 = u.pm * BM + wr * 64 + fr;
        if (blk == 2 && v0 == nullptr) return;
        float* outp = out0 + (size_t)blk * blk_stride;
        const float* bias = blk == 2 ? v0 : vec + (blk & 1) * 768;
#pragma unroll
        for (int bj = 0; bj < 2; ++bj)
#pragma unroll
            for (int n = 0; n < 2; ++n) { const int cb = cb0 + bj * HALF + n * 16;
                f32x4 bv = (f32x4){0.f, 0.f, 0.f, 0.f}; if (blk < 3) bv = *(const f32x4*)(bias + cb);
#pragma unroll
                for (int ai = 0; ai < 2; ++ai)
#pragma unroll
                    for (int m = 0; m < 4; ++m) { f32x4 v = acc[ai][bj][m][n] + bv, o;
#pragma unroll
                        for (int j = 0; j < 4; ++j) { const float d = v[j]; float r;
                            if (blk == 0) { const float sp = fmaxf(-d, 0.f) + __logf(1.0f + __expf(-fabsf(d)));
                                r = __expf(-__expf(-sp - 0.5f)); }
                            else if (blk == 3) r = d;
                            else r = 1.0f / (1.0f + __expf(-d));
                            o[j] = r; }
                        *(f32x4*)(outp + (size_t)(row0 + ai * HALF + m * 16) * 768 + cb) = o; } }
    }
};

template <class Epi, class Sched>
__device__ __forceinline__ void gemm_phase(PG8_LAS unsigned char* lds, const Gemm g, const Sched& S, const Epi& E) {
    int tid = threadIdx.x; asm volatile("" : "+v"(tid));
    const int wid = __builtin_amdgcn_readfirstlane(tid >> 6), lane = tid & 63, wr = wid >> 2, wc = wid & 3, fr = lane & 15, fq = lane >> 4;
    const int K = g.K, nt = K / BK;
    unsigned voffA[2], voffB[2];
#pragma unroll
    for (int i = 0; i < 2; ++i) { int R, C; stage_rc(tid * 16 + i * 8192, R, C); const int Rb = Epi::PERM ? ((R & ~31) + perm32(R & 31)) : R;
        voffA[i] = (unsigned)(R * g.lda + C) * 2u; voffB[i] = (unsigned)(Rb * g.ldb + C) * 2u; }
    const size_t kstep = (size_t)(BK * 2);
    const size_t hstepA = (size_t)HALF * g.lda * 2, hstepB = (size_t)HALF * g.ldb * 2;
    const size_t tstepA = 2 * hstepA, tstepB = 2 * hstepB;
    const unsigned ldsw = (unsigned)wid * 1024u;
    const int aoff = lds_byte(wr * 64 + fr, fq * 8), boff = lds_byte(wc * 32 + fr, fq * 8);
#define PG8_SA(b, h) (((b) * 2 + (h)) * HTB)
#define PG8_SB(b, h) ((4 + (b) * 2 + (h)) * HTB)
#define PG8_STAGE(bufoff, gbase, voff) do { _Pragma("unroll") for (int _i = 0; _i < 2; ++_i) \
        __builtin_amdgcn_global_load_lds((const unsigned*)((const char*)(gbase) + (voff)[_i]), (PG8_LAS unsigned*)(lds + (bufoff) + ldsw + _i * 8192), 16, 0, 0); } while (0)
#define PG8_LDA(dst, b, h) do { _Pragma("unroll") for (int m = 0; m < 4; ++m) _Pragma("unroll") for (int k = 0; k < 2; ++k) dst[m][k] = *(const PG8_LAS bf16x8*)(lds + PG8_SA(b, h) + aoff + m * 2048 + k * 1024); } while (0)
#define PG8_LDB(dst, b, h) do { _Pragma("unroll") for (int n = 0; n < 2; ++n) _Pragma("unroll") for (int k = 0; k < 2; ++k) dst[n][k] = *(const PG8_LAS bf16x8*)(lds + PG8_SB(b, h) + boff + n * 2048 + k * 1024); } while (0)
#define PG8_MMA(ai, bj, At, Bt) do { __builtin_amdgcn_s_setprio(1); _Pragma("unroll") for (int m = 0; m < 4; ++m) _Pragma("unroll") for (int n = 0; n < 2; ++n) _Pragma("unroll") for (int k = 0; k < 2; ++k) \
        acc[ai][bj][m][n] = __builtin_amdgcn_mfma_f32_16x16x32_bf16(Bt[n][k], At[m][k], acc[ai][bj][m][n], 0, 0, 0); __builtin_amdgcn_s_setprio(0); } while (0)
#define PG8_WAIT_V(n) asm volatile("s_waitcnt vmcnt(" #n ")" ::: "memory")
#define PG8_WAIT_L(n) asm volatile("s_waitcnt lgkmcnt(" #n ")" ::: "memory")
#define PG8_BAR __builtin_amdgcn_s_barrier()
#define PG8_SCHED __builtin_amdgcn_sched_barrier(0)
    Unit cur, nxt; int ui = 0;
    if (!S.next(0, cur)) return;
    f32x4 acc[2][2][4][2];
#pragma unroll
    for (int a = 0; a < 2; ++a)
#pragma unroll
        for (int b = 0; b < 2; ++b)
#pragma unroll
            for (int m = 0; m < 4; ++m)
#pragma unroll
                for (int n = 0; n < 2; ++n) acc[a][b][m][n] = (f32x4){0.f, 0.f, 0.f, 0.f};
    bf16x8 At[4][2], B0[2][2], B1[2][2];
    const char* cA = (const char*)g.A + (size_t)cur.pm * tstepA; const char* cB = (const char*)g.Bt + (size_t)cur.bt * tstepB;
    PG8_STAGE(PG8_SB(0, 0), cB, voffB); PG8_STAGE(PG8_SB(0, 1), cB + hstepB, voffB); PG8_STAGE(PG8_SA(0, 0), cA, voffA); PG8_STAGE(PG8_SA(0, 1), cA + hstepA, voffA);
    if (wr == 1) PG8_BAR;
    PG8_WAIT_V(2); PG8_BAR;
    PG8_STAGE(PG8_SB(1, 0), cB + kstep, voffB); PG8_STAGE(PG8_SA(1, 0), cA + kstep, voffA); PG8_STAGE(PG8_SB(1, 1), cB + hstepB + kstep, voffB);
    PG8_WAIT_V(6); PG8_BAR;
    for (;;) {
        const bool has_next = S.next(ui + 1, nxt);
        const char* nA = has_next ? (const char*)g.A + (size_t)nxt.pm * tstepA : cA; const char* nB = has_next ? (const char*)g.Bt + (size_t)nxt.bt * tstepB : cB;
        for (int t = 0; t < nt; t += 2) {
            const bool last = (t == nt - 2);
            const char* a1 = cA + (size_t)(t + 1) * kstep;
            const char* a2 = last ? nA : cA + (size_t)(t + 2) * kstep; const char* b2 = last ? nB : cB + (size_t)(t + 2) * kstep;
            const char* a3 = a2 + kstep; const char* b3 = b2 + kstep;
            PG8_LDB(B0, 0, 0); PG8_LDB(B1, 0, 1); PG8_SCHED; PG8_LDA(At, 0, 0); PG8_STAGE(PG8_SA(1, 1), a1 + hstepA, voffA);
            PG8_WAIT_V(8); PG8_WAIT_L(0); PG8_BAR; PG8_MMA(0, 0, At, B0); PG8_MMA(0, 1, At, B1); PG8_BAR; PG8_SCHED;
            PG8_LDA(At, 0, 1); PG8_STAGE(PG8_SB(0, 0), b2, voffB); PG8_STAGE(PG8_SB(0, 1), b2 + hstepB, voffB); PG8_STAGE(PG8_SA(0, 0), a2, voffA);
            PG8_WAIT_V(8); PG8_WAIT_L(0); PG8_BAR; PG8_MMA(1, 0, At, B0); PG8_MMA(1, 1, At, B1); PG8_BAR; PG8_SCHED;
            PG8_LDB(B0, 1, 0); PG8_LDB(B1, 1, 1); PG8_SCHED; PG8_LDA(At, 1, 0); PG8_STAGE(PG8_SA(0, 1), a2 + hstepA, voffA);
            PG8_WAIT_V(8); PG8_WAIT_L(0); PG8_BAR; PG8_MMA(0, 0, At, B0); PG8_MMA(0, 1, At, B1); PG8_BAR; PG8_SCHED;
            PG8_LDA(At, 1, 1); PG8_STAGE(PG8_SB(1, 0), b3, voffB); PG8_STAGE(PG8_SB(1, 1), b3 + hstepB, voffB); PG8_STAGE(PG8_SA(1, 0), a3, voffA);
            PG8_WAIT_V(8); PG8_WAIT_L(0); PG8_BAR; PG8_MMA(1, 0, At, B0); PG8_MMA(1, 1, At, B1); PG8_BAR; PG8_SCHED;
        }
        if (wr == 0) PG8_BAR;
        E(acc, cur, wr, wc, fr, fq);
        if (!has_next) break;
#pragma unroll
        for (int a = 0; a < 2; ++a)
#pragma unroll
            for (int b = 0; b < 2; ++b)
#pragma unroll
                for (int m = 0; m < 4; ++m)
#pragma unroll
                    for (int n = 0; n < 2; ++n) acc[a][b][m][n] = (f32x4){0.f, 0.f, 0.f, 0.f};
        cur = nxt; cA = nA; cB = nB; ++ui;
        if (wr == 1) PG8_BAR;
    }
    PG8_WAIT_V(0);
    PG8_BAR;
#undef PG8_SA
#undef PG8_SB
#undef PG8_STAGE
#undef PG8_LDA
#undef PG8_LDB
#undef PG8_MMA
#undef PG8_WAIT_V
#undef PG8_WAIT_L
#undef PG8_BAR
#undef PG8_SCHED
}
}
namespace att {
using bf16 = unsigned short;
using bf16x8 = __attribute__((ext_vector_type(8))) short;
using s16x4 = __attribute__((ext_vector_type(4))) short;
using f32x16 = __attribute__((ext_vector_type(16))) float;
using u32x4 = __attribute__((ext_vector_type(4))) unsigned;
typedef short v4i16_t __attribute__((ext_vector_type(4)));
typedef __attribute__((address_space(3))) const char* lds_cptr;
typedef __attribute__((address_space(3))) char* lds_ptr;
typedef float f32x2_t __attribute__((ext_vector_type(2))); typedef __bf16 bf16x2_t __attribute__((ext_vector_type(2)));
__device__ __forceinline__ int crow(int r, int hi) { return (r & 3) + 8 * (r >> 2) + 4 * hi; }
__device__ __forceinline__ unsigned cvtpk_s(float lo, float hi) { f32x2_t v = {lo, hi}; bf16x2_t b = __builtin_convertvector(v, bf16x2_t); return __builtin_bit_cast(unsigned, b); }
#define ATT_SBAR() __builtin_amdgcn_sched_barrier(0)
#define ATT_WAIT_BAR(N) asm volatile("s_waitcnt vmcnt(" #N ") lgkmcnt(0)\n\ts_barrier" ::: "memory")
constexpr int SLOTB = 8192;
__device__ __forceinline__ void glds16(const void* gsrc, unsigned lds_dst) { unsigned keep;
    asm volatile("s_mov_b32 %0, m0\n\ts_mov_b32 m0, %2\n\ts_nop 0\n\tglobal_load_lds_dwordx4 %1, off\n\ts_mov_b32 m0, %0" : "=&s"(keep) : "v"(gsrc), "s"(lds_dst) : "memory"); }
__device__ __forceinline__ void dma_k(const bf16* ktile, int pitch, unsigned slot_lds, int wid, int lane) {
    glds16(ktile + (long)lane * pitch + wid * 8, (unsigned)__builtin_amdgcn_readfirstlane(slot_lds + wid * 1024)); }
__device__ __forceinline__ void dma_v(const bf16* vtile, int pitch, unsigned slot_lds, int wid, int lane) {
    glds16(vtile + (long)(16 * (wid & 3) + (lane >> 2)) * pitch + (wid >> 2) * 32 + (lane & 3) * 8, (unsigned)__builtin_amdgcn_readfirstlane(slot_lds + wid * 1024)); }
__device__ __forceinline__ void qkt(f32x16& p0, f32x16& p1, lds_cptr Kslot, const bf16x8* qr, int r32, int hi) {
    lds_cptr kb = Kslot + hi * 1024 + r32 * 16;
    const f32x16 z = {};
#pragma unroll
    for (int d0 = 0; d0 < 4; ++d0) {
        const bf16x8 b0 = *(const __attribute__((address_space(3))) bf16x8*)(kb + d0 * 2048);
        const bf16x8 b1 = *(const __attribute__((address_space(3))) bf16x8*)(kb + d0 * 2048 + 512);
        if (d0 == 0) { p0 = __builtin_amdgcn_mfma_f32_32x32x16_bf16(b0, qr[0], z, 0, 0, 0); p1 = __builtin_amdgcn_mfma_f32_32x32x16_bf16(b1, qr[0], z, 0, 0, 0); }
        else { p0 = __builtin_amdgcn_mfma_f32_32x32x16_bf16(b0, qr[d0], p0, 0, 0, 0); p1 = __builtin_amdgcn_mfma_f32_32x32x16_bf16(b1, qr[d0], p1, 0, 0, 0); } }
}
__device__ __forceinline__ s16x4 vtr(lds_cptr p) { return __builtin_bit_cast(s16x4, __builtin_amdgcn_ds_read_tr16_b64_v4i16((__attribute__((address_space(3))) v4i16_t*)p)); }
__device__ __forceinline__ void pv(f32x16* o, lds_cptr vp, bf16x8 pa0, bf16x8 pa1, bf16x8 pa2, bf16x8 pa3) {
#pragma unroll
    for (int d0 = 0; d0 < 2; ++d0) { s16x4 lo[4], hi[4];
#pragma unroll
        for (int ks = 0; ks < 4; ++ks) { lo[ks] = vtr(vp + d0 * 4096 + ks * 1024); hi[ks] = vtr(vp + d0 * 4096 + ks * 1024 + 512); }
#define ATT_PK(k) (bf16x8){lo[k][0], lo[k][1], lo[k][2], lo[k][3], hi[k][0], hi[k][1], hi[k][2], hi[k][3]}
        o[d0] = __builtin_amdgcn_mfma_f32_32x32x16_bf16(pa0, ATT_PK(0), o[d0], 0, 0, 0);
        o[d0] = __builtin_amdgcn_mfma_f32_32x32x16_bf16(pa1, ATT_PK(1), o[d0], 0, 0, 0);
        o[d0] = __builtin_amdgcn_mfma_f32_32x32x16_bf16(pa2, ATT_PK(2), o[d0], 0, 0, 0);
        o[d0] = __builtin_amdgcn_mfma_f32_32x32x16_bf16(pa3, ATT_PK(3), o[d0], 0, 0, 0);
#undef ATT_PK
    }
}
__device__ __forceinline__ float swap_lo(float x, float& hi_out) { auto rr = __builtin_amdgcn_permlane32_swap(__float_as_uint(x), __float_as_uint(x), false, false); hi_out = __uint_as_float(rr[1]); return __uint_as_float(rr[0]); }
#define ATT_PKW(P, B) cvtpk_s(P[B], P[B + 1])
#define ATT_PACK4(P0, P1, w0, w1, w2, w3) do { w0 = (u32x4){ATT_PKW(P0, 0), ATT_PKW(P0, 2), ATT_PKW(P0, 4), ATT_PKW(P0, 6)}; w1 = (u32x4){ATT_PKW(P0, 8), ATT_PKW(P0, 10), ATT_PKW(P0, 12), ATT_PKW(P0, 14)}; \
    w2 = (u32x4){ATT_PKW(P1, 0), ATT_PKW(P1, 2), ATT_PKW(P1, 4), ATT_PKW(P1, 6)}; w3 = (u32x4){ATT_PKW(P1, 8), ATT_PKW(P1, 10), ATT_PKW(P1, 12), ATT_PKW(P1, 14)}; } while (0)
__device__ __forceinline__ void store_o(const f32x16* o, const float* rscale, lds_ptr stg, bf16* Ow, int pitch, int lane, int r32, int hi) {
    __attribute__((address_space(3))) bf16* s = (__attribute__((address_space(3))) bf16*)stg;
#pragma unroll
    for (int r = 0; r < 16; ++r) { const int orow = crow(r, hi);
#pragma unroll
        for (int d0 = 0; d0 < 2; ++d0) { const float v = o[d0][r] * rscale[r]; s[orow * 64 + d0 * 32 + r32] = (bf16)(cvtpk_s(v, v) & 0xffffu); } }
    asm volatile("s_waitcnt lgkmcnt(0)" ::: "memory");
#pragma unroll
    for (int i = 0; i < 4; ++i) { const int row = i * 8 + (lane >> 3), ch = lane & 7; const u32x4 v = *(const __attribute__((address_space(3))) u32x4*)(s + row * 64 + ch * 8); *(u32x4*)(Ow + (long)row * pitch + ch * 8) = v; }
}

constexpr int LDS_K = 0, LDS_V = 4 * SLOTB, LDS_WS = 8 * SLOTB, LDS_OST = LDS_WS + 8 * 256, ATT_LDS_BYTES = LDS_OST + 8 * 4096;

__device__ __forceinline__ void sb_unit(int qb, const bf16* Qh, int qp, const bf16* Kh, const bf16* Vh, int kp, bf16* Oh, int op, lds_ptr shm) {
    int tid = threadIdx.x; asm volatile("" : "+v"(tid)); const int lane = tid & 63, r32 = lane & 31, hi = lane >> 5; const int wid = __builtin_amdgcn_readfirstlane(tid >> 6);
    const unsigned lds0 = (unsigned)(size_t)shm;
    const int q0w = qb * 256 + wid * 32;
    const int NT = 4 * qb + 4;
    const lds_cptr kp0 = (lds_cptr)shm + LDS_K, vp0 = (lds_cptr)shm + LDS_V + ((lane >> 4) & 1) * 32 + (lane & 3) * 8 + (4 * hi + ((lane & 15) >> 2)) * 64;
    { const int t = NT - 1, s = t & 1; dma_k(Kh + (long)t * 64 * kp, kp, lds0 + LDS_K + s * SLOTB, wid, lane); dma_v(Vh + (long)t * 64 * kp, kp, lds0 + LDS_V + s * SLOTB, wid, lane); }
    bf16x8 qr[4];
#pragma unroll
    for (int d0 = 0; d0 < 4; ++d0) qr[d0] = *(const bf16x8*)(Qh + (long)(q0w + r32) * qp + d0 * 16 + hi * 8);
    f32x16 o[2]; o[0] = f32x16{}; o[1] = f32x16{};
    float carry = 1.0f;
    const int qabs = q0w + r32;
    for (int t = NT - 1; t >= 0; --t) {
        ATT_WAIT_BAR(0);
        if (t > 0) { const int s = (t - 1) & 1; dma_k(Kh + (long)(t - 1) * 64 * kp, kp, lds0 + LDS_K + s * SLOTB, wid, lane); dma_v(Vh + (long)(t - 1) * 64 * kp, kp, lds0 + LDS_V + s * SLOTB, wid, lane); }
        if (64 * t >= q0w + 31) continue;
        const int sl = (t & 1) * SLOTB;
        f32x16 p0, p1, x0, x1;
        qkt(p0, p1, kp0 + sl, qr, r32, hi);
        const bool need_mask = (64 * t + 63 >= q0w);
        const int kb = 64 * t + 4 * hi;
#pragma unroll
        for (int r = 0; r < 16; ++r) {
            const float z0 = fminf(p0[r], 100.f), z1 = fminf(p1[r], 100.f);
            const float e0 = __builtin_amdgcn_exp2f(z0), e1 = __builtin_amdgcn_exp2f(z1);
            float a0 = __builtin_amdgcn_rcpf(1.0f + e0), a1 = __builtin_amdgcn_rcpf(1.0f + e1);
            float b0 = e0 * a0, b1 = e1 * a1;
            if (need_mask) { const int kv = kb + (r & 3) + 8 * (r >> 2); if (kv >= qabs) { a0 = 1.f; b0 = 0.f; } if (kv + 32 >= qabs) { a1 = 1.f; b1 = 0.f; } }
            x0[r] = a0; x1[r] = a1; p0[r] = b0; p1[r] = b1; }
        float gp[8], lo[8], hv[8], T[8];
#pragma unroll
        for (int m = 0; m < 4; ++m) { gp[m] = (x0[4 * m] * x0[4 * m + 1]) * (x0[4 * m + 2] * x0[4 * m + 3]); gp[4 + m] = (x1[4 * m] * x1[4 * m + 1]) * (x1[4 * m + 2] * x1[4 * m + 3]); }
#pragma unroll
        for (int m = 0; m < 8; ++m) lo[m] = swap_lo(gp[m], hv[m]);
        T[7] = 1.0f;
#pragma unroll
        for (int m = 6; m >= 0; --m) T[m] = T[m + 1] * (lo[m + 1] * hv[m + 1]);
        const float total = T[0] * (lo[0] * hv[0]);
#pragma unroll
        for (int m = 0; m < 8; ++m) {
            float c = carry * T[m]; if (hi == 0) c *= hv[m];
            if (m < 4) { p0[4 * m + 3] *= c; c *= x0[4 * m + 3]; p0[4 * m + 2] *= c; c *= x0[4 * m + 2]; p0[4 * m + 1] *= c; c *= x0[4 * m + 1]; p0[4 * m] *= c; }
            else { const int q = m - 4; p1[4 * q + 3] *= c; c *= x1[4 * q + 3]; p1[4 * q + 2] *= c; c *= x1[4 * q + 2]; p1[4 * q + 1] *= c; c *= x1[4 * q + 1]; p1[4 * q] *= c; } }
        carry *= total;
        u32x4 w0, w1, w2, w3; ATT_PACK4(p0, p1, w0, w1, w2, w3);
        pv(o, vp0 + sl, __builtin_bit_cast(bf16x8, w0), __builtin_bit_cast(bf16x8, w1), __builtin_bit_cast(bf16x8, w2), __builtin_bit_cast(bf16x8, w3));
    }
    float one[16];
#pragma unroll
    for (int r = 0; r < 16; ++r) one[r] = 1.0f;
    store_o(o, one, shm + LDS_OST + wid * 4096, Oh + (long)q0w * op, op, lane, r32, hi);
    asm volatile("s_waitcnt lgkmcnt(0)\n\ts_barrier" ::: "memory");
}

__device__ __forceinline__ void mem_unit(const bf16* Qh, int qp, const bf16* Kh, const bf16* Vh, int kp, bf16* Oh, int op, lds_ptr shm) {
    int tid = threadIdx.x; asm volatile("" : "+v"(tid)); const int lane = tid & 63, r32 = lane & 31, hi = lane >> 5; const int wid = __builtin_amdgcn_readfirstlane(tid >> 6);
    const unsigned lds0 = (unsigned)(size_t)shm;
    const lds_cptr kp0 = (lds_cptr)shm + LDS_K, vp0 = (lds_cptr)shm + LDS_V + ((lane >> 4) & 1) * 32 + (lane & 3) * 8 + (4 * hi + ((lane & 15) >> 2)) * 64;
#pragma unroll
    for (int t = 0; t < 4; ++t) { dma_k(Kh + (long)t * 64 * kp, kp, lds0 + LDS_K + t * SLOTB, wid, lane); dma_v(Vh + (long)t * 64 * kp, kp, lds0 + LDS_V + t * SLOTB, wid, lane); }
    bf16x8 qr[4];
#pragma unroll
    for (int d0 = 0; d0 < 4; ++d0) qr[d0] = *(const bf16x8*)(Qh + (long)(wid * 32 + r32) * qp + d0 * 16 + hi * 8);
    ATT_WAIT_BAR(0);
    f32x16 p[8];
#pragma unroll
    for (int t = 0; t < 4; ++t) qkt(p[2 * t], p[2 * t + 1], kp0 + t * SLOTB, qr, r32, hi);
    float mx = -INFINITY;
#pragma unroll
    for (int t = 0; t < 8; ++t)
#pragma unroll
        for (int r = 0; r < 16; ++r) mx = fmaxf(mx, p[t][r]);
    { float h2; const float l2 = swap_lo(mx, h2); mx = fmaxf(l2, h2); }
    float sum = 0.f;
#pragma unroll
    for (int t = 0; t < 8; ++t)
#pragma unroll
        for (int r = 0; r < 16; ++r) { const float e = __builtin_amdgcn_exp2f(p[t][r] - mx); p[t][r] = e; sum += e; }
    { float h2; const float l2 = swap_lo(sum, h2); sum = l2 + h2; }
    f32x16 o[2]; o[0] = f32x16{}; o[1] = f32x16{};
#pragma unroll
    for (int t = 0; t < 4; ++t) { u32x4 w0, w1, w2, w3; ATT_PACK4(p[2 * t], p[2 * t + 1], w0, w1, w2, w3);
        pv(o, vp0 + t * SLOTB, __builtin_bit_cast(bf16x8, w0), __builtin_bit_cast(bf16x8, w1), __builtin_bit_cast(bf16x8, w2), __builtin_bit_cast(bf16x8, w3)); }
    __attribute__((address_space(3))) float* wsf = (__attribute__((address_space(3))) float*)(shm + LDS_WS) + wid * 64;
    if (hi == 0) wsf[r32] = sum;
    asm volatile("s_waitcnt lgkmcnt(0)" ::: "memory");
    float rli[16];
#pragma unroll
    for (int r = 0; r < 16; ++r) rli[r] = __builtin_amdgcn_rcpf(wsf[crow(r, hi)]);
    store_o(o, rli, shm + LDS_OST + wid * 4096, Oh + (long)(wid * 32) * op, op, lane, r32, hi);
    asm volatile("s_waitcnt lgkmcnt(0)\n\ts_barrier" ::: "memory");
}
}
constexpr int NWAVES = 8;
constexpr int DM = 1024, NB = 4, T = 4096, M = NB * T, DEPTH = 4, HD = 64, MIXH = 12, MIXW = 768, MEMH = 4, MEMW = 256, MEMT = 256;
constexpr int FF = 2816, NE = 8, NC0 = 2560, NC1 = 2592, NP0 = 2816, NP1 = 3072;
constexpr int MAXSLOT = 2 * M + NE * 256;
constexpr float LN_EPS = 1e-5f, GN_EPS = 64e-5f, ALPHA = 1.681792830507429f;
constexpr float C2 = 0.125f * 1.4426950408889634f;
typedef unsigned short bf16;

constexpr size_t al256(size_t x) { return (x + 255) & ~(size_t)255; }
constexpr size_t WS_CTL = 0, CTL_ZERO_BYTES = 1u << 20;
constexpr size_t SZ_WIN0 = (size_t)NP0 * DM * 2, SZ_WIN1 = (size_t)NP1 * DM * 2, SZ_WINB = (size_t)DM * DM * 2, SZ_WKV = (size_t)1536 * DM * 2, SZ_WMKV = (size_t)2048 * DM * 2, SZ_WO = (size_t)DM * DM * 2;
constexpr size_t SZ_WGU = (size_t)2 * FF * DM * 2, SZ_WDN = (size_t)DM * FF * 2, SZ_WLORA = (size_t)3072 * 512 * 2;
constexpr size_t WS_WIN0 = CTL_ZERO_BYTES, WS_WIN1 = WS_WIN0 + SZ_WIN0, WS_WIN2 = WS_WIN1 + SZ_WIN1, WS_WIN3 = WS_WIN2 + SZ_WINB, WS_WKV = WS_WIN3 + SZ_WINB, WS_WMKV = WS_WKV + SZ_WKV;
constexpr size_t WS_WO = WS_WMKV + SZ_WMKV, WS_WGU = WS_WO + 4 * SZ_WO, WS_WDN = WS_WGU + 2 * SZ_WGU, WS_WEGU = WS_WDN + 2 * SZ_WDN, WS_WEDN = WS_WEGU + 16 * SZ_WGU, WS_WLORA = WS_WEDN + 16 * SZ_WDN;
constexpr size_t WS_XB = WS_WLORA + 2 * SZ_WLORA, WS_XB1 = WS_XB + (size_t)M * DM * 2, WS_MEMB = WS_XB1 + (size_t)M * DM * 2, WS_MKV = WS_MEMB + (size_t)1024 * DM * 2;
constexpr size_t WS_XF0 = WS_MKV + (size_t)1024 * 2048 * 2, WS_XF1 = WS_XF0 + (size_t)M * DM * 4, WS_PRE = WS_XF1 + (size_t)M * DM * 4, WS_VFIRST = WS_PRE + (size_t)M * DM * 4;
constexpr size_t WS_MIX = WS_VFIRST + (size_t)M * MIXW * 4, WS_KV = WS_MIX + (size_t)M * DM * 2, WS_ROUTE = WS_KV + (size_t)M * 1536 * 2;
constexpr size_t RO_E = 0, RO_W = RO_E + (size_t)M * 4, RO_SLOT = RO_W + (size_t)M * 8, RO_CNTC = RO_SLOT + (size_t)M * 8, RO_TILE = RO_CNTC + 256 * 8 * 4, RO_END = RO_TILE + 256 * 4;
constexpr size_t WS_SCR = al256(WS_ROUTE + RO_END);
constexpr size_t SC_P = 0, SC_U = SC_P + (size_t)M * NP1 * 2, SC_WDEC = SC_U + (size_t)M * 512 * 2, SC_AI = SC_WDEC + (size_t)M * MIXW * 4, SC_VG = SC_AI + (size_t)M * MIXW * 4, SC_G = SC_VG + (size_t)M * MIXW * 4;
constexpr size_t SC_R = SC_G + (size_t)M * MIXW * 4, SC_K2 = SC_R + (size_t)M * MIXW * 4, SC_V = SC_K2 + (size_t)M * MIXW * 4, SC_KK = SC_V + (size_t)M * MIXW * 4, SC_Y = SC_KK + (size_t)M * MIXW * 4, SC_SRK = SC_Y + (size_t)M * MIXW * 4, SC_MIXEND = SC_SRK + (size_t)M * MIXH * 4;
constexpr size_t SC_H = 0, SC_XG = SC_H + (size_t)MAXSLOT * FF * 2, SC_YE = SC_XG + (size_t)MAXSLOT * DM * 2, SC_FFNEND = SC_YE + (size_t)MAXSLOT * DM * 4;
constexpr size_t WS_END = WS_SCR + (SC_MIXEND > SC_FFNEND ? SC_MIXEND : SC_FFNEND);
constexpr int CW_BAR = 4096;
constexpr int RING_OFF = 0, RING_BYTES = 131072, LDSCTL_OFF = RING_BYTES, MISC_OFF = LDSCTL_OFF + 320, LDS_BYTES = 147456;

#define GAS __attribute__((address_space(1)))
#define LAS __attribute__((address_space(3)))
typedef unsigned v4u __attribute__((ext_vector_type(4)));
typedef float f32x4 __attribute__((ext_vector_type(4)));
typedef GAS unsigned gu32;
#define RLX_AGENT __ATOMIC_RELAXED, __HIP_MEMORY_SCOPE_AGENT
#define LDS_WAIT() asm volatile("s_waitcnt lgkmcnt(0)" ::: "memory")
__device__ __forceinline__ unsigned f2bf(float f) { unsigned u = __builtin_bit_cast(unsigned, f); return (u + 0x7fffu + ((u >> 16) & 1u)) >> 16; }
__device__ __forceinline__ unsigned pk2(float lo, float hi) { return f2bf(lo) | (f2bf(hi) << 16); }
__device__ __forceinline__ float bf2f(unsigned short b) { return __builtin_bit_cast(float, (unsigned)b << 16); }
__device__ __forceinline__ float bflo(unsigned w) { return __builtin_bit_cast(float, w << 16); }
__device__ __forceinline__ float bfhi(unsigned w) { return __builtin_bit_cast(float, w & 0xffff0000u); }
__device__ __forceinline__ int ld_relaxed(const int* p) { return __hip_atomic_load(p, __ATOMIC_RELAXED, __HIP_MEMORY_SCOPE_AGENT); }

#define XB_TMO      128
#define XB_XCNT(j)  (256  + 64 * (j))
#define XB_XSUB(j)  (1280 + 64 * (j))
#define XB_XGEN(j)  (2304 + 64 * (j))
#define XB_TOP      3328
#define XB_TOPGEN   3392
#define XCD_BAR_WORDS 3456
#define XB_SPIN_CAP (1u << 18)
__device__ __forceinline__ unsigned xb_ld(unsigned* p)              { return __hip_atomic_load(p, __ATOMIC_RELAXED, __HIP_MEMORY_SCOPE_AGENT); }
__device__ __forceinline__ unsigned xb_add(unsigned* p, unsigned v) { return __hip_atomic_fetch_add(p, v, __ATOMIC_RELAXED, __HIP_MEMORY_SCOPE_AGENT); }
__device__ __forceinline__ unsigned xb_xcc_id() { return (unsigned)__builtin_amdgcn_s_getreg((3 << 11) | 20) & 0xFu; }
#define XB_SPIN(cond, bar) do { unsigned _sp = 0; while (cond) { __builtin_amdgcn_s_sleep(1); \
    if ((++_sp & 255u) == 0u) { if (xb_ld(&(bar)[XB_TMO])) break; if (_sp > XB_SPIN_CAP) { atomicAdd(&(bar)[XB_TMO], 1u); break; } } } } while (0)
struct XcdBarrier { unsigned* bar; unsigned x; volatile LAS unsigned* st; };
__device__ __forceinline__ XcdBarrier xcd_barrier_post(unsigned* bar, volatile LAS unsigned* st) {
    XcdBarrier b; b.bar = bar; b.x = xb_xcc_id(); b.st = st;
    if (threadIdx.x == 0) (void)xb_add(&bar[XB_XCNT(b.x)], 1u);
    return b;
}
__device__ __forceinline__ void xcd_barrier_complete(unsigned* bar, unsigned x, unsigned& nloc, unsigned& nx) {
    const unsigned G = gridDim.x * gridDim.y * gridDim.z;
    unsigned sum, cnt, mine, sp = 0u;
    for (;;) {
        sum = 0u; cnt = 0u; mine = 0u;
#pragma unroll
        for (unsigned j = 0; j < 16; ++j) { const unsigned c = xb_ld(&bar[XB_XCNT(j)]); sum += c; cnt += (c > 0u) ? 1u : 0u; mine = (j == x) ? c : mine; }
        if (sum == G) break;
        __builtin_amdgcn_s_sleep(1);
        if ((++sp & 255u) == 0u) { if (xb_ld(&bar[XB_TMO])) break; if (sp > XB_SPIN_CAP) { atomicAdd(&bar[XB_TMO], 1u); break; } }
    }
    nloc = mine > 0u ? mine : 1u; nx = cnt > 0u ? cnt : 1u;
}
__device__ __forceinline__ void xcd_barrier(const XcdBarrier& b) {
    asm volatile("s_waitcnt vmcnt(0)" ::: "memory");
    __syncthreads();
    if (threadIdx.x == 0) {
        unsigned* bar = b.bar;
        __builtin_amdgcn_s_waitcnt(0);
        unsigned nloc = b.st[0], nx = b.st[1];
        if (nloc == 0u) { xcd_barrier_complete(bar, b.x, nloc, nx); b.st[0] = nloc; b.st[1] = nx; }
        const unsigned old = xb_add(&bar[XB_XSUB(b.x)], 1u);
        const unsigned gen = old / nloc;
        if (old + 1u == (gen + 1u) * nloc) {
            __builtin_amdgcn_fence(__ATOMIC_RELEASE, "agent");
            asm volatile("s_waitcnt vmcnt(0)" ::: "memory");
            const unsigned og = xb_add(&bar[XB_TOP], 1u);
            const unsigned tg = og / nx;
            if (og + 1u == (tg + 1u) * nx) xb_add(&bar[XB_TOPGEN], 1u);
            else XB_SPIN(xb_ld(&bar[XB_TOPGEN]) == tg, bar);
            __builtin_amdgcn_fence(__ATOMIC_ACQUIRE, "agent");
            xb_add(&bar[XB_XGEN(b.x)], 1u);
            asm volatile("s_waitcnt vmcnt(0)" ::: "memory");
        } else {
            XB_SPIN(xb_ld(&bar[XB_XGEN(b.x)]) == gen, bar);
            __builtin_amdgcn_fence(__ATOMIC_ACQUIRE, "agent");
            asm volatile("s_waitcnt vmcnt(0)" ::: "memory");
        }
    }
    __syncthreads();
}

struct Frame {
    LAS unsigned char* lds;
    unsigned char* ws;
    int tid, lane, wave, vcu, G;
};
typedef __attribute__((address_space(4))) const unsigned char* kptr_t;
__device__ __forceinline__ const float* inp(int k) { kptr_t ka = (kptr_t)__builtin_amdgcn_kernarg_segment_ptr(); asm volatile("" : "+s"(ka)); return *(const float* const __attribute__((address_space(4)))*)(ka + 8 * k); }
#define ENTER(F) do { int t_ = threadIdx.x; asm volatile("" : "+v"(t_)); (F).tid = t_; (F).lane = t_ & 63; (F).wave = __builtin_amdgcn_readfirstlane(t_ >> 6); unsigned char* w_ = (unsigned char*)inp(24); (F).ws = w_; } while (0)
__device__ __forceinline__ float wave_sum(float v) {
#pragma unroll
    for (int o = 1; o < 64; o <<= 1) v += __shfl_xor(v, o);
    return v;
}
template <int CTRL> __device__ __forceinline__ float dpp(float x) { return __builtin_bit_cast(float, __builtin_amdgcn_mov_dpp(__builtin_bit_cast(int, x), CTRL, 0xf, 0xf, true)); }
__device__ __forceinline__ float red16(float x) { x += dpp<0xB1>(x); x += dpp<0x4E>(x); x += dpp<0x141>(x); x += dpp<0x128>(x); return x; }
__device__ __forceinline__ void conv_item(const float* W, int K, int N, bf16* WT, int ldt, int drow0, LAS float* scr, int kb, int nb, int lane) {
    const int k0 = 64 * kb, n0 = 32 * nb;
#pragma unroll 8
    for (int i = 0; i < 32; ++i) { const int kk = 2 * i + (lane >> 5); scr[kk * 33 + (lane & 31)] = W[(size_t)(k0 + kk) * N + n0 + (lane & 31)]; }
    LDS_WAIT(); asm volatile("" ::: "memory");
    const int c = lane & 7;
#pragma unroll
    for (int j = 0; j < 4; ++j) { const int n = (lane >> 3) + 8 * j; const LAS float* s = scr + (8 * c) * 33 + n;
        v4u o; o.x = pk2(s[0 * 33], s[1 * 33]); o.y = pk2(s[2 * 33], s[3 * 33]); o.z = pk2(s[4 * 33], s[5 * 33]); o.w = pk2(s[6 * 33], s[7 * 33]);
        *(GAS v4u*)(WT + (size_t)(drow0 + n) * ldt + k0 + 8 * c) = o; }
    LDS_WAIT(); asm volatile("" ::: "memory");
}
__device__ __forceinline__ int swiglu_row(int n0) { const int up = n0 >= FF, h = up ? n0 - FF : n0; return 256 * (h >> 7) + (up ? 128 : 0) + (h & 127); }
__device__ __forceinline__ void conv_mat(const float* W, int K, int N, bf16* WT, int mode, int row_off, LAS float* scr, int r, int lane) {
    const int nblk = N / 32, kb = r / nblk, nb = r % nblk, n0 = 32 * nb;
    const int d0 = mode == 1 ? swiglu_row(n0) : mode == 2 ? (n0 < NC1 ? n0 : n0 - NC1 + NP0) : row_off + n0;
    conv_item(W, K, N, WT, K, d0, scr, kb, nb, lane);
}
__device__ __forceinline__ void p0_prologue(Frame& F) {
    ENTER(F);
    LAS float* scr = (LAS float*)(F.lds + RING_OFF + F.wave * 16384);
    const int gw = F.vcu * NWAVES + F.wave, NGW = F.G * NWAVES;
    unsigned char* ws = F.ws;
    constexpr int I_IN0 = 16 * (NP0 / 32), I_IN1 = 16 * (2848 / 32), I_SQ = 16 * 32, I_KV = 16 * 48, I_MKV = 16 * 16, I_GU = 16 * (2 * FF / 32), I_DN = (FF / 64) * 32;
    constexpr int NITEMS = I_IN0 + I_IN1 + 2 * I_SQ + I_KV + 4 * I_MKV + 4 * I_SQ + 2 * I_GU + 2 * I_DN + 16 * I_GU + 16 * I_DN;
    for (int it = gw; it < NITEMS; it += NGW) {
        int r = it;
        if (r < I_IN0) { conv_mat(inp(2), DM, NP0, (bf16*)(ws + WS_WIN0), 0, 0, scr, r, F.lane); continue; } r -= I_IN0;
        if (r < I_IN1) { conv_mat(inp(3), DM, 2848, (bf16*)(ws + WS_WIN1), 2, 0, scr, r, F.lane); continue; } r -= I_IN1;
        if (r < 2 * I_SQ) { const int j = r / I_SQ; conv_mat(inp(13) + (size_t)j * DM * DM, DM, DM, (bf16*)(ws + WS_WIN2 + j * SZ_WINB), 0, 0, scr, r % I_SQ, F.lane); continue; } r -= 2 * I_SQ;
        if (r < I_KV) { conv_mat(inp(14), DM, 1536, (bf16*)(ws + WS_WKV), 0, 0, scr, r, F.lane); continue; } r -= I_KV;
        if (r < 4 * I_MKV) { const int j = r / I_MKV; conv_mat(inp(15) + (size_t)j * DM * 512, DM, 512, (bf16*)(ws + WS_WMKV), 0, j * 512, scr, r % I_MKV, F.lane); continue; } r -= 4 * I_MKV;
        if (r < 4 * I_SQ) { const int j = r / I_SQ; conv_mat(inp(16) + (size_t)j * DM * DM, DM, DM, (bf16*)(ws + WS_WO + j * SZ_WO), 0, 0, scr, r % I_SQ, F.lane); continue; } r -= 4 * I_SQ;
        if (r < 2 * I_GU) { const int j = r / I_GU; conv_mat(inp(18) + (size_t)j * DM * 2 * FF, DM, 2 * FF, (bf16*)(ws + WS_WGU + j * SZ_WGU), 1, 0, scr, r % I_GU, F.lane); continue; } r -= 2 * I_GU;
        if (r < 2 * I_DN) { const int j = r / I_DN; conv_mat(inp(19) + (size_t)j * FF * DM, FF, DM, (bf16*)(ws + WS_WDN + j * SZ_WDN), 0, 0, scr, r % I_DN, F.lane); continue; } r -= 2 * I_DN;
        if (r < 16 * I_GU) { const int j = r / I_GU; conv_mat(inp(21) + (size_t)j * DM * 2 * FF, DM, 2 * FF, (bf16*)(ws + WS_WEGU + j * SZ_WGU), 1, 0, scr, r % I_GU, F.lane); continue; } r -= 16 * I_GU;
        { const int j = r / I_DN; conv_mat(inp(22) + (size_t)j * FF * DM, FF, DM, (bf16*)(ws + WS_WEDN + j * SZ_WDN), 0, 0, scr, r % I_DN, F.lane); }
    }
    const int gt = F.vcu * (NWAVES * 64) + F.tid, NGT = F.G * NWAVES * 64;
    { GAS v4u* z = (GAS v4u*)(ws + WS_WIN1 + (size_t)NC1 * DM * 2); const int n16 = (NP0 - NC1) * DM * 2 / 16; for (int i = gt; i < n16; i += NGT) z[i] = (v4u){0u, 0u, 0u, 0u}; }
    const float* wup = inp(7); const float* aup = inp(8); const float* gup = inp(9); const float* vup = inp(11);
    for (int i = gt; i < 2 * 3072 * 256; i += NGT) { const int l = i / (3072 * 256), rem = i % (3072 * 256), n = rem / 256, k = (rem % 256) * 2, blk = n / 768, c = n % 768;
        float v0 = 0.f, v1 = 0.f;
        if (blk == 0 && k < 64) { v0 = wup[((size_t)l * 64 + k) * 768 + c]; v1 = wup[((size_t)l * 64 + k + 1) * 768 + c]; }
        else if (blk == 1 && k >= 128 && k < 192) { v0 = aup[((size_t)l * 64 + k - 128) * 768 + c]; v1 = aup[((size_t)l * 64 + k - 127) * 768 + c]; }
        else if (blk == 2 && l == 1 && k >= 256 && k < 288) { v0 = vup[(size_t)(k - 256) * 768 + c]; v1 = vup[(size_t)(k - 255) * 768 + c]; }
        else if (blk == 3 && k >= 384) { v0 = gup[((size_t)l * 128 + k - 384) * 768 + c]; v1 = gup[((size_t)l * 128 + k - 383) * 768 + c]; }
        ((GAS unsigned*)(ws + WS_WLORA))[i] = pk2(v0, v1); }
    { const GAS f32x4* x4 = (const GAS f32x4*)inp(0); GAS v4u* o = (GAS v4u*)(ws + WS_XB);
      for (int i = gt; i < M * DM / 8; i += NGT) { const f32x4 a = x4[2 * i], b = x4[2 * i + 1]; o[i] = (v4u){pk2(a.x, a.y), pk2(a.z, a.w), pk2(b.x, b.y), pk2(b.z, b.w)}; } }
    { const GAS f32x4* x4 = (const GAS f32x4*)inp(1); GAS v4u* o = (GAS v4u*)(ws + WS_MEMB);
      for (int i = gt; i < 1024 * DM / 8; i += NGT) { const f32x4 a = x4[2 * i], b = x4[2 * i + 1]; o[i] = (v4u){pk2(a.x, a.y), pk2(a.z, a.w), pk2(b.x, b.y), pk2(b.z, b.w)}; } }
}

__device__ __forceinline__ float sigmoidf_(float x) { return 1.0f / (1.0f + __expf(-x)); }
__device__ __forceinline__ void ph_lora_in(Frame& F, int l) {
    ENTER(F);
    const int NP = l == 0 ? NP0 : NP1, GD0 = l == 0 ? 2432 : 2464;
    const bf16* P = (const bf16*)(F.ws + WS_SCR + SC_P); bf16* U = (bf16*)(F.ws + WS_SCR + SC_U);
    const float* mu = l == 0 ? inp(4) : inp(5);
    const int gw = F.vcu * NWAVES + F.wave, NGW = F.G * NWAVES;
    const int cu = 8 * F.lane, reg = cu >> 7, off = cu & 127;
    int src = -1, mode = 0;
    if (reg == 0 && off < 64) { src = 2304 + off; mode = 1; }
    else if (reg == 1 && off < 64) { src = 2368 + off; mode = 0; }
    else if (reg == 2 && l == 1 && off < 32) { src = 2432 + off; mode = 0; }
    else if (reg == 3) { src = GD0 + off; mode = 2; }
    for (int m = gw; m < M; m += NGW) {
        v4u o = (v4u){0u, 0u, 0u, 0u};
        if (src >= 0) {
            const v4u pc = *(const GAS v4u*)(P + (size_t)m * NP + src);
            v4u pp = (v4u){0u, 0u, 0u, 0u}; if ((m & (T - 1)) != 0) pp = *(const GAS v4u*)(P + (size_t)(m - 1) * NP + src);
            float v[8];
#pragma unroll
            for (int j = 0; j < 4; ++j) { const float c0 = bflo(pc[j]), c1 = bfhi(pc[j]), q0 = bflo(pp[j]), q1 = bfhi(pp[j]);
                v[2 * j] = c0 + mu[src + 2 * j] * (q0 - c0); v[2 * j + 1] = c1 + mu[src + 2 * j + 1] * (q1 - c1); }
#pragma unroll
            for (int j = 0; j < 8; ++j) { if (mode == 1) v[j] = tanhf(v[j]); else if (mode == 2) v[j] = sigmoidf_(v[j]); }
            o = (v4u){pk2(v[0], v[1]), pk2(v[2], v[3]), pk2(v[4], v[5]), pk2(v[6], v[7])};
        }
        *(GAS v4u*)(U + (size_t)m * 512 + cu) = o;
    }
}
__device__ __forceinline__ void ph_finalize(Frame& F, int l) {
    ENTER(F);
    const int NP = l == 0 ? NP0 : NP1;
    const bf16* P = (const bf16*)(F.ws + WS_SCR + SC_P);
    const float* mu = l == 0 ? inp(4) : inp(5);
    const float* vec = inp(6) + (size_t)l * 6 * MIXW; const float* k_k = vec + 2 * MIXW; const float* k_a = vec + 3 * MIXW; const float* r_k = inp(12) + (size_t)l * MIXW;
    const float* AI = (const float*)(F.ws + WS_SCR + SC_AI); const float* VG = (const float*)(F.ws + WS_SCR + SC_VG);
    float* R = (float*)(F.ws + WS_SCR + SC_R); float* K2 = (float*)(F.ws + WS_SCR + SC_K2); float* V = (float*)(F.ws + WS_SCR + SC_V); float* KK = (float*)(F.ws + WS_SCR + SC_KK);
    float* SRK = (float*)(F.ws + WS_SCR + SC_SRK); float* VF = (float*)(F.ws + WS_VFIRST);
    const int gw = F.vcu * NWAVES + F.wave, NGW = F.G * NWAVES;
    for (int m = gw; m < M; m += NGW) {
        const bool first = (m & (T - 1)) == 0;
        const bf16* pc = P + (size_t)m * NP; const bf16* pp = pc - NP;
        for (int h = 0; h < MIXH; ++h) { const int c = h * 64 + F.lane;
            float r = bf2f(pc[c]), k = bf2f(pc[768 + c]), v = bf2f(pc[1536 + c]);
            const float pr = first ? 0.f : bf2f(pp[c]), pk = first ? 0.f : bf2f(pp[768 + c]), pvv = first ? 0.f : bf2f(pp[1536 + c]);
            r += mu[c] * (pr - r); k += mu[768 + c] * (pk - k); v += mu[1536 + c] * (pvv - v);
            const float a = AI[(size_t)m * MIXW + c];
            float kk = k * k_k[c]; const float nrm = sqrtf(wave_sum(kk * kk)); kk = kk / fmaxf(nrm, 1e-12f);
            const float k2 = k * (1.0f + (a - 1.0f) * k_a[c]);
            if (l == 0) VF[(size_t)m * MIXW + c] = v; else { const float vf = VF[(size_t)m * MIXW + c]; v = v + (vf - v) * VG[(size_t)m * MIXW + c]; }
            const float s = wave_sum(r * k2 * r_k[c]);
            R[(size_t)m * MIXW + c] = r; K2[(size_t)m * MIXW + c] = k2; V[(size_t)m * MIXW + c] = v; KK[(size_t)m * MIXW + c] = kk;
            if (F.lane == 0) SRK[(size_t)m * MIXH + h] = s;
        }
    }
}
__device__ __forceinline__ void ph_scan(Frame& F) {
    ENTER(F);
    constexpr int TC = 32, NARR = 6, BUF = TC * NARR * 64;
    LAS float* sm = (LAS float*)(F.lds + RING_OFF);
    const float* src[NARR] = {(const float*)(F.ws + WS_SCR + SC_KK), (const float*)(F.ws + WS_SCR + SC_AI), (const float*)(F.ws + WS_SCR + SC_WDEC), (const float*)(F.ws + WS_SCR + SC_K2), (const float*)(F.ws + WS_SCR + SC_R), (const float*)(F.ws + WS_SCR + SC_V)};
    float* Y = (float*)(F.ws + WS_SCR + SC_Y);
    const int il = F.lane >> 4, ks = F.lane & 15, st = F.tid >> 4, c4 = F.tid & 15;
    for (int item = blockIdx.x; item < NB * MIXH * 2; item += F.G) {
        const int half = item & 1, bh = item >> 1, b = bh / MIXH, h = bh % MIXH;
        const int irow = 32 * half + 4 * F.wave + il;
        const size_t rb = (size_t)b * T * MIXW + h * 64;
        f32x4 S = (f32x4){0.f, 0.f, 0.f, 0.f};
        f32x4 stg[NARR];
#pragma unroll
        for (int a = 0; a < NARR; ++a) stg[a] = *(const GAS f32x4*)(src[a] + rb + (size_t)st * MIXW + 4 * c4);
        __syncthreads();
#pragma unroll
        for (int a = 0; a < NARR; ++a) *(LAS f32x4*)(sm + (a * TC + st) * 64 + 4 * c4) = stg[a];
        __syncthreads();
        for (int ch = 0; ch < T / TC; ++ch) {
            const int cur = ch & 1;
            if (ch + 1 < T / TC) {
#pragma unroll
                for (int a = 0; a < NARR; ++a) stg[a] = *(const GAS f32x4*)(src[a] + rb + (size_t)((ch + 1) * TC + st) * MIXW + 4 * c4);
            }
            const LAS float* bs = sm + cur * BUF;
#pragma unroll 4
            for (int s = 0; s < TC; ++s) {
                const f32x4 kk = *(const LAS f32x4*)(bs + (0 * TC + s) * 64 + 4 * ks), ai = *(const LAS f32x4*)(bs + (1 * TC + s) * 64 + 4 * ks), w = *(const LAS f32x4*)(bs + (2 * TC + s) * 64 + 4 * ks);
                const f32x4 k2 = *(const LAS f32x4*)(bs + (3 * TC + s) * 64 + 4 * ks), r = *(const LAS f32x4*)(bs + (4 * TC + s) * 64 + 4 * ks);
                const float v = bs[(5 * TC + s) * 64 + irow];
                float sa = -((S.x * kk.x + S.y * kk.y) + (S.z * kk.z + S.w * kk.w));
                sa = red16(sa);
                const f32x4 bb = kk * ai;
                S = S * w + bb * sa + k2 * v;
                float y = (S.x * r.x + S.y * r.y) + (S.z * r.z + S.w * r.w);
                y = red16(y);
                if (ks == 0) Y[rb + (size_t)(ch * TC + s) * MIXW + irow] = y;
            }
            if (ch + 1 < T / TC) {
#pragma unroll
                for (int a = 0; a < NARR; ++a) *(LAS f32x4*)(sm + (cur ^ 1) * BUF + (a * TC + st) * 64 + 4 * c4) = stg[a];
            }
            __syncthreads();
        }
    }
}
__device__ __forceinline__ void ph_gn(Frame& F, int l) {
    ENTER(F);
    const float* vec = inp(6) + (size_t)l * 6 * MIXW; const float* lg = vec + 4 * MIXW; const float* lb = vec + 5 * MIXW;
    const float* Y = (const float*)(F.ws + WS_SCR + SC_Y); const float* V = (const float*)(F.ws + WS_SCR + SC_V); const float* Gt = (const float*)(F.ws + WS_SCR + SC_G); const float* SRK = (const float*)(F.ws + WS_SCR + SC_SRK);
    bf16* MIX = (bf16*)(F.ws + WS_MIX);
    const int gw = F.vcu * NWAVES + F.wave, NGW = F.G * NWAVES;
    for (int m = gw; m < M; m += NGW)
        for (int h = 0; h < MIXH; ++h) { const int c = h * 64 + F.lane;
            const float y = Y[(size_t)m * MIXW + c]; const float mean = wave_sum(y) * (1.0f / 64.0f); const float d = y - mean; const float var = wave_sum(d * d) * (1.0f / 64.0f);
            float o = d * (1.0f / sqrtf(var + GN_EPS)) * lg[c] + lb[c];
            o += SRK[(size_t)m * MIXH + h] * V[(size_t)m * MIXW + c];
            o *= Gt[(size_t)m * MIXW + c];
            MIX[(size_t)m * DM + c] = (bf16)f2bf(o); }
}

__device__ __forceinline__ void ph_ln(Frame& F, int mode, const float* gain, const float* bias, size_t xf_off, size_t xb_off, int to_out, int route, const float* wr) {
    ENTER(F);
    float* XF = to_out ? (float*)inp(23) : (float*)(F.ws + xf_off); bf16* XB = (bf16*)(F.ws + xb_off);
    const float* PRE = (const float*)(F.ws + WS_PRE); const float* XF1 = (const float*)(F.ws + WS_XF1); const float* YE = (const float*)(F.ws + WS_SCR + SC_YE);
    const int* SLOT = (const int*)(F.ws + WS_ROUTE + RO_SLOT); const float* RW = (const float*)(F.ws + WS_ROUTE + RO_W);
    int* RT_E = (int*)(F.ws + WS_ROUTE + RO_E); float* RT_W = (float*)(F.ws + WS_ROUTE + RO_W); int* CNTC = (int*)(F.ws + WS_ROUTE + RO_CNTC);
    LAS int* cnt = (LAS int*)(F.lds + RING_OFF);
    f32x4 gv[4], bv[4];
#pragma unroll
    for (int j = 0; j < 4; ++j) { gv[j] = *(const f32x4*)(gain + 4 * F.lane + 256 * j); bv[j] = *(const f32x4*)(bias + 4 * F.lane + 256 * j); }
    for (int chunk = blockIdx.x; chunk < M / 64; chunk += F.G) {
        if (route) { if (F.tid < NE) cnt[F.tid] = 0; __syncthreads(); }
        for (int rr = 0; rr < 8; ++rr) { const int m = chunk * 64 + F.wave * 8 + rr;
            f32x4 v[4]; float s = 0.f;
            if (mode == 0) {
#pragma unroll
                for (int j = 0; j < 4; ++j) v[j] = *(const GAS f32x4*)(PRE + (size_t)m * DM + 4 * F.lane + 256 * j);
            } else {
                const int s1 = ld_relaxed(SLOT + 2 * m), s2 = ld_relaxed(SLOT + 2 * m + 1); const float w1 = __builtin_bit_cast(float, ld_relaxed((const int*)RW + 2 * m)), w2 = __builtin_bit_cast(float, ld_relaxed((const int*)RW + 2 * m + 1));
#pragma unroll
                for (int j = 0; j < 4; ++j) { const f32x4 x = *(const GAS f32x4*)(XF1 + (size_t)m * DM + 4 * F.lane + 256 * j), y1 = *(const GAS f32x4*)(YE + (size_t)s1 * DM + 4 * F.lane + 256 * j), y2 = *(const GAS f32x4*)(YE + (size_t)s2 * DM + 4 * F.lane + 256 * j);
                    v[j] = x * ALPHA + y1 * w1 + y2 * w2; }
            }
#pragma unroll
            for (int j = 0; j < 4; ++j) s += (v[j].x + v[j].y) + (v[j].z + v[j].w);
            const float mean = wave_sum(s) * (1.f / DM); float s2 = 0.f;
#pragma unroll
            for (int j = 0; j < 4; ++j) { v[j] = v[j] - mean; s2 += (v[j].x * v[j].x + v[j].y * v[j].y) + (v[j].z * v[j].z + v[j].w * v[j].w); }
            const float rstd = 1.f / sqrtf(wave_sum(s2) * (1.f / DM) + LN_EPS);
#pragma unroll
            for (int j = 0; j < 4; ++j) { v[j] = v[j] * rstd * gv[j] + bv[j];
                *(GAS f32x4*)(XF + (size_t)m * DM + 4 * F.lane + 256 * j) = v[j];
                *(GAS unsigned long long*)(XB + (size_t)m * DM + 4 * F.lane + 256 * j) = (unsigned long long)pk2(v[j].x, v[j].y) | ((unsigned long long)pk2(v[j].z, v[j].w) << 32); }
            if (route) {
                float lg[NE];
#pragma unroll
                for (int e = 0; e < NE; ++e) lg[e] = 0.f;
#pragma unroll
                for (int j = 0; j < 4; ++j)
#pragma unroll
                    for (int q = 0; q < 4; ++q) { const int c = 4 * F.lane + 256 * j + q; const f32x4 wa = *(const f32x4*)(wr + (size_t)c * NE), wb = *(const f32x4*)(wr + (size_t)c * NE + 4); const float xv = v[j][q];
                        lg[0] += xv * wa.x; lg[1] += xv * wa.y; lg[2] += xv * wa.z; lg[3] += xv * wa.w; lg[4] += xv * wb.x; lg[5] += xv * wb.y; lg[6] += xv * wb.z; lg[7] += xv * wb.w; }
#pragma unroll
                for (int e = 0; e < NE; ++e) lg[e] = wave_sum(lg[e]);
                int e1 = 0; float b1 = lg[0];
#pragma unroll
                for (int e = 1; e < NE; ++e) if (lg[e] > b1) { b1 = lg[e]; e1 = e; }
                int e2 = -1; float b2 = -INFINITY;
#pragma unroll
                for (int e = 0; e < NE; ++e) if (e != e1 && lg[e] > b2) { b2 = lg[e]; e2 = e; }
                const float w1 = 1.0f / (1.0f + __expf(b2 - b1));
                if (F.lane == 0) { RT_E[m] = e1 | (e2 << 8); RT_W[2 * m] = w1; RT_W[2 * m + 1] = 1.0f - w1; __hip_atomic_fetch_add(&cnt[e1], 1, __ATOMIC_RELAXED, __HIP_MEMORY_SCOPE_WORKGROUP); __hip_atomic_fetch_add(&cnt[e2], 1, __ATOMIC_RELAXED, __HIP_MEMORY_SCOPE_WORKGROUP); }
            }
        }
        if (route) { __syncthreads(); if (F.tid < NE) CNTC[chunk * NE + F.tid] = cnt[F.tid]; __syncthreads(); }
    }
}
__device__ __forceinline__ void ph_route2(Frame& F) {
    ENTER(F);
    const int* CNTC = (const int*)(F.ws + WS_ROUTE + RO_CNTC); const int* RT_E = (const int*)(F.ws + WS_ROUTE + RO_E); int* SLOT = (int*)(F.ws + WS_ROUTE + RO_SLOT); int* TILE = (int*)(F.ws + WS_ROUTE + RO_TILE);
    const bf16* XB1 = (const bf16*)(F.ws + WS_XB1); bf16* XG = (bf16*)(F.ws + WS_SCR + SC_XG);
    LAS int* sh = (LAS int*)(F.lds + RING_OFF);
    for (int chunk = blockIdx.x; chunk < M / 64; chunk += F.G) {
        { const int e = F.wave; int tot = 0, off = 0;
#pragma unroll
          for (int k = 0; k < 4; ++k) { const int c = F.lane + 64 * k; const int v = ld_relaxed(CNTC + c * NE + e); tot += v; off += (c < chunk) ? v : 0; }
          tot = (int)wave_sum((float)tot); off = (int)wave_sum((float)off);
          if (F.lane == 0) { sh[e] = tot; sh[8 + e] = off; } }
        __syncthreads();
        if (F.tid == 0) { int sb = 0; for (int e = 0; e < NE; ++e) { sh[16 + e] = sb; sb += (sh[e] + 255) & ~255; } sh[24] = sb; }
        __syncthreads();
        if (F.wave == 0) { const int m = chunk * 64 + F.lane; const int ee = ld_relaxed(RT_E + m); const int e1 = ee & 0xff, e2 = (ee >> 8) & 0xff;
            const unsigned long long below = (1ull << F.lane) - 1ull; int s1 = 0, s2 = 0;
#pragma unroll
            for (int e = 0; e < NE; ++e) { const unsigned long long m1 = __ballot(e1 == e), m2 = __ballot(e2 == e); const int prior = __popcll(m1 & below) + __popcll(m2 & below);
                const int base = sh[16 + e] + sh[8 + e] + prior; if (e1 == e) s1 = base; if (e2 == e) s2 = base; }
            SLOT[2 * m] = s1; SLOT[2 * m + 1] = s2; sh[32 + 2 * F.lane] = s1; sh[33 + 2 * F.lane] = s2; }
        __syncthreads();
        for (int a = F.wave; a < 128; a += NWAVES) { const int slot = sh[32 + a], m = chunk * 64 + (a >> 1);
            const GAS v4u* s = (const GAS v4u*)(XB1 + (size_t)m * DM); GAS v4u* d = (GAS v4u*)(XG + (size_t)slot * DM);
            d[F.lane] = s[F.lane]; d[64 + F.lane] = s[64 + F.lane]; }
        if (chunk == 0 && F.tid < 256) { const int nt = sh[24] >> 8; int e = 0; for (int q = 1; q < NE; ++q) if (F.tid * 256 >= sh[16 + q]) e = q; TILE[F.tid] = (F.tid == 255) ? nt : e; }
        __syncthreads();
    }
}
constexpr int NPHASE = 1 + 12 * DEPTH;
__host__ __device__ inline bool phase_exists(int ph) {
    if (ph == 0) return true;
    const int l = (ph - 1) / 12, k = (ph - 1) % 12; const bool isA = l < 2, moe = l & 1;
    if (k >= 2 && k <= 5) return isA;
    if (k == 8) return moe;
    return true;
}
struct Args { const float* in[23]; float* out; unsigned char* ws; int ph_lo, ph_hi; };
struct Order {
    int nM, nN, G, c; const int* tile_e;
    __device__ __forceinline__ bool next(int i, pg8::Unit& u) const { if (!pg8::order_map((long)i * G + c, nM, nN, u.pm, u.pn)) return false;
        int e = 0; if (tile_e) e = __builtin_amdgcn_readfirstlane(ld_relaxed(tile_e + u.pm)); u.bt = e * nN + u.pn; return true; }
};
__global__ void __launch_bounds__(NWAVES * 64, 2) fwd(Args args) {
    extern __shared__ __attribute__((aligned(16))) unsigned char lds[];
    Frame F;
    F.lds = (LAS unsigned char*)lds;
    volatile LAS unsigned* MISC = (volatile LAS unsigned*)(F.lds + MISC_OFF);
    ENTER(F);
    F.G = gridDim.x; { const int bx = blockIdx.x; F.vcu = (F.G % 8 == 0) ? (bx % 8) * (F.G / 8) + bx / 8 : bx; }
    for (int u = F.tid; u < (LDS_BYTES - LDSCTL_OFF) / 4; u += NWAVES * 64) ((LAS unsigned*)(F.lds + LDSCTL_OFF))[u] = 0u;
    __syncthreads();
    const int lo = args.ph_lo, hi = args.ph_hi;
    XcdBarrier bar; bar.bar = (unsigned*)(F.ws + WS_CTL) + CW_BAR; bar.x = 0; bar.st = MISC + 8;
    if (hi - lo > 1) bar = xcd_barrier_post((unsigned*)(F.ws + WS_CTL) + CW_BAR, MISC + 8);
#define IN(k) (lo <= (k) && (k) < hi)
#define SEAM(k) do { if ((k) + 1 < hi) xcd_barrier(bar); } while (0)

    if (IN(0)) { p0_prologue(F); SEAM(0); }

    for (int l = 0; l < DEPTH; ++l) {
        const int pb = 1 + 12 * l; const bool isA = l < 2, moe = (l & 1) != 0;
        const int NP = l == 0 ? NP0 : l == 1 ? NP1 : DM;
        const int QM_OFF = l == 0 ? NC0 : l == 1 ? NP0 : MIXW;
        if (IN(pb)) {
            for (int gi = 0; gi < 2; ++gi) {
                if (gi == 1 && !(l == 0 || l == 2)) break;
                ENTER(F); unsigned char* ws = F.ws;
                pg8::Gemm g; pg8::EpiStore E; Order S; S.G = F.G; S.c = (int)blockIdx.x; S.tile_e = nullptr;
                if (gi == 0) { const size_t wo = l == 0 ? WS_WIN0 : l == 1 ? WS_WIN1 : l == 2 ? WS_WIN2 : WS_WIN3;
                    g = pg8::Gemm{(const bf16*)(ws + WS_XB), (const bf16*)(ws + wo), DM, DM, DM}; S.nM = M / 256; S.nN = NP / 256;
                    E = pg8::EpiStore{(bf16*)(ws + WS_SCR + SC_P), NP, l == 0 ? (1u << 10) : l == 1 ? (1u << 11) : 0xFu, C2}; }
                else if (l == 0) { g = pg8::Gemm{(const bf16*)(ws + WS_MEMB), (const bf16*)(ws + WS_WMKV), DM, DM, DM}; S.nM = 4; S.nN = 8; E = pg8::EpiStore{(bf16*)(ws + WS_MKV), 2048, 0u, 1.f}; }
                else { g = pg8::Gemm{(const bf16*)(ws + WS_XB), (const bf16*)(ws + WS_WKV), DM, DM, DM}; S.nM = M / 256; S.nN = 6; E = pg8::EpiStore{(bf16*)(ws + WS_KV), 1536, 0u, 1.f}; }
                pg8::gemm_phase<pg8::EpiStore, Order>(F.lds + RING_OFF, g, S, E);
            }
            SEAM(pb);
        }
        if (IN(pb + 1)) {
            if (isA) ph_lora_in(F, l);
            else {
                ENTER(F); unsigned char* ws = F.ws;
                unsigned* ctr = (unsigned*)(ws + WS_CTL) + 64 * (8 + l);
                const bf16* KV = (const bf16*)(ws + WS_KV); const bf16* Pb = (const bf16*)(ws + WS_SCR + SC_P); bf16* MIX = (bf16*)(ws + WS_MIX);
                for (;;) {
                    if (F.tid == 0) MISC[16] = atomicAdd(ctr, 1u);
                    __syncthreads(); const int u = (int)MISC[16]; __syncthreads();
                    if (u >= NB * MIXH * 16) break;
                    const int qb = 15 - u / (NB * MIXH), bh = u % (NB * MIXH), b = bh / MIXH, h = bh % MIXH;
                    att::sb_unit(qb, Pb + (size_t)b * T * DM + h * 64, DM, KV + (size_t)b * T * 1536 + h * 64, KV + (size_t)b * T * 1536 + MIXW + h * 64, 1536, MIX + (size_t)b * T * DM + h * 64, DM, (att::lds_ptr)(F.lds + RING_OFF));
                }
            }
            { ENTER(F); unsigned char* ws = F.ws; const bf16* Pb = (const bf16*)(ws + WS_SCR + SC_P); bf16* MIX = (bf16*)(ws + WS_MIX);
              for (int u = blockIdx.x; u < NB * MEMH * 16; u += F.G) { const int b = u >> 6, hm = (u >> 4) & 3, blk = u & 15;
                const bf16* MKV = (const bf16*)(ws + WS_MKV) + (size_t)b * MEMT * 2048 + l * 512 + hm * 64; const size_t row0 = (size_t)b * T + blk * 256;
                att::mem_unit(Pb + row0 * NP + QM_OFF + hm * 64, NP, MKV, MKV + 256, 2048, MIX + row0 * DM + MIXW + hm * 64, DM, (att::lds_ptr)(F.lds + RING_OFF)); } }
            SEAM(pb + 1);
        }
        if (isA) {
            if (IN(pb + 2)) {
                ENTER(F); unsigned char* ws = F.ws;
                pg8::Gemm g{(const bf16*)(ws + WS_SCR + SC_U), (const bf16*)(ws + WS_WLORA + l * SZ_WLORA), 512, 512, 512};
                Order S; S.G = F.G; S.c = (int)blockIdx.x; S.tile_e = nullptr; S.nM = M / 256; S.nN = 12;
                const float* vec = inp(6) + (size_t)l * 6 * MIXW;
                pg8::EpiLora E{(float*)(ws + WS_SCR + SC_WDEC), (size_t)M * MIXW, vec, l == 1 ? inp(10) : nullptr};
                pg8::gemm_phase<pg8::EpiLora, Order>(F.lds + RING_OFF, g, S, E);
                SEAM(pb + 2);
            }
            if (IN(pb + 3)) { ph_finalize(F, l); SEAM(pb + 3); }
            if (IN(pb + 4)) { ph_scan(F); SEAM(pb + 4); }
            if (IN(pb + 5)) { ph_gn(F, l); SEAM(pb + 5); }
        }
        if (IN(pb + 6)) {
            ENTER(F); unsigned char* ws = F.ws;
            pg8::Gemm g{(const bf16*)(ws + WS_MIX), (const bf16*)(ws + WS_WO + l * SZ_WO), DM, DM, DM};
            Order S; S.G = F.G; S.c = (int)blockIdx.x; S.tile_e = nullptr; S.nM = M / 256; S.nN = 4;
            pg8::EpiResid E{l == 0 ? inp(0) : (const float*)(ws + WS_XF0), (float*)(ws + WS_PRE), DM, ALPHA};
            pg8::gemm_phase<pg8::EpiResid, Order>(F.lds + RING_OFF, g, S, E);
            SEAM(pb + 6);
        }
        if (IN(pb + 7)) { const float* ln = inp(17) + (size_t)l * 4 * DM; ph_ln(F, 0, ln, ln + DM, WS_XF1, WS_XB1, 0, moe ? 1 : 0, inp(20) + (size_t)(l >> 1) * DM * NE); SEAM(pb + 7); }
        if (moe && IN(pb + 8)) { ph_route2(F); SEAM(pb + 8); }
        if (IN(pb + 9)) {
            ENTER(F); unsigned char* ws = F.ws; const int* TILE = (const int*)(ws + WS_ROUTE + RO_TILE);
            pg8::Gemm g; Order S; S.G = F.G; S.c = (int)blockIdx.x; S.nN = 22;
            if (moe) { g = pg8::Gemm{(const bf16*)(ws + WS_SCR + SC_XG), (const bf16*)(ws + WS_WEGU + (size_t)(l >> 1) * 8 * SZ_WGU), DM, DM, DM}; S.tile_e = TILE; S.nM = __builtin_amdgcn_readfirstlane(ld_relaxed(TILE + 255)); }
            else { g = pg8::Gemm{(const bf16*)(ws + WS_XB1), (const bf16*)(ws + WS_WGU + (size_t)(l >> 1) * SZ_WGU), DM, DM, DM}; S.tile_e = nullptr; S.nM = M / 256; }
            pg8::EpiSwiglu E{(bf16*)(ws + WS_SCR + SC_H), FF};
            pg8::gemm_phase<pg8::EpiSwiglu, Order>(F.lds + RING_OFF, g, S, E);
            SEAM(pb + 9);
        }
        if (IN(pb + 10)) {
            ENTER(F); unsigned char* ws = F.ws; const int* TILE = (const int*)(ws + WS_ROUTE + RO_TILE);
            pg8::Gemm g; Order S; S.G = F.G; S.c = (int)blockIdx.x; S.nN = 4; pg8::EpiResid E;
            if (moe) { g = pg8::Gemm{(const bf16*)(ws + WS_SCR + SC_H), (const bf16*)(ws + WS_WEDN + (size_t)(l >> 1) * 8 * SZ_WDN), FF, FF, FF}; S.tile_e = TILE; S.nM = __builtin_amdgcn_readfirstlane(ld_relaxed(TILE + 255));
                E = pg8::EpiResid{nullptr, (float*)(ws + WS_SCR + SC_YE), DM, 0.f}; }
            else { g = pg8::Gemm{(const bf16*)(ws + WS_SCR + SC_H), (const bf16*)(ws + WS_WDN + (size_t)(l >> 1) * SZ_WDN), FF, FF, FF}; S.tile_e = nullptr; S.nM = M / 256; E = pg8::EpiResid{(const float*)(ws + WS_XF1), (float*)(ws + WS_PRE), DM, ALPHA}; }
            pg8::gemm_phase<pg8::EpiResid, Order>(F.lds + RING_OFF, g, S, E);
            SEAM(pb + 10);
        }
        if (IN(pb + 11)) { const float* ln = inp(17) + (size_t)l * 4 * DM; ph_ln(F, moe ? 1 : 0, ln + 2 * DM, ln + 3 * DM, WS_XF0, WS_XB, l == DEPTH - 1 ? 1 : 0, 0, nullptr); SEAM(pb + 11); }
    }
#undef IN
#undef SEAM
}

#ifndef MK_ONE_LAUNCH
#define MK_ONE_LAUNCH 1
#endif
extern "C" void kernel_launch(void* const* d_in, const int* in_sizes, int n_in, void* d_out, int out_size, void* d_ws, size_t ws_size, hipStream_t stream) {
    static int grid = 0;
    if (grid == 0) {
        if (n_in != 23 || in_sizes[0] != M * DM || out_size != M * DM || ws_size < WS_END) { fprintf(stderr, "kernel_launch: shape/workspace mismatch (n_in %d, ws %zu, need %zu)\n", n_in, ws_size, (size_t)WS_END); grid = -1; return; }
        int dev = 0, cus = 0, per_cu = 0;
        if (hipGetDevice(&dev) != hipSuccess || hipDeviceGetAttribute(&cus, hipDeviceAttributeMultiprocessorCount, dev) != hipSuccess) { grid = -1; return; }
        if (hipFuncSetAttribute((const void*)fwd, hipFuncAttributeMaxDynamicSharedMemorySize, LDS_BYTES) != hipSuccess) { fprintf(stderr, "kernel_launch: hipFuncSetAttribute failed\n"); grid = -1; return; }
        if (hipOccupancyMaxActiveBlocksPerMultiprocessor(&per_cu, (const void*)fwd, NWAVES * 64, LDS_BYTES) != hipSuccess || per_cu < 1) fprintf(stderr, "kernel_launch: occupancy query reports %d\n", per_cu);
        (void)hipGetLastError();
        grid = cus;
    }
    if (grid < 0) return;
    if (hipMemsetAsync((char*)d_ws + WS_CTL, 0, CTL_ZERO_BYTES, stream) != hipSuccess) return;
    Args a{};
    for (int i = 0; i < 23; ++i) a.in[i] = (const float*)d_in[i];
    a.out = (float*)d_out; a.ws = (unsigned char*)d_ws;
    if (MK_ONE_LAUNCH) { a.ph_lo = 0; a.ph_hi = NPHASE; hipLaunchKernelGGL(fwd, dim3(grid), dim3(NWAVES * 64), LDS_BYTES, stream, a); }
    else for (int ph = 0; ph < NPHASE; ++ph) { if (!phase_exists(ph)) continue; a.ph_lo = ph; a.ph_hi = ph + 1; hipLaunchKernelGGL(fwd, dim3(grid), dim3(NWAVES * 64), LDS_BYTES, stream, a); }
}
```

```cpp
#include <hip/hip_runtime.h>
#include <cstdio>
#include <cstdint>
#include <cmath>
#define MK_ONE_LAUNCH 1
#define PROBE_LIST -1
namespace pg8 {
#define PG8_LAS __attribute__((address_space(3)))
typedef unsigned short bf16_t;
typedef short bf16x8 __attribute__((ext_vector_type(8)));
typedef float f32x4 __attribute__((ext_vector_type(4)));
typedef float f32x2 __attribute__((ext_vector_type(2)));
typedef unsigned u32x4 __attribute__((ext_vector_type(4)));
typedef unsigned u32x2 __attribute__((ext_vector_type(2)));
constexpr int BM = 256, BK = 64, HALF = 128, HTB = HALF * BK * 2, STAGE_BYTES = 8 * HTB, NXCD = 8, WGM = 8;

__host__ __device__ __forceinline__ int lds_byte(int r, int c) { const int st = (r >> 4) * 2 + (c >> 5), rr = r & 15, cc = c & 31, ob = rr * 64 + cc * 2; return st * 1024 + (ob ^ (((ob >> 9) & 1) << 5)); }
__host__ __device__ __forceinline__ void stage_rc(int b, int& R, int& C) { const int st = b / 1024, sb = b % 1024, swz = sb ^ (((sb >> 9) & 1) << 5); R = (st >> 1) * 16 + swz / 64; C = (st & 1) * 32 + (swz % 64) / 2; }
__host__ __device__ __forceinline__ int perm32(int rho) { const int n = rho >> 4, i = rho & 15; return 8 * (i >> 2) + 4 * n + (i & 3); }

struct Unit { int pm, pn, bt; };
struct Gemm { const bf16_t* A; const bf16_t* Bt; int lda, ldb, K; };

__device__ __forceinline__ bool order_map(long L, int nM, int nN, int& pm, int& pn) {
    const int nwg = nM * nN; if (L >= nwg) return false;
    int wgid = (int)L; { const int q = nwg / NXCD, r = nwg % NXCD, xcd = wgid % NXCD, off = wgid / NXCD; wgid = (xcd < r ? xcd * (q + 1) : r * (q + 1) + (xcd - r) * q) + off; }
    const int nig = WGM * nN, gid = wgid / nig, fm = gid * WGM, gsz = (nM - fm) < WGM ? (nM - fm) : WGM;
    pm = fm + ((wgid % nig) % gsz); pn = (wgid % nig) / gsz; return true;
}
struct StaticOrder {
    int nM, nN, G, c;
    __device__ void init(int M, int N, int G_, int c_) { nM = M / BM; nN = N / BM; G = G_; c = c_; }
    __device__ __forceinline__ bool next(int i, Unit& u) const { if (!order_map((long)i * G + c, nM, nN, u.pm, u.pn)) return false; u.bt = u.pn; return true; }
};
struct MoeOrder {
    int nM, nN, G, c; const int* tile_e;
    __device__ __forceinline__ bool next(int i, Unit& u) const { if (!order_map((long)i * G + c, nM, nN, u.pm, u.pn)) return false;
        const int e = __builtin_amdgcn_readfirstlane(__hip_atomic_load(tile_e + u.pm, __ATOMIC_RELAXED, __HIP_MEMORY_SCOPE_AGENT)); u.bt = e * nN + u.pn; return true; }
};

__device__ __forceinline__ unsigned cvt_pk_bf16(float lo, float hi) { unsigned r; asm volatile("v_cvt_pk_bf16_f32 %0, %1, %2" : "=v"(r) : "v"(lo), "v"(hi)); return r; }

struct EpiStore {
    static constexpr bool PERM = true;
    bf16_t* O; int ldc; unsigned scale_mask; float scale;
    __device__ __forceinline__ void operator()(const f32x4 (&acc)[2][2][4][2], const Unit& u, int wr, int wc, int fr, int fq) const {
        const int row0 = u.pm * BM + wr * 64 + fr, col0 = u.pn * BM + wc * 32 + 8 * fq;
        const float sc = ((scale_mask >> u.pn) & 1u) ? scale : 1.f;
#pragma unroll
        for (int ai = 0; ai < 2; ++ai)
#pragma unroll
            for (int m = 0; m < 4; ++m) { bf16_t* rowp = O + (size_t)(row0 + ai * HALF + m * 16) * ldc + col0;
#pragma unroll
                for (int bj = 0; bj < 2; ++bj) { const f32x4 v0 = acc[ai][bj][m][0] * sc, v1 = acc[ai][bj][m][1] * sc;
                    u32x4 w; w.x = cvt_pk_bf16(v0[0], v0[1]); w.y = cvt_pk_bf16(v0[2], v0[3]); w.z = cvt_pk_bf16(v1[0], v1[1]); w.w = cvt_pk_bf16(v1[2], v1[3]);
                    *(u32x4*)(rowp + bj * HALF) = w; } }
    }
};
__device__ __forceinline__ float silu_mul(float g, float u) { return g * u * __builtin_amdgcn_rcpf(1.0f + __builtin_amdgcn_exp2f(-1.4426950408889634f * g)); }
struct EpiSwiglu {
    static constexpr bool PERM = true;
    bf16_t* H; int ldc;
    __device__ __forceinline__ void operator()(const f32x4 (&acc)[2][2][4][2], const Unit& u, int wr, int wc, int fr, int fq) const {
        const int row0 = u.pm * BM + wr * 64 + fr, col0 = u.pn * HALF + wc * 32 + 8 * fq;
#pragma unroll
        for (int ai = 0; ai < 2; ++ai)
#pragma unroll
            for (int m = 0; m < 4; ++m) { bf16_t* rowp = H + (size_t)(row0 + ai * HALF + m * 16) * ldc + col0;
                const f32x4 g0 = acc[ai][0][m][0], g1 = acc[ai][0][m][1], u0 = acc[ai][1][m][0], u1 = acc[ai][1][m][1];
                u32x4 w; w.x = cvt_pk_bf16(silu_mul(g0[0], u0[0]), silu_mul(g0[1], u0[1])); w.y = cvt_pk_bf16(silu_mul(g0[2], u0[2]), silu_mul(g0[3], u0[3]));
                w.z = cvt_pk_bf16(silu_mul(g1[0], u1[0]), silu_mul(g1[1], u1[1])); w.w = cvt_pk_bf16(silu_mul(g1[2], u1[2]), silu_mul(g1[3], u1[3]));
                *(u32x4*)rowp = w; }
    }
};
struct EpiResid {
    static constexpr bool PERM = false;
    const float* base; float* out; int ldc; float alpha;
    __device__ __forceinline__ void operator()(const f32x4 (&acc)[2][2][4][2], const Unit& u, int wr, int wc, int fr, int fq) const {
        const int row0 = u.pm * BM + wr * 64 + fr, col0 = u.pn * BM + wc * 32 + 4 * fq;
#pragma unroll
        for (int ai = 0; ai < 2; ++ai)
#pragma unroll
            for (int m = 0; m < 4; ++m) { const size_t off = (size_t)(row0 + ai * HALF + m * 16) * ldc + col0;
#pragma unroll
                for (int bj = 0; bj < 2; ++bj)
#pragma unroll
                    for (int n = 0; n < 2; ++n) { f32x4 o = acc[ai][bj][m][n];
                        if (base) { const f32x4 bs = *(const f32x4*)(base + off + bj * HALF + n * 16); o = o + bs * alpha; }
                        *(f32x4*)(out + off + bj * HALF + n * 16) = o; } }
    }
};
struct EpiLora {
    static constexpr bool PERM = false;
    float* out0; size_t off1, off2, off3; const float* vec; const float* v0;
    __device__ __forceinline__ void operator()(const f32x4 (&acc)[2][2][4][2], const Unit& u, int wr, int wc, int fr, int fq) const {
        const int blk = u.pn / 3, cb0 = (u.pn - 3 * blk) * BM + wc * 32 + 4 * fq, row0 = u.pm * BM + wr * 64 + fr;
        if (blk == 2 && v0 == nullptr) return;
        float* outp = out0 + (blk == 0 ? (size_t)0 : blk == 1 ? off1 : blk == 2 ? off2 : off3);
        const float* bias = blk == 2 ? v0 : vec + (blk & 1) * 768;
#pragma unroll
        for (int bj = 0; bj < 2; ++bj)
#pragma unroll
            for (int n = 0; n < 2; ++n) { const int cb = cb0 + bj * HALF + n * 16;
                f32x4 bv = (f32x4){0.f, 0.f, 0.f, 0.f}; if (blk < 3) bv = *(const f32x4*)(bias + cb);
#pragma unroll
                for (int ai = 0; ai < 2; ++ai)
#pragma unroll
                    for (int m = 0; m < 4; ++m) { f32x4 v = acc[ai][bj][m][n] + bv, o;
#pragma unroll
                        for (int j = 0; j < 4; ++j) { const float d = v[j]; float r;
                            if (blk == 0) { const float sp = fmaxf(-d, 0.f) + __logf(1.0f + __expf(-fabsf(d)));
                                r = -__expf(-sp - 0.5f); }
                            else if (blk == 3) r = d;
                            else r = 1.0f / (1.0f + __expf(-d));
                            o[j] = r; }
                        *(f32x4*)(outp + (size_t)(row0 + ai * HALF + m * 16) * 768 + cb) = o; } }
    }
};

template <class Epi, class Sched>
__device__ __forceinline__ void gemm_phase(PG8_LAS unsigned char* lds, const Gemm g, const Sched& S, const Epi& E) {
    int tid = threadIdx.x; asm volatile("" : "+v"(tid));
    const int wid = __builtin_amdgcn_readfirstlane(tid >> 6), lane = tid & 63, wr = wid >> 2, wc = wid & 3, fr = lane & 15, fq = lane >> 4;
    const int K = g.K, nt = K / BK;
    unsigned voffA[2], voffB[2];
#pragma unroll
    for (int i = 0; i < 2; ++i) { int R, C; stage_rc(tid * 16 + i * 8192, R, C); const int Rb = Epi::PERM ? ((R & ~31) + perm32(R & 31)) : R;
        voffA[i] = (unsigned)(R * g.lda + C) * 2u; voffB[i] = (unsigned)(Rb * g.ldb + C) * 2u; }
    const size_t kstep = (size_t)(BK * 2);
    const size_t hstepA = (size_t)HALF * g.lda * 2, hstepB = (size_t)HALF * g.ldb * 2;
    const size_t tstepA = 2 * hstepA, tstepB = 2 * hstepB;
    const unsigned ldsw = (unsigned)wid * 1024u;
    const int aoff = lds_byte(wr * 64 + fr, fq * 8), boff = lds_byte(wc * 32 + fr, fq * 8);
#define PG8_SA(b, h) (((b) * 2 + (h)) * HTB)
#define PG8_SB(b, h) ((4 + (b) * 2 + (h)) * HTB)
#define PG8_STAGE(bufoff, gbase, voff) do { _Pragma("unroll") for (int _i = 0; _i < 2; ++_i) \
        __builtin_amdgcn_global_load_lds((const unsigned*)((const char*)(gbase) + (voff)[_i]), (PG8_LAS unsigned*)(lds + (bufoff) + ldsw + _i * 8192), 16, 0, 0); } while (0)
#define PG8_LDA(dst, b, h) do { _Pragma("unroll") for (int m = 0; m < 4; ++m) _Pragma("unroll") for (int k = 0; k < 2; ++k) dst[m][k] = *(const PG8_LAS bf16x8*)(lds + PG8_SA(b, h) + aoff + m * 2048 + k * 1024); } while (0)
#define PG8_LDB(dst, b, h) do { _Pragma("unroll") for (int n = 0; n < 2; ++n) _Pragma("unroll") for (int k = 0; k < 2; ++k) dst[n][k] = *(const PG8_LAS bf16x8*)(lds + PG8_SB(b, h) + boff + n * 2048 + k * 1024); } while (0)
#define PG8_MMA(ai, bj, At, Bt) do { __builtin_amdgcn_s_setprio(1); _Pragma("unroll") for (int m = 0; m < 4; ++m) _Pragma("unroll") for (int n = 0; n < 2; ++n) _Pragma("unroll") for (int k = 0; k < 2; ++k) \
        acc[ai][bj][m][n] = __builtin_amdgcn_mfma_f32_16x16x32_bf16(Bt[n][k], At[m][k], acc[ai][bj][m][n], 0, 0, 0); __builtin_amdgcn_s_setprio(0); } while (0)
#define PG8_WAIT_V(n) asm volatile("s_waitcnt vmcnt(" #n ")" ::: "memory")
#define PG8_WAIT_L(n) asm volatile("s_waitcnt lgkmcnt(" #n ")" ::: "memory")
#define PG8_BAR __builtin_amdgcn_s_barrier()
#define PG8_SCHED __builtin_amdgcn_sched_barrier(0)
    Unit cur, nxt; int ui = 0;
    if (!S.next(0, cur)) return;
    f32x4 acc[2][2][4][2];
#pragma unroll
    for (int a = 0; a < 2; ++a)
#pragma unroll
        for (int b = 0; b < 2; ++b)
#pragma unroll
            for (int m = 0; m < 4; ++m)
#pragma unroll
                for (int n = 0; n < 2; ++n) acc[a][b][m][n] = (f32x4){0.f, 0.f, 0.f, 0.f};
    bf16x8 At[4][2], B0[2][2], B1[2][2];
    const char* cA = (const char*)g.A + (size_t)cur.pm * tstepA; const char* cB = (const char*)g.Bt + (size_t)cur.bt * tstepB;
    PG8_STAGE(PG8_SB(0, 0), cB, voffB); PG8_STAGE(PG8_SB(0, 1), cB + hstepB, voffB); PG8_STAGE(PG8_SA(0, 0), cA, voffA); PG8_STAGE(PG8_SA(0, 1), cA + hstepA, voffA);
    if (wr == 1) PG8_BAR;
    PG8_WAIT_V(2); PG8_BAR;
    PG8_STAGE(PG8_SB(1, 0), cB + kstep, voffB); PG8_STAGE(PG8_SA(1, 0), cA + kstep, voffA); PG8_STAGE(PG8_SB(1, 1), cB + hstepB + kstep, voffB);
    PG8_WAIT_V(6); PG8_BAR;
    for (;;) {
        const bool has_next = S.next(ui + 1, nxt);
        const char* nA = has_next ? (const char*)g.A + (size_t)nxt.pm * tstepA : cA; const char* nB = has_next ? (const char*)g.Bt + (size_t)nxt.bt * tstepB : cB;
        for (int t = 0; t < nt; t += 2) {
            const bool last = (t == nt - 2);
            const char* a1 = cA + (size_t)(t + 1) * kstep;
            const char* a2 = last ? nA : cA + (size_t)(t + 2) * kstep; const char* b2 = last ? nB : cB + (size_t)(t + 2) * kstep;
            const char* a3 = a2 + kstep; const char* b3 = b2 + kstep;
            PG8_LDB(B0, 0, 0); PG8_LDB(B1, 0, 1); PG8_SCHED; PG8_LDA(At, 0, 0); PG8_STAGE(PG8_SA(1, 1), a1 + hstepA, voffA);
            PG8_WAIT_V(8); PG8_WAIT_L(0); PG8_BAR; PG8_MMA(0, 0, At, B0); PG8_MMA(0, 1, At, B1); PG8_BAR; PG8_SCHED;
            PG8_LDA(At, 0, 1); PG8_STAGE(PG8_SB(0, 0), b2, voffB); PG8_STAGE(PG8_SB(0, 1), b2 + hstepB, voffB); PG8_STAGE(PG8_SA(0, 0), a2, voffA);
            PG8_WAIT_V(8); PG8_WAIT_L(0); PG8_BAR; PG8_MMA(1, 0, At, B0); PG8_MMA(1, 1, At, B1); PG8_BAR; PG8_SCHED;
            PG8_LDB(B0, 1, 0); PG8_LDB(B1, 1, 1); PG8_SCHED; PG8_LDA(At, 1, 0); PG8_STAGE(PG8_SA(0, 1), a2 + hstepA, voffA);
            PG8_WAIT_V(8); PG8_WAIT_L(0); PG8_BAR; PG8_MMA(0, 0, At, B0); PG8_MMA(0, 1, At, B1); PG8_BAR; PG8_SCHED;
            PG8_LDA(At, 1, 1); PG8_STAGE(PG8_SB(1, 0), b3, voffB); PG8_STAGE(PG8_SB(1, 1), b3 + hstepB, voffB); PG8_STAGE(PG8_SA(1, 0), a3, voffA);
            PG8_WAIT_V(8); PG8_WAIT_L(0); PG8_BAR; PG8_MMA(1, 0, At, B0); PG8_MMA(1, 1, At, B1); PG8_BAR; PG8_SCHED;
        }
        if (wr == 0) PG8_BAR;
        E(acc, cur, wr, wc, fr, fq);
        if (!has_next) break;
#pragma unroll
        for (int a = 0; a < 2; ++a)
#pragma unroll
            for (int b = 0; b < 2; ++b)
#pragma unroll
                for (int m = 0; m < 4; ++m)
#pragma unroll
                    for (int n = 0; n < 2; ++n) acc[a][b][m][n] = (f32x4){0.f, 0.f, 0.f, 0.f};
        cur = nxt; cA = nA; cB = nB; ++ui;
        if (wr == 1) PG8_BAR;
    }
    PG8_WAIT_V(0);
    PG8_BAR;
#undef PG8_SA
#undef PG8_SB
#undef PG8_STAGE
#undef PG8_LDA
#undef PG8_LDB
#undef PG8_MMA
#undef PG8_WAIT_V
#undef PG8_WAIT_L
#undef PG8_BAR
#undef PG8_SCHED
}
}
namespace att {
using bf16 = unsigned short;
using bf16x8 = __attribute__((ext_vector_type(8))) short;
using s16x4 = __attribute__((ext_vector_type(4))) short;
using f32x16 = __attribute__((ext_vector_type(16))) float;
using u32x4 = __attribute__((ext_vector_type(4))) unsigned;
typedef short v4i16_t __attribute__((ext_vector_type(4)));
typedef __attribute__((address_space(3))) const char* lds_cptr;
typedef __attribute__((address_space(3))) char* lds_ptr;
typedef float f32x2_t __attribute__((ext_vector_type(2))); typedef __bf16 bf16x2_t __attribute__((ext_vector_type(2)));
__device__ __forceinline__ int crow(int r, int hi) { return (r & 3) + 8 * (r >> 2) + 4 * hi; }
__device__ __forceinline__ unsigned cvtpk_s(float lo, float hi) { f32x2_t v = {lo, hi}; bf16x2_t b = __builtin_convertvector(v, bf16x2_t); return __builtin_bit_cast(unsigned, b); }
#define ATT_SBAR() __builtin_amdgcn_sched_barrier(0)
#define ATT_WAIT_BAR(N) asm volatile("s_waitcnt vmcnt(" #N ") lgkmcnt(0)\n\ts_barrier" ::: "memory")
constexpr int SLOTB = 8192;
__device__ __forceinline__ void glds16(const void* gsrc, unsigned lds_dst) { unsigned keep;
    asm volatile("s_mov_b32 %0, m0\n\ts_mov_b32 m0, %2\n\ts_nop 0\n\tglobal_load_lds_dwordx4 %1, off\n\ts_mov_b32 m0, %0" : "=&s"(keep) : "v"(gsrc), "s"(lds_dst) : "memory"); }
__device__ __forceinline__ void dma_k(const bf16* ktile, int pitch, unsigned slot_lds, int wid, int lane) {
    glds16(ktile + (long)lane * pitch + wid * 8, (unsigned)__builtin_amdgcn_readfirstlane(slot_lds + wid * 1024)); }
__device__ __forceinline__ void dma_v(const bf16* vtile, int pitch, unsigned slot_lds, int wid, int lane) {
    glds16(vtile + (long)(16 * (wid & 3) + (lane >> 2)) * pitch + (wid >> 2) * 32 + (lane & 3) * 8, (unsigned)__builtin_amdgcn_readfirstlane(slot_lds + wid * 1024)); }
__device__ __forceinline__ void qkt(f32x16& p0, f32x16& p1, lds_cptr Kslot, const bf16x8* qr, int r32, int hi) {
    lds_cptr kb = Kslot + hi * 1024 + r32 * 16;
    const f32x16 z = {};
#pragma unroll
    for (int d0 = 0; d0 < 4; ++d0) {
        const bf16x8 b0 = *(const __attribute__((address_space(3))) bf16x8*)(kb + d0 * 2048);
        const bf16x8 b1 = *(const __attribute__((address_space(3))) bf16x8*)(kb + d0 * 2048 + 512);
        if (d0 == 0) { p0 = __builtin_amdgcn_mfma_f32_32x32x16_bf16(b0, qr[0], z, 0, 0, 0); p1 = __builtin_amdgcn_mfma_f32_32x32x16_bf16(b1, qr[0], z, 0, 0, 0); }
        else { p0 = __builtin_amdgcn_mfma_f32_32x32x16_bf16(b0, qr[d0], p0, 0, 0, 0); p1 = __builtin_amdgcn_mfma_f32_32x32x16_bf16(b1, qr[d0], p1, 0, 0, 0); } }
}
__device__ __forceinline__ s16x4 vtr(lds_cptr p) { return __builtin_bit_cast(s16x4, __builtin_amdgcn_ds_read_tr16_b64_v4i16((__attribute__((address_space(3))) v4i16_t*)p)); }
__device__ __forceinline__ void pv(f32x16* o, lds_cptr vp, bf16x8 pa0, bf16x8 pa1, bf16x8 pa2, bf16x8 pa3) {
#pragma unroll
    for (int d0 = 0; d0 < 2; ++d0) { s16x4 lo[4], hi[4];
#pragma unroll
        for (int ks = 0; ks < 4; ++ks) { lo[ks] = vtr(vp + d0 * 4096 + ks * 1024); hi[ks] = vtr(vp + d0 * 4096 + ks * 1024 + 512); }
#define ATT_PK(k) (bf16x8){lo[k][0], lo[k][1], lo[k][2], lo[k][3], hi[k][0], hi[k][1], hi[k][2], hi[k][3]}
        o[d0] = __builtin_amdgcn_mfma_f32_32x32x16_bf16(pa0, ATT_PK(0), o[d0], 0, 0, 0);
        o[d0] = __builtin_amdgcn_mfma_f32_32x32x16_bf16(pa1, ATT_PK(1), o[d0], 0, 0, 0);
        o[d0] = __builtin_amdgcn_mfma_f32_32x32x16_bf16(pa2, ATT_PK(2), o[d0], 0, 0, 0);
        o[d0] = __builtin_amdgcn_mfma_f32_32x32x16_bf16(pa3, ATT_PK(3), o[d0], 0, 0, 0);
#undef ATT_PK
    }
}
__device__ __forceinline__ float swap_lo(float x, float& hi_out) { auto rr = __builtin_amdgcn_permlane32_swap(__float_as_uint(x), __float_as_uint(x), false, false); hi_out = __uint_as_float(rr[1]); return __uint_as_float(rr[0]); }
#define ATT_PKW(P, B) cvtpk_s(P[B], P[B + 1])
#define ATT_PACK4(P0, P1, w0, w1, w2, w3) do { w0 = (u32x4){ATT_PKW(P0, 0), ATT_PKW(P0, 2), ATT_PKW(P0, 4), ATT_PKW(P0, 6)}; w1 = (u32x4){ATT_PKW(P0, 8), ATT_PKW(P0, 10), ATT_PKW(P0, 12), ATT_PKW(P0, 14)}; \
    w2 = (u32x4){ATT_PKW(P1, 0), ATT_PKW(P1, 2), ATT_PKW(P1, 4), ATT_PKW(P1, 6)}; w3 = (u32x4){ATT_PKW(P1, 8), ATT_PKW(P1, 10), ATT_PKW(P1, 12), ATT_PKW(P1, 14)}; } while (0)
__device__ __forceinline__ void store_o(const f32x16* o, const float* rscale, lds_ptr stg, bf16* Ow, int pitch, int lane, int r32, int hi) {
    __attribute__((address_space(3))) bf16* s = (__attribute__((address_space(3))) bf16*)stg;
#pragma unroll
    for (int r = 0; r < 16; ++r) { const int orow = crow(r, hi);
#pragma unroll
        for (int d0 = 0; d0 < 2; ++d0) { const float v = o[d0][r] * rscale[r]; s[orow * 64 + d0 * 32 + r32] = (bf16)(cvtpk_s(v, v) & 0xffffu); } }
    asm volatile("s_waitcnt lgkmcnt(0)" ::: "memory");
#pragma unroll
    for (int i = 0; i < 4; ++i) { const int row = i * 8 + (lane >> 3), ch = lane & 7; const u32x4 v = *(const __attribute__((address_space(3))) u32x4*)(s + row * 64 + ch * 8); *(u32x4*)(Ow + (long)row * pitch + ch * 8) = v; }
}

constexpr int LDS_K = 0, LDS_V = 4 * SLOTB, LDS_WS = 8 * SLOTB, LDS_OST = LDS_WS + 8 * 256, ATT_LDS_BYTES = LDS_OST + 8 * 4096;

__device__ __forceinline__ void sb_unit(int qb, const bf16* Qh, int qp, const bf16* Kh, const bf16* Vh, int kp, bf16* Oh, int op, lds_ptr shm) {
    int tid = threadIdx.x; asm volatile("" : "+v"(tid)); const int lane = tid & 63, r32 = lane & 31, hi = lane >> 5; const int wid = __builtin_amdgcn_readfirstlane(tid >> 6);
    const unsigned lds0 = (unsigned)(size_t)shm;
    const int q0w = qb * 256 + wid * 32;
    const int NT = 4 * qb + 4;
    const lds_cptr kp0 = (lds_cptr)shm + LDS_K, vp0 = (lds_cptr)shm + LDS_V + ((lane >> 4) & 1) * 32 + (lane & 3) * 8 + (4 * hi + ((lane & 15) >> 2)) * 64;
    { const int t = NT - 1, s = t & 1; dma_k(Kh + (long)t * 64 * kp, kp, lds0 + LDS_K + s * SLOTB, wid, lane); dma_v(Vh + (long)t * 64 * kp, kp, lds0 + LDS_V + s * SLOTB, wid, lane); }
    bf16x8 qr[4];
#pragma unroll
    for (int d0 = 0; d0 < 4; ++d0) qr[d0] = *(const bf16x8*)(Qh + (long)(q0w + r32) * qp + d0 * 16 + hi * 8);
    f32x16 o[2]; o[0] = f32x16{}; o[1] = f32x16{};
    float carry = 1.0f;
    const int qabs = q0w + r32;
    for (int t = NT - 1; t >= 0; --t) {
        ATT_WAIT_BAR(0);
        if (t > 0) { const int s = (t - 1) & 1; dma_k(Kh + (long)(t - 1) * 64 * kp, kp, lds0 + LDS_K + s * SLOTB, wid, lane); dma_v(Vh + (long)(t - 1) * 64 * kp, kp, lds0 + LDS_V + s * SLOTB, wid, lane); }
        if (64 * t >= q0w + 31) continue;
        const int sl = (t & 1) * SLOTB;
        f32x16 p0, p1, x0, x1;
        qkt(p0, p1, kp0 + sl, qr, r32, hi);
        const bool need_mask = (64 * t + 63 >= q0w);
        const int kb = 64 * t + 4 * hi;
#pragma unroll
        for (int r = 0; r < 16; ++r) {
            const float z0 = fminf(p0[r], 100.f), z1 = fminf(p1[r], 100.f);
            const float e0 = __builtin_amdgcn_exp2f(z0), e1 = __builtin_amdgcn_exp2f(z1);
            float a0 = __builtin_amdgcn_rcpf(1.0f + e0), a1 = __builtin_amdgcn_rcpf(1.0f + e1);
            float b0 = e0 * a0, b1 = e1 * a1;
            if (need_mask) { const int kv = kb + (r & 3) + 8 * (r >> 2); if (kv >= qabs) { a0 = 1.f; b0 = 0.f; } if (kv + 32 >= qabs) { a1 = 1.f; b1 = 0.f; } }
            x0[r] = a0; x1[r] = a1; p0[r] = b0; p1[r] = b1; }
        float gp[8], lo[8], hv[8], T[8];
#pragma unroll
        for (int m = 0; m < 4; ++m) { gp[m] = (x0[4 * m] * x0[4 * m + 1]) * (x0[4 * m + 2] * x0[4 * m + 3]); gp[4 + m] = (x1[4 * m] * x1[4 * m + 1]) * (x1[4 * m + 2] * x1[4 * m + 3]); }
#pragma unroll
        for (int m = 0; m < 8; ++m) lo[m] = swap_lo(gp[m], hv[m]);
        T[7] = 1.0f;
#pragma unroll
        for (int m = 6; m >= 0; --m) T[m] = T[m + 1] * (lo[m + 1] * hv[m + 1]);
        const float total = T[0] * (lo[0] * hv[0]);
#pragma unroll
        for (int m = 0; m < 8; ++m) {
            float c = carry * T[m]; if (hi == 0) c *= hv[m];
            if (m < 4) { p0[4 * m + 3] *= c; c *= x0[4 * m + 3]; p0[4 * m + 2] *= c; c *= x0[4 * m + 2]; p0[4 * m + 1] *= c; c *= x0[4 * m + 1]; p0[4 * m] *= c; }
            else { const int q = m - 4; p1[4 * q + 3] *= c; c *= x1[4 * q + 3]; p1[4 * q + 2] *= c; c *= x1[4 * q + 2]; p1[4 * q + 1] *= c; c *= x1[4 * q + 1]; p1[4 * q] *= c; } }
        carry *= total;
        u32x4 w0, w1, w2, w3; ATT_PACK4(p0, p1, w0, w1, w2, w3);
        pv(o, vp0 + sl, __builtin_bit_cast(bf16x8, w0), __builtin_bit_cast(bf16x8, w1), __builtin_bit_cast(bf16x8, w2), __builtin_bit_cast(bf16x8, w3));
    }
    float one[16];
#pragma unroll
    for (int r = 0; r < 16; ++r) one[r] = 1.0f;
    store_o(o, one, shm + LDS_OST + wid * 4096, Oh + (long)q0w * op, op, lane, r32, hi);
    asm volatile("s_waitcnt lgkmcnt(0)\n\ts_barrier" ::: "memory");
}

__device__ __forceinline__ void mem_unit(const bf16* Qh, int qp, const bf16* Kh, const bf16* Vh, int kp, bf16* Oh, int op, lds_ptr shm) {
    int tid = threadIdx.x; asm volatile("" : "+v"(tid)); const int lane = tid & 63, r32 = lane & 31, hi = lane >> 5; const int wid = __builtin_amdgcn_readfirstlane(tid >> 6);
    const unsigned lds0 = (unsigned)(size_t)shm;
    const lds_cptr kp0 = (lds_cptr)shm + LDS_K, vp0 = (lds_cptr)shm + LDS_V + ((lane >> 4) & 1) * 32 + (lane & 3) * 8 + (4 * hi + ((lane & 15) >> 2)) * 64;
#pragma unroll
    for (int t = 0; t < 4; ++t) { dma_k(Kh + (long)t * 64 * kp, kp, lds0 + LDS_K + t * SLOTB, wid, lane); dma_v(Vh + (long)t * 64 * kp, kp, lds0 + LDS_V + t * SLOTB, wid, lane); }
    bf16x8 qr[4];
#pragma unroll
    for (int d0 = 0; d0 < 4; ++d0) qr[d0] = *(const bf16x8*)(Qh + (long)(wid * 32 + r32) * qp + d0 * 16 + hi * 8);
    ATT_WAIT_BAR(0);
    f32x16 p[8];
#pragma unroll
    for (int t = 0; t < 4; ++t) qkt(p[2 * t], p[2 * t + 1], kp0 + t * SLOTB, qr, r32, hi);
    float mx = -INFINITY;
#pragma unroll
    for (int t = 0; t < 8; ++t)
#pragma unroll
        for (int r = 0; r < 16; ++r) mx = fmaxf(mx, p[t][r]);
    { float h2; const float l2 = swap_lo(mx, h2); mx = fmaxf(l2, h2); }
    float sum = 0.f;
#pragma unroll
    for (int t = 0; t < 8; ++t)
#pragma unroll
        for (int r = 0; r < 16; ++r) { const float e = __builtin_amdgcn_exp2f(p[t][r] - mx); p[t][r] = e; sum += e; }
    { float h2; const float l2 = swap_lo(sum, h2); sum = l2 + h2; }
    f32x16 o[2]; o[0] = f32x16{}; o[1] = f32x16{};
#pragma unroll
    for (int t = 0; t < 4; ++t) { u32x4 w0, w1, w2, w3; ATT_PACK4(p[2 * t], p[2 * t + 1], w0, w1, w2, w3);
        pv(o, vp0 + t * SLOTB, __builtin_bit_cast(bf16x8, w0), __builtin_bit_cast(bf16x8, w1), __builtin_bit_cast(bf16x8, w2), __builtin_bit_cast(bf16x8, w3)); }
    __attribute__((address_space(3))) float* wsf = (__attribute__((address_space(3))) float*)(shm + LDS_WS) + wid * 64;
    if (hi == 0) wsf[r32] = sum;
    asm volatile("s_waitcnt lgkmcnt(0)" ::: "memory");
    float rli[16];
#pragma unroll
    for (int r = 0; r < 16; ++r) rli[r] = __builtin_amdgcn_rcpf(wsf[crow(r, hi)]);
    store_o(o, rli, shm + LDS_OST + wid * 4096, Oh + (long)(wid * 32) * op, op, lane, r32, hi);
    asm volatile("s_waitcnt lgkmcnt(0)\n\ts_barrier" ::: "memory");
}
}
constexpr int NWAVES = 8;
constexpr int DM = 1024, NB = 4, T = 4096, M = NB * T, DEPTH = 4, HD = 64, MIXH = 12, MIXW = 768, MEMH = 4, MEMW = 256, MEMT = 256;
constexpr int FF = 2816, NE = 8, NC0 = 2560, NC1 = 2592, NP0 = 2816, NP1 = 3072;
constexpr int MAXSLOT = 2 * M + NE * 256;
constexpr float LN_EPS = 1e-5f, GN_EPS = 64e-5f, ALPHA = 1.681792830507429f;
constexpr float C2 = 0.125f * 1.4426950408889634f;
typedef unsigned short bf16;

constexpr size_t al256(size_t x) { return (x + 255) & ~(size_t)255; }
constexpr size_t WS_CTL = 0, CTL_ZERO_BYTES = 1u << 20;
constexpr size_t SZ_WIN0 = (size_t)NP0 * DM * 2, SZ_WIN1 = (size_t)NP1 * DM * 2, SZ_WINB = (size_t)DM * DM * 2, SZ_WKV = (size_t)1536 * DM * 2, SZ_WMKV = (size_t)2048 * DM * 2, SZ_WO = (size_t)DM * DM * 2;
constexpr size_t SZ_WGU = (size_t)2 * FF * DM * 2, SZ_WDN = (size_t)DM * FF * 2, SZ_WLORA = (size_t)3072 * 512 * 2;
constexpr size_t WS_WIN0 = CTL_ZERO_BYTES, WS_WIN1 = WS_WIN0 + SZ_WIN0, WS_WIN2 = WS_WIN1 + SZ_WIN1, WS_WIN3 = WS_WIN2 + SZ_WINB, WS_WKV = WS_WIN3 + SZ_WINB, WS_WMKV = WS_WKV + SZ_WKV;
constexpr size_t WS_WO = WS_WMKV + SZ_WMKV, WS_WGU = WS_WO + 4 * SZ_WO, WS_WDN = WS_WGU + 2 * SZ_WGU, WS_WEGU = WS_WDN + 2 * SZ_WDN, WS_WEDN = WS_WEGU + 16 * SZ_WGU, WS_WLORA = WS_WEDN + 16 * SZ_WDN;
constexpr size_t WS_XB = WS_WLORA + 2 * SZ_WLORA, WS_XB1 = WS_XB + (size_t)M * DM * 2, WS_MEMB = WS_XB1 + (size_t)M * DM * 2, WS_MKV = WS_MEMB + (size_t)1024 * DM * 2;
constexpr size_t WS_XF0 = WS_MKV + (size_t)1024 * 2048 * 2, WS_XF1 = WS_XF0 + (size_t)M * DM * 4, WS_PRE = WS_XF1 + (size_t)M * DM * 4, WS_VFIRST = WS_PRE + (size_t)M * DM * 4;
constexpr size_t WS_MIX = WS_VFIRST + (size_t)M * MIXW * 4, WS_KV = WS_MIX + (size_t)M * DM * 2, WS_ROUTE = WS_KV + (size_t)M * 1536 * 2;
constexpr size_t RO_E = 0, RO_W = RO_E + (size_t)M * 4, RO_SLOT = RO_W + (size_t)M * 8, RO_CNTC = RO_SLOT + (size_t)M * 8, RO_TILE = RO_CNTC + 256 * 8 * 4, RO_END = RO_TILE + 256 * 4;
constexpr size_t WS_SCR = al256(WS_ROUTE + RO_END);
constexpr size_t SC_P = 0, SC_U = SC_P + (size_t)M * NP1 * 2, SC_VG = SC_U + (size_t)M * 512 * 2, SC_PUV_END = SC_VG + (size_t)M * MIXW * 4;
constexpr size_t CK_NUNIT = (size_t)NB * MIXH * (T / 64);
constexpr size_t SC_S2IN = 0, SC_S3IN = SC_S2IN + CK_NUNIT * 41216, SC_SU = SC_S3IN + CK_NUNIT * 24576, SC_CK_END = SC_SU + CK_NUNIT * 16384;
constexpr size_t SC_WDEC = al256(SC_PUV_END > SC_CK_END ? SC_PUV_END : SC_CK_END), SC_AI = SC_WDEC + (size_t)M * MIXW * 4, SC_G = SC_AI + (size_t)M * MIXW * 4;
constexpr size_t SC_R = SC_G + (size_t)M * MIXW * 4, SC_K2 = SC_R + (size_t)M * MIXW * 4, SC_V = SC_K2 + (size_t)M * MIXW * 4, SC_KK = SC_V + (size_t)M * MIXW * 4, SC_Y = SC_KK + (size_t)M * MIXW * 4, SC_SRK = SC_Y + (size_t)M * MIXW * 4, SC_MIXEND = SC_SRK + (size_t)M * MIXH * 4;
constexpr size_t SC_H = 0, SC_XG = SC_H + (size_t)MAXSLOT * FF * 2, SC_YE = SC_XG + (size_t)MAXSLOT * DM * 2, SC_FFNEND = SC_YE + (size_t)MAXSLOT * DM * 4;
constexpr size_t WS_END = WS_SCR + (SC_MIXEND > SC_FFNEND ? SC_MIXEND : SC_FFNEND);
constexpr int CW_BAR = 4096;
constexpr int RING_OFF = 0, RING_BYTES = 131072, LDSCTL_OFF = RING_BYTES, MISC_OFF = LDSCTL_OFF + 320, LDS_BYTES = 147456;

#define GAS __attribute__((address_space(1)))
#define LAS __attribute__((address_space(3)))
typedef unsigned v4u __attribute__((ext_vector_type(4)));
typedef float f32x4 __attribute__((ext_vector_type(4)));
typedef GAS unsigned gu32;
#define RLX_AGENT __ATOMIC_RELAXED, __HIP_MEMORY_SCOPE_AGENT
#define LDS_WAIT() asm volatile("s_waitcnt lgkmcnt(0)" ::: "memory")
__device__ __forceinline__ unsigned f2bf(float f) { unsigned u = __builtin_bit_cast(unsigned, f); return (u + 0x7fffu + ((u >> 16) & 1u)) >> 16; }
__device__ __forceinline__ unsigned pk2(float lo, float hi) { return f2bf(lo) | (f2bf(hi) << 16); }
__device__ __forceinline__ float bf2f(unsigned short b) { return __builtin_bit_cast(float, (unsigned)b << 16); }
__device__ __forceinline__ float bflo(unsigned w) { return __builtin_bit_cast(float, w << 16); }
__device__ __forceinline__ float bfhi(unsigned w) { return __builtin_bit_cast(float, w & 0xffff0000u); }
__device__ __forceinline__ int ld_relaxed(const int* p) { return __hip_atomic_load(p, __ATOMIC_RELAXED, __HIP_MEMORY_SCOPE_AGENT); }

#define XB_TMO      128
#define XB_XCNT(j)  (256  + 64 * (j))
#define XB_XSUB(j)  (1280 + 64 * (j))
#define XB_XGEN(j)  (2304 + 64 * (j))
#define XB_TOP      3328
#define XB_TOPGEN   3392
#define XCD_BAR_WORDS 3456
#define XB_SPIN_CAP (1u << 18)
__device__ __forceinline__ unsigned xb_ld(unsigned* p)              { return __hip_atomic_load(p, __ATOMIC_RELAXED, __HIP_MEMORY_SCOPE_AGENT); }
__device__ __forceinline__ unsigned xb_add(unsigned* p, unsigned v) { return __hip_atomic_fetch_add(p, v, __ATOMIC_RELAXED, __HIP_MEMORY_SCOPE_AGENT); }
__device__ __forceinline__ unsigned xb_xcc_id() { return (unsigned)__builtin_amdgcn_s_getreg((3 << 11) | 20) & 0xFu; }
#define XB_SPIN(cond, bar) do { unsigned _sp = 0; while (cond) { __builtin_amdgcn_s_sleep(1); \
    if ((++_sp & 255u) == 0u) { if (xb_ld(&(bar)[XB_TMO])) break; if (_sp > XB_SPIN_CAP) { atomicAdd(&(bar)[XB_TMO], 1u); break; } } } } while (0)
struct XcdBarrier { unsigned* bar; unsigned x; volatile LAS unsigned* st; };
__device__ __forceinline__ XcdBarrier xcd_barrier_post(unsigned* bar, volatile LAS unsigned* st) {
    XcdBarrier b; b.bar = bar; b.x = xb_xcc_id(); b.st = st;
    if (threadIdx.x == 0) (void)xb_add(&bar[XB_XCNT(b.x)], 1u);
    return b;
}
__device__ __forceinline__ void xcd_barrier_complete(unsigned* bar, unsigned x, unsigned& nloc, unsigned& nx) {
    const unsigned G = gridDim.x * gridDim.y * gridDim.z;
    unsigned sum, cnt, mine, sp = 0u;
    for (;;) {
        sum = 0u; cnt = 0u; mine = 0u;
#pragma unroll
        for (unsigned j = 0; j < 16; ++j) { const unsigned c = xb_ld(&bar[XB_XCNT(j)]); sum += c; cnt += (c > 0u) ? 1u : 0u; mine = (j == x) ? c : mine; }
        if (sum == G) break;
        __builtin_amdgcn_s_sleep(1);
        if ((++sp & 255u) == 0u) { if (xb_ld(&bar[XB_TMO])) break; if (sp > XB_SPIN_CAP) { atomicAdd(&bar[XB_TMO], 1u); break; } }
    }
    nloc = mine > 0u ? mine : 1u; nx = cnt > 0u ? cnt : 1u;
}
__device__ __forceinline__ void xcd_barrier(const XcdBarrier& b) {
    asm volatile("s_waitcnt vmcnt(0)" ::: "memory");
    __syncthreads();
    if (threadIdx.x == 0) {
        unsigned* bar = b.bar;
        __builtin_amdgcn_s_waitcnt(0);
        unsigned nloc = b.st[0], nx = b.st[1];
        if (nloc == 0u) { xcd_barrier_complete(bar, b.x, nloc, nx); b.st[0] = nloc; b.st[1] = nx; }
        const unsigned old = xb_add(&bar[XB_XSUB(b.x)], 1u);
        const unsigned gen = old / nloc;
        if (old + 1u == (gen + 1u) * nloc) {
            __builtin_amdgcn_fence(__ATOMIC_RELEASE, "agent");
            asm volatile("s_waitcnt vmcnt(0)" ::: "memory");
            const unsigned og = xb_add(&bar[XB_TOP], 1u);
            const unsigned tg = og / nx;
            if (og + 1u == (tg + 1u) * nx) xb_add(&bar[XB_TOPGEN], 1u);
            else XB_SPIN(xb_ld(&bar[XB_TOPGEN]) == tg, bar);
            __builtin_amdgcn_fence(__ATOMIC_ACQUIRE, "agent");
            xb_add(&bar[XB_XGEN(b.x)], 1u);
            asm volatile("s_waitcnt vmcnt(0)" ::: "memory");
        } else {
            XB_SPIN(xb_ld(&bar[XB_XGEN(b.x)]) == gen, bar);
            __builtin_amdgcn_fence(__ATOMIC_ACQUIRE, "agent");
            asm volatile("s_waitcnt vmcnt(0)" ::: "memory");
        }
    }
    __syncthreads();
}

struct Frame {
    LAS unsigned char* lds;
    unsigned char* ws;
    int tid, lane, wave, vcu, G;
};
typedef __attribute__((address_space(4))) const unsigned char* kptr_t;
__device__ __forceinline__ const float* inp(int k) { kptr_t ka = (kptr_t)__builtin_amdgcn_kernarg_segment_ptr(); asm volatile("" : "+s"(ka)); return *(const float* const __attribute__((address_space(4)))*)(ka + 8 * k); }
#define ENTER(F) do { int t_ = threadIdx.x; asm volatile("" : "+v"(t_)); (F).tid = t_; (F).lane = t_ & 63; (F).wave = __builtin_amdgcn_readfirstlane(t_ >> 6); unsigned char* w_ = (unsigned char*)inp(24); (F).ws = w_; } while (0)
__device__ __forceinline__ float wave_sum(float v) {
#pragma unroll
    for (int o = 1; o < 64; o <<= 1) v += __shfl_xor(v, o);
    return v;
}
template <int CTRL> __device__ __forceinline__ float dpp(float x) { return __builtin_bit_cast(float, __builtin_amdgcn_mov_dpp(__builtin_bit_cast(int, x), CTRL, 0xf, 0xf, true)); }
__device__ __forceinline__ float red16(float x) { x += dpp<0xB1>(x); x += dpp<0x4E>(x); x += dpp<0x141>(x); x += dpp<0x128>(x); return x; }
static_assert(WS_END <= 1476395008ull, "workspace map exceeds the guaranteed d_ws size");
static_assert(SC_CK_END <= SC_WDEC && SC_PUV_END <= SC_WDEC, "chunk records overlay only P | U | VG");
__device__ __forceinline__ void conv_item(const float* W, int K, int N, bf16* WT, int ldt, int drow0, LAS float* scr, int kb, int nb, int lane) {
    const int k0 = 64 * kb, n0 = 32 * nb;
#pragma unroll 8
    for (int i = 0; i < 32; ++i) { const int kk = 2 * i + (lane >> 5); scr[kk * 33 + (lane & 31)] = W[(size_t)(k0 + kk) * N + n0 + (lane & 31)]; }
    LDS_WAIT(); asm volatile("" ::: "memory");
    const int c = lane & 7;
#pragma unroll
    for (int j = 0; j < 4; ++j) { const int n = (lane >> 3) + 8 * j; const LAS float* s = scr + (8 * c) * 33 + n;
        v4u o; o.x = pk2(s[0 * 33], s[1 * 33]); o.y = pk2(s[2 * 33], s[3 * 33]); o.z = pk2(s[4 * 33], s[5 * 33]); o.w = pk2(s[6 * 33], s[7 * 33]);
        *(GAS v4u*)(WT + (size_t)(drow0 + n) * ldt + k0 + 8 * c) = o; }
    LDS_WAIT(); asm volatile("" ::: "memory");
}
__device__ __forceinline__ int swiglu_row(int n0) { const int up = n0 >= FF, h = up ? n0 - FF : n0; return 256 * (h >> 7) + (up ? 128 : 0) + (h & 127); }
__device__ __forceinline__ void conv_mat(const float* W, int K, int N, bf16* WT, int mode, int row_off, LAS float* scr, int r, int lane) {
    const int nblk = N / 32, kb = r / nblk, nb = r % nblk, n0 = 32 * nb;
    const int d0 = mode == 1 ? swiglu_row(n0) : mode == 2 ? (n0 < NC1 ? n0 : n0 - NC1 + NP0) : row_off + n0;
    conv_item(W, K, N, WT, K, d0, scr, kb, nb, lane);
}
__device__ __forceinline__ void p0_prologue(Frame& F) {
    ENTER(F);
    LAS float* scr = (LAS float*)(F.lds + RING_OFF + F.wave * 16384);
    const int gw = F.vcu * NWAVES + F.wave, NGW = F.G * NWAVES;
    unsigned char* ws = F.ws;
    constexpr int I_IN0 = 16 * (NP0 / 32), I_IN1 = 16 * (2848 / 32), I_SQ = 16 * 32, I_KV = 16 * 48, I_MKV = 16 * 16, I_GU = 16 * (2 * FF / 32), I_DN = (FF / 64) * 32;
    constexpr int NITEMS = I_IN0 + I_IN1 + 2 * I_SQ + I_KV + 4 * I_MKV + 4 * I_SQ + 2 * I_GU + 2 * I_DN + 16 * I_GU + 16 * I_DN;
    for (int it = gw; it < NITEMS; it += NGW) {
        int r = it;
        if (r < I_IN0) { conv_mat(inp(2), DM, NP0, (bf16*)(ws + WS_WIN0), 0, 0, scr, r, F.lane); continue; } r -= I_IN0;
        if (r < I_IN1) { conv_mat(inp(3), DM, 2848, (bf16*)(ws + WS_WIN1), 2, 0, scr, r, F.lane); continue; } r -= I_IN1;
        if (r < 2 * I_SQ) { const int j = r / I_SQ; conv_mat(inp(13) + (size_t)j * DM * DM, DM, DM, (bf16*)(ws + WS_WIN2 + j * SZ_WINB), 0, 0, scr, r % I_SQ, F.lane); continue; } r -= 2 * I_SQ;
        if (r < I_KV) { conv_mat(inp(14), DM, 1536, (bf16*)(ws + WS_WKV), 0, 0, scr, r, F.lane); continue; } r -= I_KV;
        if (r < 4 * I_MKV) { const int j = r / I_MKV; conv_mat(inp(15) + (size_t)j * DM * 512, DM, 512, (bf16*)(ws + WS_WMKV), 0, j * 512, scr, r % I_MKV, F.lane); continue; } r -= 4 * I_MKV;
        if (r < 4 * I_SQ) { const int j = r / I_SQ; conv_mat(inp(16) + (size_t)j * DM * DM, DM, DM, (bf16*)(ws + WS_WO + j * SZ_WO), 0, 0, scr, r % I_SQ, F.lane); continue; } r -= 4 * I_SQ;
        if (r < 2 * I_GU) { const int j = r / I_GU; conv_mat(inp(18) + (size_t)j * DM * 2 * FF, DM, 2 * FF, (bf16*)(ws + WS_WGU + j * SZ_WGU), 1, 0, scr, r % I_GU, F.lane); continue; } r -= 2 * I_GU;
        if (r < 2 * I_DN) { const int j = r / I_DN; conv_mat(inp(19) + (size_t)j * FF * DM, FF, DM, (bf16*)(ws + WS_WDN + j * SZ_WDN), 0, 0, scr, r % I_DN, F.lane); continue; } r -= 2 * I_DN;
        if (r < 16 * I_GU) { const int j = r / I_GU; conv_mat(inp(21) + (size_t)j * DM * 2 * FF, DM, 2 * FF, (bf16*)(ws + WS_WEGU + j * SZ_WGU), 1, 0, scr, r % I_GU, F.lane); continue; } r -= 16 * I_GU;
        { const int j = r / I_DN; conv_mat(inp(22) + (size_t)j * FF * DM, FF, DM, (bf16*)(ws + WS_WEDN + j * SZ_WDN), 0, 0, scr, r % I_DN, F.lane); }
    }
    const int gt = F.vcu * (NWAVES * 64) + F.tid, NGT = F.G * NWAVES * 64;
    { GAS v4u* z = (GAS v4u*)(ws + WS_WIN1 + (size_t)NC1 * DM * 2); const int n16 = (NP0 - NC1) * DM * 2 / 16; for (int i = gt; i < n16; i += NGT) z[i] = (v4u){0u, 0u, 0u, 0u}; }
    const float* wup = inp(7); const float* aup = inp(8); const float* gup = inp(9); const float* vup = inp(11);
    for (int i = gt; i < 2 * 3072 * 256; i += NGT) { const int l = i / (3072 * 256), rem = i % (3072 * 256), n = rem / 256, k = (rem % 256) * 2, blk = n / 768, c = n % 768;
        float v0 = 0.f, v1 = 0.f;
        if (blk == 0 && k < 64) { v0 = wup[((size_t)l * 64 + k) * 768 + c]; v1 = wup[((size_t)l * 64 + k + 1) * 768 + c]; }
        else if (blk == 1 && k >= 128 && k < 192) { v0 = aup[((size_t)l * 64 + k - 128) * 768 + c]; v1 = aup[((size_t)l * 64 + k - 127) * 768 + c]; }
        else if (blk == 2 && l == 1 && k >= 256 && k < 288) { v0 = vup[(size_t)(k - 256) * 768 + c]; v1 = vup[(size_t)(k - 255) * 768 + c]; }
        else if (blk == 3 && k >= 384) { v0 = gup[((size_t)l * 128 + k - 384) * 768 + c]; v1 = gup[((size_t)l * 128 + k - 383) * 768 + c]; }
        ((GAS unsigned*)(ws + WS_WLORA))[i] = pk2(v0, v1); }
    { const GAS f32x4* x4 = (const GAS f32x4*)inp(0); GAS v4u* o = (GAS v4u*)(ws + WS_XB);
      for (int i = gt; i < M * DM / 8; i += NGT) { const f32x4 a = x4[2 * i], b = x4[2 * i + 1]; o[i] = (v4u){pk2(a.x, a.y), pk2(a.z, a.w), pk2(b.x, b.y), pk2(b.z, b.w)}; } }
    { const GAS f32x4* x4 = (const GAS f32x4*)inp(1); GAS v4u* o = (GAS v4u*)(ws + WS_MEMB);
      for (int i = gt; i < 1024 * DM / 8; i += NGT) { const f32x4 a = x4[2 * i], b = x4[2 * i + 1]; o[i] = (v4u){pk2(a.x, a.y), pk2(a.z, a.w), pk2(b.x, b.y), pk2(b.z, b.w)}; } }
}

__device__ __forceinline__ float sigmoidf_(float x) { return 1.0f / (1.0f + __expf(-x)); }
__device__ __forceinline__ void ph_lora_in(Frame& F, int l) {
    ENTER(F);
    const int NP = l == 0 ? NP0 : NP1, GD0 = l == 0 ? 2432 : 2464;
    const bf16* P = (const bf16*)(F.ws + WS_SCR + SC_P); bf16* U = (bf16*)(F.ws + WS_SCR + SC_U);
    const float* mu = l == 0 ? inp(4) : inp(5);
    const int gw = F.vcu * NWAVES + F.wave, NGW = F.G * NWAVES;
    const int cu = 8 * F.lane, reg = cu >> 7, off = cu & 127;
    int src = -1, mode = 0;
    if (reg == 0 && off < 64) { src = 2304 + off; mode = 1; }
    else if (reg == 1 && off < 64) { src = 2368 + off; mode = 0; }
    else if (reg == 2 && l == 1 && off < 32) { src = 2432 + off; mode = 0; }
    else if (reg == 3) { src = GD0 + off; mode = 2; }
    for (int m = gw; m < M; m += NGW) {
        v4u o = (v4u){0u, 0u, 0u, 0u};
        if (src >= 0) {
            const v4u pc = *(const GAS v4u*)(P + (size_t)m * NP + src);
            v4u pp = (v4u){0u, 0u, 0u, 0u}; if ((m & (T - 1)) != 0) pp = *(const GAS v4u*)(P + (size_t)(m - 1) * NP + src);
            float v[8];
#pragma unroll
            for (int j = 0; j < 4; ++j) { const float c0 = bflo(pc[j]), c1 = bfhi(pc[j]), q0 = bflo(pp[j]), q1 = bfhi(pp[j]);
                v[2 * j] = c0 + mu[src + 2 * j] * (q0 - c0); v[2 * j + 1] = c1 + mu[src + 2 * j + 1] * (q1 - c1); }
#pragma unroll
            for (int j = 0; j < 8; ++j) { if (mode == 1) v[j] = tanhf(v[j]); else if (mode == 2) v[j] = sigmoidf_(v[j]); }
            o = (v4u){pk2(v[0], v[1]), pk2(v[2], v[3]), pk2(v[4], v[5]), pk2(v[6], v[7])};
        }
        *(GAS v4u*)(U + (size_t)m * 512 + cu) = o;
    }
}
__device__ __forceinline__ void ph_finalize(Frame& F, int l) {
    ENTER(F);
    const int NP = l == 0 ? NP0 : NP1;
    const bf16* P = (const bf16*)(F.ws + WS_SCR + SC_P);
    const float* mu = l == 0 ? inp(4) : inp(5);
    const float* vec = inp(6) + (size_t)l * 6 * MIXW; const float* k_k = vec + 2 * MIXW; const float* k_a = vec + 3 * MIXW; const float* r_k = inp(12) + (size_t)l * MIXW;
    const float* AI = (const float*)(F.ws + WS_SCR + SC_AI); const float* VG = (const float*)(F.ws + WS_SCR + SC_VG);
    float* R = (float*)(F.ws + WS_SCR + SC_R); float* K2 = (float*)(F.ws + WS_SCR + SC_K2); float* V = (float*)(F.ws + WS_SCR + SC_V); float* KK = (float*)(F.ws + WS_SCR + SC_KK);
    float* SRK = (float*)(F.ws + WS_SCR + SC_SRK); float* VF = (float*)(F.ws + WS_VFIRST);
    const int gw = F.vcu * NWAVES + F.wave, NGW = F.G * NWAVES;
    for (int m = gw; m < M; m += NGW) {
        const bool first = (m & (T - 1)) == 0;
        const bf16* pc = P + (size_t)m * NP; const bf16* pp = pc - NP;
        for (int h = 0; h < MIXH; ++h) { const int c = h * 64 + F.lane;
            float r = bf2f(pc[c]), k = bf2f(pc[768 + c]), v = bf2f(pc[1536 + c]);
            const float pr = first ? 0.f : bf2f(pp[c]), pk = first ? 0.f : bf2f(pp[768 + c]), pvv = first ? 0.f : bf2f(pp[1536 + c]);
            r += mu[c] * (pr - r); k += mu[768 + c] * (pk - k); v += mu[1536 + c] * (pvv - v);
            const float a = AI[(size_t)m * MIXW + c];
            float kk = k * k_k[c]; const float nrm = sqrtf(wave_sum(kk * kk)); kk = kk / fmaxf(nrm, 1e-12f);
            const float k2 = k * (1.0f + (a - 1.0f) * k_a[c]);
            if (l == 0) VF[(size_t)m * MIXW + c] = v; else { const float vf = VF[(size_t)m * MIXW + c]; v = v + (vf - v) * VG[(size_t)m * MIXW + c]; }
            const float s = wave_sum(r * k2 * r_k[c]);
            R[(size_t)m * MIXW + c] = r; K2[(size_t)m * MIXW + c] = k2; V[(size_t)m * MIXW + c] = v; KK[(size_t)m * MIXW + c] = kk;
            if (F.lane == 0) SRK[(size_t)m * MIXH + h] = s;
        }
    }
}
__device__ __forceinline__ void ph_gn(Frame& F, int l) {
    ENTER(F);
    const float* vec = inp(6) + (size_t)l * 6 * MIXW; const float* lg = vec + 4 * MIXW; const float* lb = vec + 5 * MIXW;
    const float* Y = (const float*)(F.ws + WS_SCR + SC_Y); const float* V = (const float*)(F.ws + WS_SCR + SC_V); const float* Gt = (const float*)(F.ws + WS_SCR + SC_G); const float* SRK = (const float*)(F.ws + WS_SCR + SC_SRK);
    bf16* MIX = (bf16*)(F.ws + WS_MIX);
    const int gw = F.vcu * NWAVES + F.wave, NGW = F.G * NWAVES;
    for (int m = gw; m < M; m += NGW)
        for (int h = 0; h < MIXH; ++h) { const int c = h * 64 + F.lane;
            const float y = Y[(size_t)m * MIXW + c]; const float mean = wave_sum(y) * (1.0f / 64.0f); const float d = y - mean; const float var = wave_sum(d * d) * (1.0f / 64.0f);
            float o = d * (1.0f / sqrtf(var + GN_EPS)) * lg[c] + lb[c];
            o += SRK[(size_t)m * MIXH + h] * V[(size_t)m * MIXW + c];
            o *= Gt[(size_t)m * MIXW + c];
            MIX[(size_t)m * DM + c] = (bf16)f2bf(o); }
}

__device__ __forceinline__ void ph_ln(Frame& F, int mode, const float* gain, const float* bias, size_t xf_off, size_t xb_off, int to_out, int route, const float* wr) {
    ENTER(F);
    float* XF = to_out ? (float*)inp(23) : (float*)(F.ws + xf_off); bf16* XB = (bf16*)(F.ws + xb_off);
    const float* PRE = (const float*)(F.ws + WS_PRE); const float* XF1 = (const float*)(F.ws + WS_XF1); const float* YE = (const float*)(F.ws + WS_SCR + SC_YE);
    const int* SLOT = (const int*)(F.ws + WS_ROUTE + RO_SLOT); const float* RW = (const float*)(F.ws + WS_ROUTE + RO_W);
    int* RT_E = (int*)(F.ws + WS_ROUTE + RO_E); float* RT_W = (float*)(F.ws + WS_ROUTE + RO_W); int* CNTC = (int*)(F.ws + WS_ROUTE + RO_CNTC);
    LAS int* cnt = (LAS int*)(F.lds + RING_OFF);
    f32x4 gv[4], bv[4];
#pragma unroll
    for (int j = 0; j < 4; ++j) { gv[j] = *(const f32x4*)(gain + 4 * F.lane + 256 * j); bv[j] = *(const f32x4*)(bias + 4 * F.lane + 256 * j); }
    for (int chunk = blockIdx.x; chunk < M / 64; chunk += F.G) {
        if (route) { if (F.tid < NE) cnt[F.tid] = 0; __syncthreads(); }
        for (int rr = 0; rr < 8; ++rr) { const int m = chunk * 64 + F.wave * 8 + rr;
            f32x4 v[4]; float s = 0.f;
            if (mode == 0) {
#pragma unroll
                for (int j = 0; j < 4; ++j) v[j] = *(const GAS f32x4*)(PRE + (size_t)m * DM + 4 * F.lane + 256 * j);
            } else {
                const int s1 = ld_relaxed(SLOT + 2 * m), s2 = ld_relaxed(SLOT + 2 * m + 1); const float w1 = __builtin_bit_cast(float, ld_relaxed((const int*)RW + 2 * m)), w2 = __builtin_bit_cast(float, ld_relaxed((const int*)RW + 2 * m + 1));
#pragma unroll
                for (int j = 0; j < 4; ++j) { const f32x4 x = *(const GAS f32x4*)(XF1 + (size_t)m * DM + 4 * F.lane + 256 * j), y1 = *(const GAS f32x4*)(YE + (size_t)s1 * DM + 4 * F.lane + 256 * j), y2 = *(const GAS f32x4*)(YE + (size_t)s2 * DM + 4 * F.lane + 256 * j);
                    v[j] = x * ALPHA + y1 * w1 + y2 * w2; }
            }
#pragma unroll
            for (int j = 0; j < 4; ++j) s += (v[j].x + v[j].y) + (v[j].z + v[j].w);
            const float mean = wave_sum(s) * (1.f / DM); float s2 = 0.f;
#pragma unroll
            for (int j = 0; j < 4; ++j) { v[j] = v[j] - mean; s2 += (v[j].x * v[j].x + v[j].y * v[j].y) + (v[j].z * v[j].z + v[j].w * v[j].w); }
            const float rstd = 1.f / sqrtf(wave_sum(s2) * (1.f / DM) + LN_EPS);
#pragma unroll
            for (int j = 0; j < 4; ++j) { v[j] = v[j] * rstd * gv[j] + bv[j];
                *(GAS f32x4*)(XF + (size_t)m * DM + 4 * F.lane + 256 * j) = v[j];
                *(GAS unsigned long long*)(XB + (size_t)m * DM + 4 * F.lane + 256 * j) = (unsigned long long)pk2(v[j].x, v[j].y) | ((unsigned long long)pk2(v[j].z, v[j].w) << 32); }
            if (route) {
                float lg[NE];
#pragma unroll
                for (int e = 0; e < NE; ++e) lg[e] = 0.f;
#pragma unroll
                for (int j = 0; j < 4; ++j)
#pragma unroll
                    for (int q = 0; q < 4; ++q) { const int c = 4 * F.lane + 256 * j + q; const f32x4 wa = *(const f32x4*)(wr + (size_t)c * NE), wb = *(const f32x4*)(wr + (size_t)c * NE + 4); const float xv = v[j][q];
                        lg[0] += xv * wa.x; lg[1] += xv * wa.y; lg[2] += xv * wa.z; lg[3] += xv * wa.w; lg[4] += xv * wb.x; lg[5] += xv * wb.y; lg[6] += xv * wb.z; lg[7] += xv * wb.w; }
#pragma unroll
                for (int e = 0; e < NE; ++e) lg[e] = wave_sum(lg[e]);
                int e1 = 0; float b1 = lg[0];
#pragma unroll
                for (int e = 1; e < NE; ++e) if (lg[e] > b1) { b1 = lg[e]; e1 = e; }
                int e2 = -1; float b2 = -INFINITY;
#pragma unroll
                for (int e = 0; e < NE; ++e) if (e != e1 && lg[e] > b2) { b2 = lg[e]; e2 = e; }
                const float w1 = 1.0f / (1.0f + __expf(b2 - b1));
                if (F.lane == 0) { RT_E[m] = e1 | (e2 << 8); RT_W[2 * m] = w1; RT_W[2 * m + 1] = 1.0f - w1; __hip_atomic_fetch_add(&cnt[e1], 1, __ATOMIC_RELAXED, __HIP_MEMORY_SCOPE_WORKGROUP); __hip_atomic_fetch_add(&cnt[e2], 1, __ATOMIC_RELAXED, __HIP_MEMORY_SCOPE_WORKGROUP); }
            }
        }
        if (route) { __syncthreads(); if (F.tid < NE) CNTC[chunk * NE + F.tid] = cnt[F.tid]; __syncthreads(); }
    }
}
__device__ __forceinline__ void ph_route2(Frame& F) {
    ENTER(F);
    const int* CNTC = (const int*)(F.ws + WS_ROUTE + RO_CNTC); const int* RT_E = (const int*)(F.ws + WS_ROUTE + RO_E); int* SLOT = (int*)(F.ws + WS_ROUTE + RO_SLOT); int* TILE = (int*)(F.ws + WS_ROUTE + RO_TILE);
    const bf16* XB1 = (const bf16*)(F.ws + WS_XB1); bf16* XG = (bf16*)(F.ws + WS_SCR + SC_XG);
    LAS int* sh = (LAS int*)(F.lds + RING_OFF);
    for (int chunk = blockIdx.x; chunk < M / 64; chunk += F.G) {
        { const int e = F.wave; int tot = 0, off = 0;
#pragma unroll
          for (int k = 0; k < 4; ++k) { const int c = F.lane + 64 * k; const int v = ld_relaxed(CNTC + c * NE + e); tot += v; off += (c < chunk) ? v : 0; }
          tot = (int)wave_sum((float)tot); off = (int)wave_sum((float)off);
          if (F.lane == 0) { sh[e] = tot; sh[8 + e] = off; } }
        __syncthreads();
        if (F.tid == 0) { int sb = 0; for (int e = 0; e < NE; ++e) { sh[16 + e] = sb; sb += (sh[e] + 255) & ~255; } sh[24] = sb; }
        __syncthreads();
        if (F.wave == 0) { const int m = chunk * 64 + F.lane; const int ee = ld_relaxed(RT_E + m); const int e1 = ee & 0xff, e2 = (ee >> 8) & 0xff;
            const unsigned long long below = (1ull << F.lane) - 1ull; int s1 = 0, s2 = 0;
#pragma unroll
            for (int e = 0; e < NE; ++e) { const unsigned long long m1 = __ballot(e1 == e), m2 = __ballot(e2 == e); const int prior = __popcll(m1 & below) + __popcll(m2 & below);
                const int base = sh[16 + e] + sh[8 + e] + prior; if (e1 == e) s1 = base; if (e2 == e) s2 = base; }
            SLOT[2 * m] = s1; SLOT[2 * m + 1] = s2; sh[32 + 2 * F.lane] = s1; sh[33 + 2 * F.lane] = s2; }
        __syncthreads();
        for (int a = F.wave; a < 128; a += NWAVES) { const int slot = sh[32 + a], m = chunk * 64 + (a >> 1);
            const GAS v4u* s = (const GAS v4u*)(XB1 + (size_t)m * DM); GAS v4u* d = (GAS v4u*)(XG + (size_t)slot * DM);
            d[F.lane] = s[F.lane]; d[64 + F.lane] = s[64 + F.lane]; }
        if (chunk == 0 && F.tid < 256) { const int nt = sh[24] >> 8; int e = 0; for (int q = 1; q < NE; ++q) if (F.tid * 256 >= sh[16 + q]) e = q; TILE[F.tid] = (F.tid == 255) ? nt : e; }
        __syncthreads();
    }
}
namespace ck {
typedef unsigned short bf16;
typedef short bf16x8 __attribute__((ext_vector_type(8)));
typedef float f32x4 __attribute__((ext_vector_type(4)));
typedef float f32x16 __attribute__((ext_vector_type(16)));
typedef unsigned u32x4 __attribute__((ext_vector_type(4)));
typedef unsigned u32x2 __attribute__((ext_vector_type(2)));
typedef LAS bf16* lmat;
constexpr int LD = 72, MATB = 64 * LD * 2;
constexpr int NCH = T / 64, NUNIT = NB * MIXH * NCH;
constexpr size_t S2_AT = 0, S2_MN = 8192, S2_BB = 16384, S2_HK = 24576, S2_HQ = 32768, S2_GC = 40960, S2_BYTES = 41216;
constexpr size_t S3_RT = 0, S3_ARB = 8192, S3_HY = 16384, S3_BYTES = 24576;
constexpr size_t SU_S0 = 0, SU_U = 8192, SU_BYTES = 16384;
__device__ __forceinline__ unsigned pk(float lo, float hi) { typedef float f2 __attribute__((ext_vector_type(2))); typedef __bf16 b2 __attribute__((ext_vector_type(2))); f2 v = {lo, hi}; b2 b = __builtin_convertvector(v, b2); return __builtin_bit_cast(unsigned, b); }
__device__ __forceinline__ int kperm(int p) { const int blk = p & ~15, h = (p >> 3) & 1, e = p & 7; return blk + 8 * (e >> 2) + 4 * h + (e & 3); }
__device__ __forceinline__ void mm(f32x4 (&acc)[2], lmat L, lmat R, int wave, int lane) {
    const int tm = wave >> 1, l15 = lane & 15, kq = lane >> 4;
#pragma unroll
    for (int kk = 0; kk < 2; ++kk) { const bf16x8 a = *(const LAS bf16x8*)(L + (16 * tm + l15) * LD + 32 * kk + 8 * kq);
#pragma unroll
        for (int q = 0; q < 2; ++q) { const bf16x8 b = *(const LAS bf16x8*)(R + (16 * (2 * (wave & 1) + q) + l15) * LD + 32 * kk + 8 * kq); acc[q] = __builtin_amdgcn_mfma_f32_16x16x32_bf16(a, b, acc[q], 0, 0, 0); } }
}
template <int MASK> __device__ __forceinline__ void maskacc(f32x4 (&acc)[2], int wave, int lane) {
    if (MASK == 0) return;
#pragma unroll
    for (int q = 0; q < 2; ++q) { const int n = 16 * (2 * (wave & 1) + q) + (lane & 15);
#pragma unroll
        for (int r = 0; r < 4; ++r) { const int m = 16 * (wave >> 1) + 4 * (lane >> 4) + r; const bool keep = MASK == 1 ? (n < m) : (n <= m); if (!keep) acc[q][r] = 0.f; } }
}
__device__ __forceinline__ void st_rm(lmat D, const f32x4 (&acc)[2], int wave, int lane) {
#pragma unroll
    for (int q = 0; q < 2; ++q) { const int n = 16 * (2 * (wave & 1) + q) + (lane & 15), m0 = 16 * (wave >> 1) + 4 * (lane >> 4);
#pragma unroll
        for (int r = 0; r < 4; ++r) D[(m0 + r) * LD + n] = (bf16)(pk(acc[q][r], 0.f) & 0xffffu); }
}
__device__ __forceinline__ void st_cm(lmat D, const f32x4 (&acc)[2], int wave, int lane) {
#pragma unroll
    for (int q = 0; q < 2; ++q) { const int n = 16 * (2 * (wave & 1) + q) + (lane & 15), m0 = 16 * (wave >> 1) + 4 * (lane >> 4);
        *(LAS u32x2*)(D + n * LD + m0) = (u32x2){pk(acc[q][0], acc[q][1]), pk(acc[q][2], acc[q][3])}; }
}
__device__ __forceinline__ void gst_cm(bf16* G, const f32x4 (&acc)[2], int wave, int lane) {
#pragma unroll
    for (int q = 0; q < 2; ++q) { const int n = 16 * (2 * (wave & 1) + q) + (lane & 15), m0 = 16 * (wave >> 1) + 4 * (lane >> 4);
        *(GAS u32x2*)(G + n * 64 + m0) = (u32x2){pk(acc[q][0], acc[q][1]), pk(acc[q][2], acc[q][3])}; }
}
template <bool PERM> __device__ __forceinline__ void copy_out(bf16* G, lmat Smat, int tid) {
    const int row = tid >> 3, p0 = (tid & 7) * 8;
    if (PERM) { unsigned short v[8];
#pragma unroll
        for (int e = 0; e < 8; ++e) v[e] = Smat[row * LD + kperm(p0 + e)];
        *(GAS u32x4*)(G + row * 64 + p0) = (u32x4){(unsigned)v[0] | ((unsigned)v[1] << 16), (unsigned)v[2] | ((unsigned)v[3] << 16), (unsigned)v[4] | ((unsigned)v[5] << 16), (unsigned)v[6] | ((unsigned)v[7] << 16)}; }
    else *(GAS u32x4*)(G + row * 64 + p0) = *(const LAS u32x4*)(Smat + row * LD + p0);
}
__device__ __forceinline__ void copy_in(lmat D, const bf16* G, int tid) { const int row = tid >> 3, p0 = (tid & 7) * 8; *(LAS u32x4*)(D + row * LD + p0) = *(const GAS u32x4*)(G + row * 64 + p0); }

__device__ __forceinline__ void ph_s1(Frame& F) {
    ENTER(F);
    const float* pKK = (const float*)(F.ws + WS_SCR + SC_KK); const float* pAI = (const float*)(F.ws + WS_SCR + SC_AI); const float* pLW = (const float*)(F.ws + WS_SCR + SC_WDEC);
    const float* pK2 = (const float*)(F.ws + WS_SCR + SC_K2); const float* pR = (const float*)(F.ws + WS_SCR + SC_R); const float* pV = (const float*)(F.ws + WS_SCR + SC_V);
    unsigned char* s2in = F.ws + WS_SCR + SC_S2IN; unsigned char* s3in = F.ws + WS_SCR + SC_S3IN;
    LAS unsigned char* base = F.lds + RING_OFF;
#define CKB(k) ((lmat)(base + (k) * MATB))
    lmat At = CKB(0), Rt = CKB(1), Bh = CKB(2), Kh = CKB(3), VC = CKB(4), KbC = CKB(5), PXr = CKB(6), PXc = CKB(7), AkT = CKB(8), ArkT = CKB(9), ArbT = CKB(10), PYr = CKB(0), PYc = CKB(1), MA = CKB(2), MB = CKB(3);
    LAS float* seg = (LAS float*)(base + 11 * MATB);
    const int j = F.tid & 63, sg = F.wave;
    for (int u = blockIdx.x; u < NUNIT; u += F.G) {
        const int c = u & (NCH - 1), bh = u >> 6, b = bh / MIXH, h = bh % MIXH;
        const size_t g0 = ((size_t)b * T + c * 64 + 8 * sg) * MIXW + h * 64 + j;
        unsigned char* o2 = s2in + (size_t)u * S2_BYTES; unsigned char* o3 = s3in + (size_t)u * S3_BYTES;
        float lw[8], kk[8], ai[8], k2[8], rr[8], vv[8];
#pragma unroll
        for (int q = 0; q < 8; ++q) { const size_t o = g0 + (size_t)q * MIXW; lw[q] = pLW[o]; kk[q] = pKK[o]; ai[q] = pAI[o]; k2[q] = pK2[o]; rr[q] = pR[o]; vv[q] = pV[o]; }
        float pl[8]; { float a = 0.f;
#pragma unroll
            for (int q = 0; q < 8; ++q) { a += lw[q]; pl[q] = a; } }
        seg[sg * 64 + j] = pl[7];
        __syncthreads();
        float off = 0.f, LC = 0.f;
#pragma unroll
        for (int s = 0; s < 8; ++s) { const float x = seg[s * 64 + j]; LC += x; off += (s < sg) ? x : 0.f; }
        unsigned short at[8], rt[8], bhh[8], khh[8], vb[8], kb[8], bbv[8];
#pragma unroll
        for (int q = 0; q < 8; ++q) { const float L = off + pl[q], Lm1 = L - lw[q]; const float en = __expf(-L), ec = __expf(LC - L), kb_ = kk[q] * ai[q];
            at[q] = (unsigned short)(pk(-kk[q] * __expf(Lm1), 0.f) & 0xffffu); rt[q] = (unsigned short)(pk(rr[q] * __expf(L), 0.f) & 0xffffu);
            bhh[q] = (unsigned short)(pk(kb_ * en, 0.f) & 0xffffu); khh[q] = (unsigned short)(pk(k2[q] * en, 0.f) & 0xffffu);
            bbv[q] = (unsigned short)(pk(kb_ * ec, 0.f) & 0xffffu); kb[q] = (unsigned short)(pk(k2[q] * ec, 0.f) & 0xffffu); vb[q] = (unsigned short)(pk(vv[q], 0.f) & 0xffffu); }
#pragma unroll
        for (int q = 0; q < 8; ++q) { const int t = 8 * sg + q; At[t * LD + j] = at[q]; Rt[t * LD + j] = rt[q]; Bh[t * LD + j] = bhh[q]; Kh[t * LD + j] = khh[q]; }
        *(LAS u32x4*)(VC + j * LD + 8 * sg) = (u32x4){(unsigned)vb[0] | ((unsigned)vb[1] << 16), (unsigned)vb[2] | ((unsigned)vb[3] << 16), (unsigned)vb[4] | ((unsigned)vb[5] << 16), (unsigned)vb[6] | ((unsigned)vb[7] << 16)};
        *(LAS u32x4*)(KbC + j * LD + 8 * sg) = (u32x4){(unsigned)kb[0] | ((unsigned)kb[1] << 16), (unsigned)kb[2] | ((unsigned)kb[3] << 16), (unsigned)kb[4] | ((unsigned)kb[5] << 16), (unsigned)kb[6] | ((unsigned)kb[7] << 16)};
        {
            bf16* gb = (bf16*)(o2 + S2_BB) + j * 64 + 16 * (sg >> 1) + 4 * (sg & 1);
            *(GAS u32x2*)(gb) = (u32x2){(unsigned)bbv[0] | ((unsigned)bbv[1] << 16), (unsigned)bbv[2] | ((unsigned)bbv[3] << 16)};
            *(GAS u32x2*)(gb + 8) = (u32x2){(unsigned)bbv[4] | ((unsigned)bbv[5] << 16), (unsigned)bbv[6] | ((unsigned)bbv[7] << 16)}; }
        if (sg == 0) ((float*)(o2 + S2_GC))[j] = __expf(LC);
        __syncthreads();
        copy_out<true>((bf16*)(o2 + S2_AT), At, F.tid);
        copy_out<false>((bf16*)(o3 + S3_RT), Rt, F.tid);
        f32x4 mn[2];
        { f32x4 a[2] = {{0.f, 0.f, 0.f, 0.f}, {0.f, 0.f, 0.f, 0.f}}; mm(a, At, Bh, F.wave, F.lane); maskacc<1>(a, F.wave, F.lane); st_rm(PXr, a, F.wave, F.lane); st_cm(PXc, a, F.wave, F.lane); mn[0] = a[0]; mn[1] = a[1]; }
        { f32x4 a[2] = {{0.f, 0.f, 0.f, 0.f}, {0.f, 0.f, 0.f, 0.f}}; mm(a, At, Kh, F.wave, F.lane); maskacc<1>(a, F.wave, F.lane); st_rm(AkT, a, F.wave, F.lane); }
        { f32x4 a[2] = {{0.f, 0.f, 0.f, 0.f}, {0.f, 0.f, 0.f, 0.f}}; mm(a, Rt, Kh, F.wave, F.lane); maskacc<2>(a, F.wave, F.lane); st_rm(ArkT, a, F.wave, F.lane); }
        { f32x4 a[2] = {{0.f, 0.f, 0.f, 0.f}, {0.f, 0.f, 0.f, 0.f}}; mm(a, Rt, Bh, F.wave, F.lane); maskacc<2>(a, F.wave, F.lane); st_rm(ArbT, a, F.wave, F.lane); }
        __syncthreads();
        copy_out<false>((bf16*)(o3 + S3_ARB), ArbT, F.tid);
        { f32x4 a[2] = {{0.f, 0.f, 0.f, 0.f}, {0.f, 0.f, 0.f, 0.f}}; mm(a, AkT, VC, F.wave, F.lane); gst_cm((bf16*)(o2 + S2_HK), a, F.wave, F.lane); }
        { f32x4 a[2] = {{0.f, 0.f, 0.f, 0.f}, {0.f, 0.f, 0.f, 0.f}}; mm(a, ArkT, VC, F.wave, F.lane); gst_cm((bf16*)(o3 + S3_HY), a, F.wave, F.lane); }
        { f32x4 a[2] = {{0.f, 0.f, 0.f, 0.f}, {0.f, 0.f, 0.f, 0.f}}; mm(a, KbC, VC, F.wave, F.lane); gst_cm((bf16*)(o2 + S2_HQ), a, F.wave, F.lane); }
        lmat Pr_old = PXr, Pc_old = PXc, Pr_new = PYr, Pc_new = PYc, M_old = PXr, M_new = MA;
#pragma unroll
        for (int it = 1; it <= 5; ++it) {
            f32x4 p[2] = {{0.f, 0.f, 0.f, 0.f}, {0.f, 0.f, 0.f, 0.f}}; mm(p, Pr_old, Pc_old, F.wave, F.lane);
            st_rm(Pr_new, p, F.wave, F.lane); st_cm(Pc_new, p, F.wave, F.lane);
            __syncthreads();
            f32x4 a[2] = {mn[0] + p[0], mn[1] + p[1]}; mm(a, M_old, Pc_new, F.wave, F.lane); mn[0] = a[0]; mn[1] = a[1];
            st_rm(M_new, a, F.wave, F.lane);
            __syncthreads();
            { lmat t1 = Pr_old; Pr_old = Pr_new; Pr_new = t1; t1 = Pc_old; Pc_old = Pc_new; Pc_new = t1; }
            M_old = M_new; M_new = (M_new == MA) ? MB : MA;
        }
        copy_out<true>((bf16*)(o2 + S2_MN), M_old, F.tid);
        __syncthreads();
    }
#undef CKB
}

__device__ __forceinline__ bf16x8 pack8(const f32x16& x, int s) { const u32x4 w = (u32x4){pk(x[8 * s], x[8 * s + 1]), pk(x[8 * s + 2], x[8 * s + 3]), pk(x[8 * s + 4], x[8 * s + 5]), pk(x[8 * s + 6], x[8 * s + 7])}; return __builtin_bit_cast(bf16x8, w); }
__device__ __forceinline__ void ph_s2(Frame& F) {
    ENTER(F);
    const unsigned char* s2in = F.ws + WS_SCR + SC_S2IN; unsigned char* su = F.ws + WS_SCR + SC_SU;
    LAS unsigned char* base = F.lds + RING_OFF;
    constexpr int BUFB = 5 * MATB + 256;
    const int r32 = F.lane & 31, hi = F.lane >> 5;
    for (int bh = blockIdx.x; bh < NB * MIXH; bh += F.G) {
        f32x16 st[2]; st[0] = f32x16{}; st[1] = f32x16{};
        const int lt = F.tid - 128;
        u32x4 stg[7];
#define S2_LOAD(cc) do { const unsigned char* g_ = s2in + (size_t)(bh * NCH + (cc)) * S2_BYTES; _Pragma("unroll") for (int k_ = 0; k_ < 7; ++k_) { const int idx_ = lt + 384 * k_; if (idx_ < 5 * 512 + 16) stg[k_] = *(const GAS u32x4*)(g_ + (size_t)idx_ * 16); } } while (0)
#define S2_WRITE(cc) do { LAS unsigned char* d_ = base + ((cc) & 1) * BUFB; _Pragma("unroll") for (int k_ = 0; k_ < 7; ++k_) { const int idx_ = lt + 384 * k_; \
            if (idx_ < 5 * 512) { const int mtx_ = idx_ >> 9, rem_ = idx_ & 511; *(LAS u32x4*)(d_ + mtx_ * MATB + (rem_ >> 3) * (LD * 2) + (rem_ & 7) * 16) = stg[k_]; } \
            else if (idx_ < 5 * 512 + 16) *(LAS u32x4*)(d_ + 5 * MATB + (idx_ - 5 * 512) * 16) = stg[k_]; } } while (0)
        if (F.wave >= 2) S2_LOAD(0);
        for (int c = -1; c < NCH; ++c) {
            if (F.wave >= 2) { if (c + 1 < NCH) S2_WRITE(c + 1); if (c + 2 < NCH) S2_LOAD(c + 2); }
            if (F.wave < 2 && c >= 0) {
                const LAS unsigned char* d = base + (c & 1) * BUFB; const int ih = F.wave; const int icol = 32 * ih + r32;
                const lmat AtP = (lmat)d, MnP = (lmat)(d + MATB), BbP = (lmat)(d + 2 * MATB), HkT = (lmat)(d + 3 * MATB), HqT = (lmat)(d + 4 * MATB); const LAS float* gC = (const LAS float*)(d + 5 * MATB);
                unsigned char* so = su + (size_t)(bh * NCH + c) * SU_BYTES;
#pragma unroll
                for (int jt = 0; jt < 2; ++jt)
#pragma unroll
                    for (int g4 = 0; g4 < 4; ++g4) *(GAS u32x2*)((bf16*)(so + SU_S0) + icol * 64 + 32 * jt + 8 * g4 + 4 * hi) = (u32x2){pk(st[jt][4 * g4], st[jt][4 * g4 + 1]), pk(st[jt][4 * g4 + 2], st[jt][4 * g4 + 3])};
                bf16x8 bs[4];
#pragma unroll
                for (int ks = 0; ks < 4; ++ks) bs[ks] = pack8(st[ks >> 1], ks & 1);
                f32x16 rh[2];
#pragma unroll
                for (int mt = 0; mt < 2; ++mt)
#pragma unroll
                    for (int g4 = 0; g4 < 4; ++g4) { const u32x2 w = *(const LAS u32x2*)(HkT + icol * LD + 32 * mt + 8 * g4 + 4 * hi); rh[mt][4 * g4] = bflo(w.x); rh[mt][4 * g4 + 1] = bfhi(w.x); rh[mt][4 * g4 + 2] = bflo(w.y); rh[mt][4 * g4 + 3] = bfhi(w.y); }
#pragma unroll
                for (int mt = 0; mt < 2; ++mt)
#pragma unroll
                    for (int ks = 0; ks < 4; ++ks) rh[mt] = __builtin_amdgcn_mfma_f32_32x32x16_bf16(*(const LAS bf16x8*)(AtP + (32 * mt + r32) * LD + 16 * ks + 8 * hi), bs[ks], rh[mt], 0, 0, 0);
                bf16x8 br[4];
#pragma unroll
                for (int ks = 0; ks < 4; ++ks) br[ks] = pack8(rh[ks >> 1], ks & 1);
                f32x16 uu[2]; uu[0] = rh[0]; uu[1] = rh[1];
#pragma unroll
                for (int mt = 0; mt < 2; ++mt)
#pragma unroll
                    for (int ks = 0; ks < 4; ++ks) uu[mt] = __builtin_amdgcn_mfma_f32_32x32x16_bf16(*(const LAS bf16x8*)(MnP + (32 * mt + r32) * LD + 16 * ks + 8 * hi), br[ks], uu[mt], 0, 0, 0);
#pragma unroll
                for (int mt = 0; mt < 2; ++mt)
#pragma unroll
                    for (int g4 = 0; g4 < 4; ++g4) *(GAS u32x2*)((bf16*)(so + SU_U) + icol * 64 + 32 * mt + 8 * g4 + 4 * hi) = (u32x2){pk(uu[mt][4 * g4], uu[mt][4 * g4 + 1]), pk(uu[mt][4 * g4 + 2], uu[mt][4 * g4 + 3])};
                bf16x8 bu[4];
#pragma unroll
                for (int ks = 0; ks < 4; ++ks) bu[ks] = pack8(uu[ks >> 1], ks & 1);
#pragma unroll
                for (int jt = 0; jt < 2; ++jt)
#pragma unroll
                    for (int g4 = 0; g4 < 4; ++g4) { const u32x2 w = *(const LAS u32x2*)(HqT + icol * LD + 32 * jt + 8 * g4 + 4 * hi); const f32x4 gc = *(const LAS f32x4*)(gC + 32 * jt + 8 * g4 + 4 * hi);
                        st[jt][4 * g4] = st[jt][4 * g4] * gc.x + bflo(w.x); st[jt][4 * g4 + 1] = st[jt][4 * g4 + 1] * gc.y + bfhi(w.x); st[jt][4 * g4 + 2] = st[jt][4 * g4 + 2] * gc.z + bflo(w.y); st[jt][4 * g4 + 3] = st[jt][4 * g4 + 3] * gc.w + bfhi(w.y); }
#pragma unroll
                for (int jt = 0; jt < 2; ++jt)
#pragma unroll
                    for (int ks = 0; ks < 4; ++ks) st[jt] = __builtin_amdgcn_mfma_f32_32x32x16_bf16(*(const LAS bf16x8*)(BbP + (32 * jt + r32) * LD + 16 * ks + 8 * hi), bu[ks], st[jt], 0, 0, 0);
            }
            __syncthreads();
        }
#undef S2_LOAD
#undef S2_WRITE
    }
}
__device__ __forceinline__ void ph_s3(Frame& F) {
    ENTER(F);
    const unsigned char* s3in = F.ws + WS_SCR + SC_S3IN; const unsigned char* su = F.ws + WS_SCR + SC_SU; float* Y = (float*)(F.ws + WS_SCR + SC_Y);
    LAS unsigned char* base = F.lds + RING_OFF;
    lmat Rt = (lmat)base, S0 = (lmat)(base + MATB), Arb = (lmat)(base + 2 * MATB), Ub = (lmat)(base + 3 * MATB), HyT = (lmat)(base + 4 * MATB);
    for (int u = blockIdx.x; u < NUNIT; u += F.G) {
        const int c = u & (NCH - 1), bh = u >> 6, b = bh / MIXH, h = bh % MIXH;
        const unsigned char* g3 = s3in + (size_t)u * S3_BYTES; const unsigned char* gu = su + (size_t)u * SU_BYTES;
        copy_in(Rt, (const bf16*)(g3 + S3_RT), F.tid); copy_in(Arb, (const bf16*)(g3 + S3_ARB), F.tid); copy_in(HyT, (const bf16*)(g3 + S3_HY), F.tid);
        copy_in(S0, (const bf16*)(gu + SU_S0), F.tid); copy_in(Ub, (const bf16*)(gu + SU_U), F.tid);
        __syncthreads();
        f32x4 a[2];
#pragma unroll
        for (int q = 0; q < 2; ++q) { const int n = 16 * (2 * (F.wave & 1) + q) + (F.lane & 15), m0 = 16 * (F.wave >> 1) + 4 * (F.lane >> 4); const u32x2 w = *(const LAS u32x2*)(HyT + n * LD + m0); a[q] = (f32x4){bflo(w.x), bfhi(w.x), bflo(w.y), bfhi(w.y)}; }
        mm(a, Rt, S0, F.wave, F.lane); mm(a, Arb, Ub, F.wave, F.lane);
        const size_t y0 = ((size_t)b * T + c * 64) * MIXW + h * 64;
#pragma unroll
        for (int q = 0; q < 2; ++q) { const int n = 16 * (2 * (F.wave & 1) + q) + (F.lane & 15), m0 = 16 * (F.wave >> 1) + 4 * (F.lane >> 4);
#pragma unroll
            for (int r = 0; r < 4; ++r) Y[y0 + (size_t)(m0 + r) * MIXW + n] = a[q][r]; }
        __syncthreads();
    }
}
}
constexpr int PPL = 14, NPHASE = 1 + PPL * DEPTH;
__host__ __device__ inline bool phase_exists(int ph) {
    if (ph == 0) return true;
    const int l = (ph - 1) / PPL, k = (ph - 1) % PPL; const bool isA = l < 2, moe = l & 1;
    if (k >= 2 && k <= 7) return isA;
    if (k == 10) return moe;
    return true;
}
struct Args { const float* in[23]; float* out; unsigned char* ws; int ph_lo, ph_hi; };
struct Order {
    int nM, nN, G, c; const int* tile_e;
    __device__ __forceinline__ bool next(int i, pg8::Unit& u) const { if (!pg8::order_map((long)i * G + c, nM, nN, u.pm, u.pn)) return false;
        int e = 0; if (tile_e) e = __builtin_amdgcn_readfirstlane(ld_relaxed(tile_e + u.pm)); u.bt = e * nN + u.pn; return true; }
};
__global__ void __launch_bounds__(NWAVES * 64, 2) fwd(Args args) {
    extern __shared__ __attribute__((aligned(16))) unsigned char lds[];
    Frame F;
    F.lds = (LAS unsigned char*)lds;
    volatile LAS unsigned* MISC = (volatile LAS unsigned*)(F.lds + MISC_OFF);
    ENTER(F);
    F.G = gridDim.x; { const int bx = blockIdx.x; F.vcu = (F.G % 8 == 0) ? (bx % 8) * (F.G / 8) + bx / 8 : bx; }
    for (int u = F.tid; u < (LDS_BYTES - LDSCTL_OFF) / 4; u += NWAVES * 64) ((LAS unsigned*)(F.lds + LDSCTL_OFF))[u] = 0u;
    __syncthreads();
    const int lo = args.ph_lo, hi = args.ph_hi;
    XcdBarrier bar; bar.bar = (unsigned*)(F.ws + WS_CTL) + CW_BAR; bar.x = 0; bar.st = MISC + 8;
    if (hi - lo > 1) bar = xcd_barrier_post((unsigned*)(F.ws + WS_CTL) + CW_BAR, MISC + 8);
#define IN(k) (lo <= (k) && (k) < hi)
#define SEAM(k) do { if ((k) + 1 < hi) xcd_barrier(bar); } while (0)

    if (IN(0)) { p0_prologue(F); SEAM(0); }

    for (int l = 0; l < DEPTH; ++l) {
        const int pb = 1 + PPL * l; const bool isA = l < 2, moe = (l & 1) != 0;
        const int NP = l == 0 ? NP0 : l == 1 ? NP1 : DM;
        const int QM_OFF = l == 0 ? NC0 : l == 1 ? NP0 : MIXW;
        if (IN(pb)) {
            for (int gi = 0; gi < 2; ++gi) {
                if (gi == 1 && !(l == 0 || l == 2)) break;
                ENTER(F); unsigned char* ws = F.ws;
                pg8::Gemm g; pg8::EpiStore E; Order S; S.G = F.G; S.c = (int)blockIdx.x; S.tile_e = nullptr;
                if (gi == 0) { const size_t wo = l == 0 ? WS_WIN0 : l == 1 ? WS_WIN1 : l == 2 ? WS_WIN2 : WS_WIN3;
                    g = pg8::Gemm{(const bf16*)(ws + WS_XB), (const bf16*)(ws + wo), DM, DM, DM}; S.nM = M / 256; S.nN = NP / 256;
                    E = pg8::EpiStore{(bf16*)(ws + WS_SCR + SC_P), NP, l == 0 ? (1u << 10) : l == 1 ? (1u << 11) : 0xFu, C2}; }
                else if (l == 0) { g = pg8::Gemm{(const bf16*)(ws + WS_MEMB), (const bf16*)(ws + WS_WMKV), DM, DM, DM}; S.nM = 4; S.nN = 8; E = pg8::EpiStore{(bf16*)(ws + WS_MKV), 2048, 0u, 1.f}; }
                else { g = pg8::Gemm{(const bf16*)(ws + WS_XB), (const bf16*)(ws + WS_WKV), DM, DM, DM}; S.nM = M / 256; S.nN = 6; E = pg8::EpiStore{(bf16*)(ws + WS_KV), 1536, 0u, 1.f}; }
                pg8::gemm_phase<pg8::EpiStore, Order>(F.lds + RING_OFF, g, S, E);
            }
            SEAM(pb);
        }
        if (IN(pb + 1)) {
            if (isA) ph_lora_in(F, l);
            else {
                ENTER(F); unsigned char* ws = F.ws;
                unsigned* ctr = (unsigned*)(ws + WS_CTL) + 64 * (8 + l);
                const bf16* KV = (const bf16*)(ws + WS_KV); const bf16* Pb = (const bf16*)(ws + WS_SCR + SC_P); bf16* MIX = (bf16*)(ws + WS_MIX);
                for (;;) {
                    if (F.tid == 0) MISC[16] = atomicAdd(ctr, 1u);
                    __syncthreads(); const int u = (int)MISC[16]; __syncthreads();
                    if (u >= NB * MIXH * 16) break;
                    const int qb = 15 - u / (NB * MIXH), bh = u % (NB * MIXH), b = bh / MIXH, h = bh % MIXH;
                    att::sb_unit(qb, Pb + (size_t)b * T * DM + h * 64, DM, KV + (size_t)b * T * 1536 + h * 64, KV + (size_t)b * T * 1536 + MIXW + h * 64, 1536, MIX + (size_t)b * T * DM + h * 64, DM, (att::lds_ptr)(F.lds + RING_OFF));
                }
            }
            { ENTER(F); unsigned char* ws = F.ws; const bf16* Pb = (const bf16*)(ws + WS_SCR + SC_P); bf16* MIX = (bf16*)(ws + WS_MIX);
              for (int u = blockIdx.x; u < NB * MEMH * 16; u += F.G) { const int b = u >> 6, hm = (u >> 4) & 3, blk = u & 15;
                const bf16* MKV = (const bf16*)(ws + WS_MKV) + (size_t)b * MEMT * 2048 + l * 512 + hm * 64; const size_t row0 = (size_t)b * T + blk * 256;
                att::mem_unit(Pb + row0 * NP + QM_OFF + hm * 64, NP, MKV, MKV + 256, 2048, MIX + row0 * DM + MIXW + hm * 64, DM, (att::lds_ptr)(F.lds + RING_OFF)); } }
            SEAM(pb + 1);
        }
        if (isA) {
            if (IN(pb + 2)) {
                ENTER(F); unsigned char* ws = F.ws;
                pg8::Gemm g{(const bf16*)(ws + WS_SCR + SC_U), (const bf16*)(ws + WS_WLORA + l * SZ_WLORA), 512, 512, 512};
                Order S; S.G = F.G; S.c = (int)blockIdx.x; S.tile_e = nullptr; S.nM = M / 256; S.nN = 12;
                const float* vec = inp(6) + (size_t)l * 6 * MIXW;
                pg8::EpiLora E{(float*)(ws + WS_SCR + SC_WDEC), (SC_AI - SC_WDEC) / 4, ((size_t)WS_SCR + SC_VG - (WS_SCR + SC_WDEC)) / 4, (SC_G - SC_WDEC) / 4, vec, l == 1 ? inp(10) : nullptr};
                pg8::gemm_phase<pg8::EpiLora, Order>(F.lds + RING_OFF, g, S, E);
                SEAM(pb + 2);
            }
            if (IN(pb + 3)) { ph_finalize(F, l); SEAM(pb + 3); }
            if (IN(pb + 4)) { ck::ph_s1(F); SEAM(pb + 4); }
            if (IN(pb + 5)) { ck::ph_s2(F); SEAM(pb + 5); }
            if (IN(pb + 6)) { ck::ph_s3(F); SEAM(pb + 6); }
            if (IN(pb + 7)) { ph_gn(F, l); SEAM(pb + 7); }
        }
        if (IN(pb + 8)) {
            ENTER(F); unsigned char* ws = F.ws;
            pg8::Gemm g{(const bf16*)(ws + WS_MIX), (const bf16*)(ws + WS_WO + l * SZ_WO), DM, DM, DM};
            Order S; S.G = F.G; S.c = (int)blockIdx.x; S.tile_e = nullptr; S.nM = M / 256; S.nN = 4;
            pg8::EpiResid E{l == 0 ? inp(0) : (const float*)(ws + WS_XF0), (float*)(ws + WS_PRE), DM, ALPHA};
            pg8::gemm_phase<pg8::EpiResid, Order>(F.lds + RING_OFF, g, S, E);
            SEAM(pb + 8);
        }
        if (IN(pb + 9)) { const float* ln = inp(17) + (size_t)l * 4 * DM; ph_ln(F, 0, ln, ln + DM, WS_XF1, WS_XB1, 0, moe ? 1 : 0, inp(20) + (size_t)(l >> 1) * DM * NE); SEAM(pb + 9); }
        if (moe && IN(pb + 10)) { ph_route2(F); SEAM(pb + 10); }
        if (IN(pb + 11)) {
            ENTER(F); unsigned char* ws = F.ws; const int* TILE = (const int*)(ws + WS_ROUTE + RO_TILE);
            pg8::Gemm g; Order S; S.G = F.G; S.c = (int)blockIdx.x; S.nN = 22;
            if (moe) { g = pg8::Gemm{(const bf16*)(ws + WS_SCR + SC_XG), (const bf16*)(ws + WS_WEGU + (size_t)(l >> 1) * 8 * SZ_WGU), DM, DM, DM}; S.tile_e = TILE; S.nM = __builtin_amdgcn_readfirstlane(ld_relaxed(TILE + 255)); }
            else { g = pg8::Gemm{(const bf16*)(ws + WS_XB1), (const bf16*)(ws + WS_WGU + (size_t)(l >> 1) * SZ_WGU), DM, DM, DM}; S.tile_e = nullptr; S.nM = M / 256; }
            pg8::EpiSwiglu E{(bf16*)(ws + WS_SCR + SC_H), FF};
            pg8::gemm_phase<pg8::EpiSwiglu, Order>(F.lds + RING_OFF, g, S, E);
            SEAM(pb + 11);
        }
        if (IN(pb + 12)) {
            ENTER(F); unsigned char* ws = F.ws; const int* TILE = (const int*)(ws + WS_ROUTE + RO_TILE);
            pg8::Gemm g; Order S; S.G = F.G; S.c = (int)blockIdx.x; S.nN = 4; pg8::EpiResid E;
            if (moe) { g = pg8::Gemm{(const bf16*)(ws + WS_SCR + SC_H), (const bf16*)(ws + WS_WEDN + (size_t)(l >> 1) * 8 * SZ_WDN), FF, FF, FF}; S.tile_e = TILE; S.nM = __builtin_amdgcn_readfirstlane(ld_relaxed(TILE + 255));
                E = pg8::EpiResid{nullptr, (float*)(ws + WS_SCR + SC_YE), DM, 0.f}; }
            else { g = pg8::Gemm{(const bf16*)(ws + WS_SCR + SC_H), (const bf16*)(ws + WS_WDN + (size_t)(l >> 1) * SZ_WDN), FF, FF, FF}; S.tile_e = nullptr; S.nM = M / 256; E = pg8::EpiResid{(const float*)(ws + WS_XF1), (float*)(ws + WS_PRE), DM, ALPHA}; }
            pg8::gemm_phase<pg8::EpiResid, Order>(F.lds + RING_OFF, g, S, E);
            SEAM(pb + 12);
        }
        if (IN(pb + 13)) { const float* ln = inp(17) + (size_t)l * 4 * DM; ph_ln(F, moe ? 1 : 0, ln + 2 * DM, ln + 3 * DM, WS_XF0, WS_XB, l == DEPTH - 1 ? 1 : 0, 0, nullptr); SEAM(pb + 13); }
    }
#undef IN
#undef SEAM
}

#ifndef PROBE_LIST
#define PROBE_LIST -1
#endif
static const int PROBE_PHS[] = {PROBE_LIST};
#ifndef MK_ONE_LAUNCH
#define MK_ONE_LAUNCH 1
#endif
extern "C" void kernel_launch(void* const* d_in, const int* in_sizes, int n_in, void* d_out, int out_size, void* d_ws, size_t ws_size, hipStream_t stream) {
    static int grid = 0;
    if (grid == 0) {
        if (n_in != 23 || in_sizes[0] != M * DM || out_size != M * DM || ws_size < WS_END) { fprintf(stderr, "kernel_launch: shape/workspace mismatch (n_in %d, ws %zu, need %zu)\n", n_in, ws_size, (size_t)WS_END); grid = -1; return; }
        int dev = 0, cus = 0, per_cu = 0;
        if (hipGetDevice(&dev) != hipSuccess || hipDeviceGetAttribute(&cus, hipDeviceAttributeMultiprocessorCount, dev) != hipSuccess) { grid = -1; return; }
        if (hipFuncSetAttribute((const void*)fwd, hipFuncAttributeMaxDynamicSharedMemorySize, LDS_BYTES) != hipSuccess) { fprintf(stderr, "kernel_launch: hipFuncSetAttribute failed\n"); grid = -1; return; }
        if (hipOccupancyMaxActiveBlocksPerMultiprocessor(&per_cu, (const void*)fwd, NWAVES * 64, LDS_BYTES) != hipSuccess || per_cu < 1) fprintf(stderr, "kernel_launch: occupancy query reports %d\n", per_cu);
        (void)hipGetLastError();
        grid = cus;
    }
    if (grid < 0) return;
    if (hipMemsetAsync((char*)d_ws + WS_CTL, 0, CTL_ZERO_BYTES, stream) != hipSuccess) return;
    Args a{};
    for (int i = 0; i < 23; ++i) a.in[i] = (const float*)d_in[i];
    a.out = (float*)d_out; a.ws = (unsigned char*)d_ws;
    if (MK_ONE_LAUNCH) { a.ph_lo = 0; a.ph_hi = NPHASE; hipLaunchKernelGGL(fwd, dim3(grid), dim3(NWAVES * 64), LDS_BYTES, stream, a); }
    else for (int ph = 0; ph < NPHASE; ++ph) { if (!phase_exists(ph)) continue; a.ph_lo = ph; a.ph_hi = ph + 1;
        int reps = 1; for (int q : PROBE_PHS) if (q == ph) reps = 2;
        for (int r = 0; r < reps; ++r) { if (r) (void)hipMemsetAsync((char*)d_ws + WS_CTL, 0, CTL_ZERO_BYTES, stream); hipLaunchKernelGGL(fwd, dim3(grid), dim3(NWAVES * 64), LDS_BYTES, stream, a); } }
}
```

```cpp
#include <hip/hip_runtime.h>
#include <cstdio>
#include <cstdint>
#include <cmath>
#define MK_ONE_LAUNCH 1
#define PROBE_LIST -1
#define PROBE_VAR 0
namespace pg8 {
#define PG8_LAS __attribute__((address_space(3)))
typedef unsigned short bf16_t;
typedef short bf16x8 __attribute__((ext_vector_type(8)));
typedef float f32x4 __attribute__((ext_vector_type(4)));
typedef float f32x2 __attribute__((ext_vector_type(2)));
typedef unsigned u32x4 __attribute__((ext_vector_type(4)));
typedef unsigned u32x2 __attribute__((ext_vector_type(2)));
constexpr int BM = 256, BK = 64, HALF = 128, HTB = HALF * BK * 2, STAGE_BYTES = 8 * HTB, NXCD = 8, WGM = 8;

__host__ __device__ __forceinline__ int lds_byte(int r, int c) { const int st = (r >> 4) * 2 + (c >> 5), rr = r & 15, cc = c & 31, ob = rr * 64 + cc * 2; return st * 1024 + (ob ^ (((ob >> 9) & 1) << 5)); }
__host__ __device__ __forceinline__ void stage_rc(int b, int& R, int& C) { const int st = b / 1024, sb = b % 1024, swz = sb ^ (((sb >> 9) & 1) << 5); R = (st >> 1) * 16 + swz / 64; C = (st & 1) * 32 + (swz % 64) / 2; }
__host__ __device__ __forceinline__ int perm32(int rho) { const int n = rho >> 4, i = rho & 15; return 8 * (i >> 2) + 4 * n + (i & 3); }

struct Unit { int pm, pn, bt; };
struct Gemm { const bf16_t* A; const bf16_t* Bt; int lda, ldb, K; };

__device__ __forceinline__ bool order_map(long L, int nM, int nN, int& pm, int& pn) {
    const int nwg = nM * nN; if (L >= nwg) return false;
    int wgid = (int)L; { const int q = nwg / NXCD, r = nwg % NXCD, xcd = wgid % NXCD, off = wgid / NXCD; wgid = (xcd < r ? xcd * (q + 1) : r * (q + 1) + (xcd - r) * q) + off; }
    const int nig = WGM * nN, gid = wgid / nig, fm = gid * WGM, gsz = (nM - fm) < WGM ? (nM - fm) : WGM;
    pm = fm + ((wgid % nig) % gsz); pn = (wgid % nig) / gsz; return true;
}
struct StaticOrder {
    int nM, nN, G, c;
    __device__ void init(int M, int N, int G_, int c_) { nM = M / BM; nN = N / BM; G = G_; c = c_; }
    __device__ __forceinline__ bool next(int i, Unit& u) const { if (!order_map((long)i * G + c, nM, nN, u.pm, u.pn)) return false; u.bt = u.pn; return true; }
};
struct MoeOrder {
    int nM, nN, G, c; const int* tile_e;
    __device__ __forceinline__ bool next(int i, Unit& u) const { if (!order_map((long)i * G + c, nM, nN, u.pm, u.pn)) return false;
        const int e = __builtin_amdgcn_readfirstlane(__hip_atomic_load(tile_e + u.pm, __ATOMIC_RELAXED, __HIP_MEMORY_SCOPE_AGENT)); u.bt = e * nN + u.pn; return true; }
};

__device__ __forceinline__ unsigned cvt_pk_bf16(float lo, float hi) { unsigned r; asm volatile("v_cvt_pk_bf16_f32 %0, %1, %2" : "=v"(r) : "v"(lo), "v"(hi)); return r; }

struct EpiStore {
    static constexpr bool PERM = true;
    bf16_t* O; int ldc; unsigned scale_mask; float scale;
    __device__ __forceinline__ void operator()(const f32x4 (&acc)[2][2][4][2], const Unit& u, int wr, int wc, int fr, int fq) const {
        const int row0 = u.pm * BM + wr * 64 + fr, col0 = u.pn * BM + wc * 32 + 8 * fq;
        const float sc = ((scale_mask >> u.pn) & 1u) ? scale : 1.f;
#pragma unroll
        for (int ai = 0; ai < 2; ++ai)
#pragma unroll
            for (int m = 0; m < 4; ++m) { bf16_t* rowp = O + (size_t)(row0 + ai * HALF + m * 16) * ldc + col0;
#pragma unroll
                for (int bj = 0; bj < 2; ++bj) { const f32x4 v0 = acc[ai][bj][m][0] * sc, v1 = acc[ai][bj][m][1] * sc;
                    u32x4 w; w.x = cvt_pk_bf16(v0[0], v0[1]); w.y = cvt_pk_bf16(v0[2], v0[3]); w.z = cvt_pk_bf16(v1[0], v1[1]); w.w = cvt_pk_bf16(v1[2], v1[3]);
                    *(u32x4*)(rowp + bj * HALF) = w; } }
    }
};
__device__ __forceinline__ float silu_mul(float g, float u) { return g * u * __builtin_amdgcn_rcpf(1.0f + __builtin_amdgcn_exp2f(-1.4426950408889634f * g)); }
struct EpiSwiglu {
    static constexpr bool PERM = true;
    bf16_t* H; int ldc;
    __device__ __forceinline__ void operator()(const f32x4 (&acc)[2][2][4][2], const Unit& u, int wr, int wc, int fr, int fq) const {
        const int row0 = u.pm * BM + wr * 64 + fr, col0 = u.pn * HALF + wc * 32 + 8 * fq;
#pragma unroll
        for (int ai = 0; ai < 2; ++ai)
#pragma unroll
            for (int m = 0; m < 4; ++m) { bf16_t* rowp = H + (size_t)(row0 + ai * HALF + m * 16) * ldc + col0;
                const f32x4 g0 = acc[ai][0][m][0], g1 = acc[ai][0][m][1], u0 = acc[ai][1][m][0], u1 = acc[ai][1][m][1];
                u32x4 w; w.x = cvt_pk_bf16(silu_mul(g0[0], u0[0]), silu_mul(g0[1], u0[1])); w.y = cvt_pk_bf16(silu_mul(g0[2], u0[2]), silu_mul(g0[3], u0[3]));
                w.z = cvt_pk_bf16(silu_mul(g1[0], u1[0]), silu_mul(g1[1], u1[1])); w.w = cvt_pk_bf16(silu_mul(g1[2], u1[2]), silu_mul(g1[3], u1[3]));
                *(u32x4*)rowp = w; }
    }
};
struct EpiResid {
    static constexpr bool PERM = false;
    const float* base; float* out; int ldc; float alpha;
    __device__ __forceinline__ void operator()(const f32x4 (&acc)[2][2][4][2], const Unit& u, int wr, int wc, int fr, int fq) const {
        const int row0 = u.pm * BM + wr * 64 + fr, col0 = u.pn * BM + wc * 32 + 4 * fq;
#pragma unroll
        for (int ai = 0; ai < 2; ++ai)
#pragma unroll
            for (int m = 0; m < 4; ++m) { const size_t off = (size_t)(row0 + ai * HALF + m * 16) * ldc + col0;
#pragma unroll
                for (int bj = 0; bj < 2; ++bj)
#pragma unroll
                    for (int n = 0; n < 2; ++n) { f32x4 o = acc[ai][bj][m][n];
                        if (base) { const f32x4 bs = *(const f32x4*)(base + off + bj * HALF + n * 16); o = o + bs * alpha; }
                        *(f32x4*)(out + off + bj * HALF + n * 16) = o; } }
    }
};
struct EpiLora {
    static constexpr bool PERM = false;
    float* out0; size_t off1, off2, off3; const float* vec; const float* v0;
    __device__ __forceinline__ void operator()(const f32x4 (&acc)[2][2][4][2], const Unit& u, int wr, int wc, int fr, int fq) const {
        const int blk = u.pn / 3, cb0 = (u.pn - 3 * blk) * BM + wc * 32 + 4 * fq, row0 = u.pm * BM + wr * 64 + fr;
        if (blk == 2 && v0 == nullptr) return;
        float* outp = out0 + (blk == 0 ? (size_t)0 : blk == 1 ? off1 : blk == 2 ? off2 : off3);
        const float* bias = blk == 2 ? v0 : vec + (blk & 1) * 768;
#pragma unroll
        for (int bj = 0; bj < 2; ++bj)
#pragma unroll
            for (int n = 0; n < 2; ++n) { const int cb = cb0 + bj * HALF + n * 16;
                f32x4 bv = (f32x4){0.f, 0.f, 0.f, 0.f}; if (blk < 3) bv = *(const f32x4*)(bias + cb);
#pragma unroll
                for (int ai = 0; ai < 2; ++ai)
#pragma unroll
                    for (int m = 0; m < 4; ++m) { f32x4 v = acc[ai][bj][m][n] + bv, o;
#pragma unroll
                        for (int j = 0; j < 4; ++j) { const float d = v[j]; float r;
                            if (blk == 0) { const float sp = fmaxf(-d, 0.f) + __logf(1.0f + __expf(-fabsf(d)));
                                r = -__expf(-sp - 0.5f); }
                            else if (blk == 3) r = d;
                            else r = 1.0f / (1.0f + __expf(-d));
                            o[j] = r; }
                        *(f32x4*)(outp + (size_t)(row0 + ai * HALF + m * 16) * 768 + cb) = o; } }
    }
};

template <class Epi, class Sched>
__device__ __forceinline__ void gemm_phase(PG8_LAS unsigned char* lds, const Gemm g, const Sched& S, const Epi& E) {
    int tid = threadIdx.x; asm volatile("" : "+v"(tid));
    const int wid = __builtin_amdgcn_readfirstlane(tid >> 6), lane = tid & 63, wr = wid >> 2, wc = wid & 3, fr = lane & 15, fq = lane >> 4;
    const int K = g.K, nt = K / BK;
    unsigned voffA[2], voffB[2];
#pragma unroll
    for (int i = 0; i < 2; ++i) { int R, C; stage_rc(tid * 16 + i * 8192, R, C); const int Rb = Epi::PERM ? ((R & ~31) + perm32(R & 31)) : R;
        voffA[i] = (unsigned)(R * g.lda + C) * 2u; voffB[i] = (unsigned)(Rb * g.ldb + C) * 2u; }
    const size_t kstep = (size_t)(BK * 2);
    const size_t hstepA = (size_t)HALF * g.lda * 2, hstepB = (size_t)HALF * g.ldb * 2;
    const size_t tstepA = 2 * hstepA, tstepB = 2 * hstepB;
    const unsigned ldsw = (unsigned)wid * 1024u;
    const int aoff = lds_byte(wr * 64 + fr, fq * 8), boff = lds_byte(wc * 32 + fr, fq * 8);
#define PG8_SA(b, h) (((b) * 2 + (h)) * HTB)
#define PG8_SB(b, h) ((4 + (b) * 2 + (h)) * HTB)
#define PG8_STAGE(bufoff, gbase, voff) do { _Pragma("unroll") for (int _i = 0; _i < 2; ++_i) \
        __builtin_amdgcn_global_load_lds((const unsigned*)((const char*)(gbase) + (voff)[_i]), (PG8_LAS unsigned*)(lds + (bufoff) + ldsw + _i * 8192), 16, 0, 0); } while (0)
#define PG8_LDA(dst, b, h) do { _Pragma("unroll") for (int m = 0; m < 4; ++m) _Pragma("unroll") for (int k = 0; k < 2; ++k) dst[m][k] = *(const PG8_LAS bf16x8*)(lds + PG8_SA(b, h) + aoff + m * 2048 + k * 1024); } while (0)
#define PG8_LDB(dst, b, h) do { _Pragma("unroll") for (int n = 0; n < 2; ++n) _Pragma("unroll") for (int k = 0; k < 2; ++k) dst[n][k] = *(const PG8_LAS bf16x8*)(lds + PG8_SB(b, h) + boff + n * 2048 + k * 1024); } while (0)
#define PG8_MMA(ai, bj, At, Bt) do { __builtin_amdgcn_s_setprio(1); _Pragma("unroll") for (int m = 0; m < 4; ++m) _Pragma("unroll") for (int n = 0; n < 2; ++n) _Pragma("unroll") for (int k = 0; k < 2; ++k) \
        acc[ai][bj][m][n] = __builtin_amdgcn_mfma_f32_16x16x32_bf16(Bt[n][k], At[m][k], acc[ai][bj][m][n], 0, 0, 0); __builtin_amdgcn_s_setprio(0); } while (0)
#define PG8_WAIT_V(n) asm volatile("s_waitcnt vmcnt(" #n ")" ::: "memory")
#define PG8_WAIT_L(n) asm volatile("s_waitcnt lgkmcnt(" #n ")" ::: "memory")
#define PG8_BAR __builtin_amdgcn_s_barrier()
#define PG8_SCHED __builtin_amdgcn_sched_barrier(0)
    Unit cur, nxt; int ui = 0;
    if (!S.next(0, cur)) return;
    f32x4 acc[2][2][4][2];
#pragma unroll
    for (int a = 0; a < 2; ++a)
#pragma unroll
        for (int b = 0; b < 2; ++b)
#pragma unroll
            for (int m = 0; m < 4; ++m)
#pragma unroll
                for (int n = 0; n < 2; ++n) acc[a][b][m][n] = (f32x4){0.f, 0.f, 0.f, 0.f};
    bf16x8 At[4][2], B0[2][2], B1[2][2];
    const char* cA = (const char*)g.A + (size_t)cur.pm * tstepA; const char* cB = (const char*)g.Bt + (size_t)cur.bt * tstepB;
    PG8_STAGE(PG8_SB(0, 0), cB, voffB); PG8_STAGE(PG8_SB(0, 1), cB + hstepB, voffB); PG8_STAGE(PG8_SA(0, 0), cA, voffA); PG8_STAGE(PG8_SA(0, 1), cA + hstepA, voffA);
    if (wr == 1) PG8_BAR;
    PG8_WAIT_V(2); PG8_BAR;
    PG8_STAGE(PG8_SB(1, 0), cB + kstep, voffB); PG8_STAGE(PG8_SA(1, 0), cA + kstep, voffA); PG8_STAGE(PG8_SB(1, 1), cB + hstepB + kstep, voffB);
    PG8_WAIT_V(6); PG8_BAR;
    for (;;) {
        const bool has_next = S.next(ui + 1, nxt);
        const char* nA = has_next ? (const char*)g.A + (size_t)nxt.pm * tstepA : cA; const char* nB = has_next ? (const char*)g.Bt + (size_t)nxt.bt * tstepB : cB;
        for (int t = 0; t < nt; t += 2) {
            const bool last = (t == nt - 2);
            const char* a1 = cA + (size_t)(t + 1) * kstep;
            const char* a2 = last ? nA : cA + (size_t)(t + 2) * kstep; const char* b2 = last ? nB : cB + (size_t)(t + 2) * kstep;
            const char* a3 = a2 + kstep; const char* b3 = b2 + kstep;
            PG8_LDB(B0, 0, 0); PG8_LDB(B1, 0, 1); PG8_SCHED; PG8_LDA(At, 0, 0); PG8_STAGE(PG8_SA(1, 1), a1 + hstepA, voffA);
            PG8_WAIT_V(8); PG8_WAIT_L(0); PG8_BAR; PG8_MMA(0, 0, At, B0); PG8_MMA(0, 1, At, B1); PG8_BAR; PG8_SCHED;
            PG8_LDA(At, 0, 1); PG8_STAGE(PG8_SB(0, 0), b2, voffB); PG8_STAGE(PG8_SB(0, 1), b2 + hstepB, voffB); PG8_STAGE(PG8_SA(0, 0), a2, voffA);
            PG8_WAIT_V(8); PG8_WAIT_L(0); PG8_BAR; PG8_MMA(1, 0, At, B0); PG8_MMA(1, 1, At, B1); PG8_BAR; PG8_SCHED;
            PG8_LDB(B0, 1, 0); PG8_LDB(B1, 1, 1); PG8_SCHED; PG8_LDA(At, 1, 0); PG8_STAGE(PG8_SA(0, 1), a2 + hstepA, voffA);
            PG8_WAIT_V(8); PG8_WAIT_L(0); PG8_BAR; PG8_MMA(0, 0, At, B0); PG8_MMA(0, 1, At, B1); PG8_BAR; PG8_SCHED;
            PG8_LDA(At, 1, 1); PG8_STAGE(PG8_SB(1, 0), b3, voffB); PG8_STAGE(PG8_SB(1, 1), b3 + hstepB, voffB); PG8_STAGE(PG8_SA(1, 0), a3, voffA);
            PG8_WAIT_V(8); PG8_WAIT_L(0); PG8_BAR; PG8_MMA(1, 0, At, B0); PG8_MMA(1, 1, At, B1); PG8_BAR; PG8_SCHED;
        }
        if (wr == 0) PG8_BAR;
        E(acc, cur, wr, wc, fr, fq);
        if (!has_next) break;
#pragma unroll
        for (int a = 0; a < 2; ++a)
#pragma unroll
            for (int b = 0; b < 2; ++b)
#pragma unroll
                for (int m = 0; m < 4; ++m)
#pragma unroll
                    for (int n = 0; n < 2; ++n) acc[a][b][m][n] = (f32x4){0.f, 0.f, 0.f, 0.f};
        cur = nxt; cA = nA; cB = nB; ++ui;
        if (wr == 1) PG8_BAR;
    }
    PG8_WAIT_V(0);
    PG8_BAR;
#undef PG8_SA
#undef PG8_SB
#undef PG8_STAGE
#undef PG8_LDA
#undef PG8_LDB
#undef PG8_MMA
#undef PG8_WAIT_V
#undef PG8_WAIT_L
#undef PG8_BAR
#undef PG8_SCHED
}
}
namespace att {
using bf16 = unsigned short;
using bf16x8 = __attribute__((ext_vector_type(8))) short;
using s16x4 = __attribute__((ext_vector_type(4))) short;
using f32x16 = __attribute__((ext_vector_type(16))) float;
using u32x4 = __attribute__((ext_vector_type(4))) unsigned;
typedef short v4i16_t __attribute__((ext_vector_type(4)));
typedef __attribute__((address_space(3))) const char* lds_cptr;
typedef __attribute__((address_space(3))) char* lds_ptr;
typedef float f32x2_t __attribute__((ext_vector_type(2))); typedef __bf16 bf16x2_t __attribute__((ext_vector_type(2)));
__device__ __forceinline__ int crow(int r, int hi) { return (r & 3) + 8 * (r >> 2) + 4 * hi; }
__device__ __forceinline__ unsigned cvtpk_s(float lo, float hi) { f32x2_t v = {lo, hi}; bf16x2_t b = __builtin_convertvector(v, bf16x2_t); return __builtin_bit_cast(unsigned, b); }
#define ATT_SBAR() __builtin_amdgcn_sched_barrier(0)
#define ATT_WAIT_BAR(N) asm volatile("s_waitcnt vmcnt(" #N ") lgkmcnt(0)\n\ts_barrier" ::: "memory")
constexpr int SLOTB = 8192;
__device__ __forceinline__ void glds16(const void* gsrc, unsigned lds_dst) { unsigned keep;
    asm volatile("s_mov_b32 %0, m0\n\ts_mov_b32 m0, %2\n\ts_nop 0\n\tglobal_load_lds_dwordx4 %1, off\n\ts_mov_b32 m0, %0" : "=&s"(keep) : "v"(gsrc), "s"(lds_dst) : "memory"); }
__device__ __forceinline__ void dma_k(const bf16* ktile, int pitch, unsigned slot_lds, int wid, int lane) {
    glds16(ktile + (long)lane * pitch + wid * 8, (unsigned)__builtin_amdgcn_readfirstlane(slot_lds + wid * 1024)); }
__device__ __forceinline__ void dma_v(const bf16* vtile, int pitch, unsigned slot_lds, int wid, int lane) {
    glds16(vtile + (long)(16 * (wid & 3) + (lane >> 2)) * pitch + (wid >> 2) * 32 + (lane & 3) * 8, (unsigned)__builtin_amdgcn_readfirstlane(slot_lds + wid * 1024)); }
__device__ __forceinline__ void qkt(f32x16& p0, f32x16& p1, lds_cptr Kslot, const bf16x8* qr, int r32, int hi) {
    lds_cptr kb = Kslot + hi * 1024 + r32 * 16;
    const f32x16 z = {};
#pragma unroll
    for (int d0 = 0; d0 < 4; ++d0) {
        const bf16x8 b0 = *(const __attribute__((address_space(3))) bf16x8*)(kb + d0 * 2048);
        const bf16x8 b1 = *(const __attribute__((address_space(3))) bf16x8*)(kb + d0 * 2048 + 512);
        if (d0 == 0) { p0 = __builtin_amdgcn_mfma_f32_32x32x16_bf16(b0, qr[0], z, 0, 0, 0); p1 = __builtin_amdgcn_mfma_f32_32x32x16_bf16(b1, qr[0], z, 0, 0, 0); }
        else { p0 = __builtin_amdgcn_mfma_f32_32x32x16_bf16(b0, qr[d0], p0, 0, 0, 0); p1 = __builtin_amdgcn_mfma_f32_32x32x16_bf16(b1, qr[d0], p1, 0, 0, 0); } }
}
__device__ __forceinline__ s16x4 vtr(lds_cptr p) { return __builtin_bit_cast(s16x4, __builtin_amdgcn_ds_read_tr16_b64_v4i16((__attribute__((address_space(3))) v4i16_t*)p)); }
__device__ __forceinline__ void pv(f32x16* o, lds_cptr vp, bf16x8 pa0, bf16x8 pa1, bf16x8 pa2, bf16x8 pa3) {
#pragma unroll
    for (int d0 = 0; d0 < 2; ++d0) { s16x4 lo[4], hi[4];
#pragma unroll
        for (int ks = 0; ks < 4; ++ks) { lo[ks] = vtr(vp + d0 * 4096 + ks * 1024); hi[ks] = vtr(vp + d0 * 4096 + ks * 1024 + 512); }
#define ATT_PK(k) (bf16x8){lo[k][0], lo[k][1], lo[k][2], lo[k][3], hi[k][0], hi[k][1], hi[k][2], hi[k][3]}
        o[d0] = __builtin_amdgcn_mfma_f32_32x32x16_bf16(pa0, ATT_PK(0), o[d0], 0, 0, 0);
        o[d0] = __builtin_amdgcn_mfma_f32_32x32x16_bf16(pa1, ATT_PK(1), o[d0], 0, 0, 0);
        o[d0] = __builtin_amdgcn_mfma_f32_32x32x16_bf16(pa2, ATT_PK(2), o[d0], 0, 0, 0);
        o[d0] = __builtin_amdgcn_mfma_f32_32x32x16_bf16(pa3, ATT_PK(3), o[d0], 0, 0, 0);
#undef ATT_PK
    }
}
__device__ __forceinline__ float swap_lo(float x, float& hi_out) { auto rr = __builtin_amdgcn_permlane32_swap(__float_as_uint(x), __float_as_uint(x), false, false); hi_out = __uint_as_float(rr[1]); return __uint_as_float(rr[0]); }
#define ATT_PKW(P, B) cvtpk_s(P[B], P[B + 1])
#define ATT_PACK4(P0, P1, w0, w1, w2, w3) do { w0 = (u32x4){ATT_PKW(P0, 0), ATT_PKW(P0, 2), ATT_PKW(P0, 4), ATT_PKW(P0, 6)}; w1 = (u32x4){ATT_PKW(P0, 8), ATT_PKW(P0, 10), ATT_PKW(P0, 12), ATT_PKW(P0, 14)}; \
    w2 = (u32x4){ATT_PKW(P1, 0), ATT_PKW(P1, 2), ATT_PKW(P1, 4), ATT_PKW(P1, 6)}; w3 = (u32x4){ATT_PKW(P1, 8), ATT_PKW(P1, 10), ATT_PKW(P1, 12), ATT_PKW(P1, 14)}; } while (0)
__device__ __forceinline__ void store_o(const f32x16* o, const float* rscale, lds_ptr stg, bf16* Ow, int pitch, int lane, int r32, int hi) {
    __attribute__((address_space(3))) bf16* s = (__attribute__((address_space(3))) bf16*)stg;
#pragma unroll
    for (int r = 0; r < 16; ++r) { const int orow = crow(r, hi);
#pragma unroll
        for (int d0 = 0; d0 < 2; ++d0) { const float v = o[d0][r] * rscale[r]; s[orow * 64 + d0 * 32 + r32] = (bf16)(cvtpk_s(v, v) & 0xffffu); } }
    asm volatile("s_waitcnt lgkmcnt(0)" ::: "memory");
#pragma unroll
    for (int i = 0; i < 4; ++i) { const int row = i * 8 + (lane >> 3), ch = lane & 7; const u32x4 v = *(const __attribute__((address_space(3))) u32x4*)(s + row * 64 + ch * 8); *(u32x4*)(Ow + (long)row * pitch + ch * 8) = v; }
}

constexpr int LDS_K = 0, LDS_V = 4 * SLOTB, LDS_WS = 8 * SLOTB, LDS_OST = LDS_WS + 8 * 256, ATT_LDS_BYTES = LDS_OST + 8 * 4096;

__device__ __forceinline__ void sb_unit(int qb, const bf16* Qh, int qp, const bf16* Kh, const bf16* Vh, int kp, bf16* Oh, int op, lds_ptr shm) {
    int tid = threadIdx.x; asm volatile("" : "+v"(tid)); const int lane = tid & 63, r32 = lane & 31, hi = lane >> 5; const int wid = __builtin_amdgcn_readfirstlane(tid >> 6);
    const unsigned lds0 = (unsigned)(size_t)shm;
    const int q0w = qb * 256 + wid * 32;
    const int NT = 4 * qb + 4;
    const lds_cptr kp0 = (lds_cptr)shm + LDS_K, vp0 = (lds_cptr)shm + LDS_V + ((lane >> 4) & 1) * 32 + (lane & 3) * 8 + (4 * hi + ((lane & 15) >> 2)) * 64;
    { const int t = NT - 1, s = t & 1; dma_k(Kh + (long)t * 64 * kp, kp, lds0 + LDS_K + s * SLOTB, wid, lane); dma_v(Vh + (long)t * 64 * kp, kp, lds0 + LDS_V + s * SLOTB, wid, lane); }
    bf16x8 qr[4];
#pragma unroll
    for (int d0 = 0; d0 < 4; ++d0) qr[d0] = *(const bf16x8*)(Qh + (long)(q0w + r32) * qp + d0 * 16 + hi * 8);
    f32x16 o[2]; o[0] = f32x16{}; o[1] = f32x16{};
    float carry = 1.0f;
    const int qabs = q0w + r32;
    for (int t = NT - 1; t >= 0; --t) {
        ATT_WAIT_BAR(0);
        if (t > 0) { const int s = (t - 1) & 1; dma_k(Kh + (long)(t - 1) * 64 * kp, kp, lds0 + LDS_K + s * SLOTB, wid, lane); dma_v(Vh + (long)(t - 1) * 64 * kp, kp, lds0 + LDS_V + s * SLOTB, wid, lane); }
        if (64 * t >= q0w + 31) continue;
        const int sl = (t & 1) * SLOTB;
        f32x16 p0, p1, x0, x1;
        qkt(p0, p1, kp0 + sl, qr, r32, hi);
        const bool need_mask = (64 * t + 63 >= q0w);
        const int kb = 64 * t + 4 * hi;
#pragma unroll
        for (int r = 0; r < 16; ++r) {
            const float z0 = fminf(p0[r], 100.f), z1 = fminf(p1[r], 100.f);
            const float e0 = __builtin_amdgcn_exp2f(z0), e1 = __builtin_amdgcn_exp2f(z1);
            float a0 = __builtin_amdgcn_rcpf(1.0f + e0), a1 = __builtin_amdgcn_rcpf(1.0f + e1);
            float b0 = e0 * a0, b1 = e1 * a1;
            if (need_mask) { const int kv = kb + (r & 3) + 8 * (r >> 2); if (kv >= qabs) { a0 = 1.f; b0 = 0.f; } if (kv + 32 >= qabs) { a1 = 1.f; b1 = 0.f; } }
            x0[r] = a0; x1[r] = a1; p0[r] = b0; p1[r] = b1; }
        float gp[8], lo[8], hv[8], T[8];
#pragma unroll
        for (int m = 0; m < 4; ++m) { gp[m] = (x0[4 * m] * x0[4 * m + 1]) * (x0[4 * m + 2] * x0[4 * m + 3]); gp[4 + m] = (x1[4 * m] * x1[4 * m + 1]) * (x1[4 * m + 2] * x1[4 * m + 3]); }
#pragma unroll
        for (int m = 0; m < 8; ++m) lo[m] = swap_lo(gp[m], hv[m]);
        T[7] = 1.0f;
#pragma unroll
        for (int m = 6; m >= 0; --m) T[m] = T[m + 1] * (lo[m + 1] * hv[m + 1]);
        const float total = T[0] * (lo[0] * hv[0]);
#pragma unroll
        for (int m = 0; m < 8; ++m) {
            float c = carry * T[m]; if (hi == 0) c *= hv[m];
            if (m < 4) { p0[4 * m + 3] *= c; c *= x0[4 * m + 3]; p0[4 * m + 2] *= c; c *= x0[4 * m + 2]; p0[4 * m + 1] *= c; c *= x0[4 * m + 1]; p0[4 * m] *= c; }
            else { const int q = m - 4; p1[4 * q + 3] *= c; c *= x1[4 * q + 3]; p1[4 * q + 2] *= c; c *= x1[4 * q + 2]; p1[4 * q + 1] *= c; c *= x1[4 * q + 1]; p1[4 * q] *= c; } }
        carry *= total;
        u32x4 w0, w1, w2, w3; ATT_PACK4(p0, p1, w0, w1, w2, w3);
        pv(o, vp0 + sl, __builtin_bit_cast(bf16x8, w0), __builtin_bit_cast(bf16x8, w1), __builtin_bit_cast(bf16x8, w2), __builtin_bit_cast(bf16x8, w3));
    }
    float one[16];
#pragma unroll
    for (int r = 0; r < 16; ++r) one[r] = 1.0f;
    store_o(o, one, shm + LDS_OST + wid * 4096, Oh + (long)q0w * op, op, lane, r32, hi);
    asm volatile("s_waitcnt lgkmcnt(0)\n\ts_barrier" ::: "memory");
}

__device__ __forceinline__ void mem_unit(const bf16* Qh, int qp, const bf16* Kh, const bf16* Vh, int kp, bf16* Oh, int op, lds_ptr shm) {
    int tid = threadIdx.x; asm volatile("" : "+v"(tid)); const int lane = tid & 63, r32 = lane & 31, hi = lane >> 5; const int wid = __builtin_amdgcn_readfirstlane(tid >> 6);
    const unsigned lds0 = (unsigned)(size_t)shm;
    const lds_cptr kp0 = (lds_cptr)shm + LDS_K, vp0 = (lds_cptr)shm + LDS_V + ((lane >> 4) & 1) * 32 + (lane & 3) * 8 + (4 * hi + ((lane & 15) >> 2)) * 64;
#pragma unroll
    for (int t = 0; t < 4; ++t) { dma_k(Kh + (long)t * 64 * kp, kp, lds0 + LDS_K + t * SLOTB, wid, lane); dma_v(Vh + (long)t * 64 * kp, kp, lds0 + LDS_V + t * SLOTB, wid, lane); }
    bf16x8 qr[4];
#pragma unroll
    for (int d0 = 0; d0 < 4; ++d0) qr[d0] = *(const bf16x8*)(Qh + (long)(wid * 32 + r32) * qp + d0 * 16 + hi * 8);
    ATT_WAIT_BAR(0);
    f32x16 p[8];
#pragma unroll
    for (int t = 0; t < 4; ++t) qkt(p[2 * t], p[2 * t + 1], kp0 + t * SLOTB, qr, r32, hi);
    float mx = -INFINITY;
#pragma unroll
    for (int t = 0; t < 8; ++t)
#pragma unroll
        for (int r = 0; r < 16; ++r) mx = fmaxf(mx, p[t][r]);
    { float h2; const float l2 = swap_lo(mx, h2); mx = fmaxf(l2, h2); }
    float sum = 0.f;
#pragma unroll
    for (int t = 0; t < 8; ++t)
#pragma unroll
        for (int r = 0; r < 16; ++r) { const float e = __builtin_amdgcn_exp2f(p[t][r] - mx); p[t][r] = e; sum += e; }
    { float h2; const float l2 = swap_lo(sum, h2); sum = l2 + h2; }
    f32x16 o[2]; o[0] = f32x16{}; o[1] = f32x16{};
#pragma unroll
    for (int t = 0; t < 4; ++t) { u32x4 w0, w1, w2, w3; ATT_PACK4(p[2 * t], p[2 * t + 1], w0, w1, w2, w3);
        pv(o, vp0 + t * SLOTB, __builtin_bit_cast(bf16x8, w0), __builtin_bit_cast(bf16x8, w1), __builtin_bit_cast(bf16x8, w2), __builtin_bit_cast(bf16x8, w3)); }
    __attribute__((address_space(3))) float* wsf = (__attribute__((address_space(3))) float*)(shm + LDS_WS) + wid * 64;
    if (hi == 0) wsf[r32] = sum;
    asm volatile("s_waitcnt lgkmcnt(0)" ::: "memory");
    float rli[16];
#pragma unroll
    for (int r = 0; r < 16; ++r) rli[r] = __builtin_amdgcn_rcpf(wsf[crow(r, hi)]);
    store_o(o, rli, shm + LDS_OST + wid * 4096, Oh + (long)(wid * 32) * op, op, lane, r32, hi);
    asm volatile("s_waitcnt lgkmcnt(0)\n\ts_barrier" ::: "memory");
}
}
constexpr int NWAVES = 8;
constexpr int DM = 1024, NB = 4, T = 4096, M = NB * T, DEPTH = 4, HD = 64, MIXH = 12, MIXW = 768, MEMH = 4, MEMW = 256, MEMT = 256;
constexpr int FF = 2816, NE = 8, NC0 = 2560, NC1 = 2592, NP0 = 2816, NP1 = 3072;
constexpr int MAXSLOT = 2 * M + NE * 256;
constexpr float LN_EPS = 1e-5f, GN_EPS = 64e-5f, ALPHA = 1.681792830507429f;
constexpr float C2 = 0.125f * 1.4426950408889634f;
typedef unsigned short bf16;

constexpr size_t al256(size_t x) { return (x + 255) & ~(size_t)255; }
constexpr size_t WS_CTL = 0, CTL_ZERO_BYTES = 1u << 20;
constexpr size_t SZ_WIN0 = (size_t)NP0 * DM * 2, SZ_WIN1 = (size_t)NP1 * DM * 2, SZ_WINB = (size_t)DM * DM * 2, SZ_WKV = (size_t)1536 * DM * 2, SZ_WMKV = (size_t)2048 * DM * 2, SZ_WO = (size_t)DM * DM * 2;
constexpr size_t SZ_WGU = (size_t)2 * FF * DM * 2, SZ_WDN = (size_t)DM * FF * 2, SZ_WLORA = (size_t)3072 * 512 * 2;
constexpr size_t WS_WIN0 = CTL_ZERO_BYTES, WS_WIN1 = WS_WIN0 + SZ_WIN0, WS_WIN2 = WS_WIN1 + SZ_WIN1, WS_WIN3 = WS_WIN2 + SZ_WINB, WS_WKV = WS_WIN3 + SZ_WINB, WS_WMKV = WS_WKV + SZ_WKV;
constexpr size_t WS_WO = WS_WMKV + SZ_WMKV, WS_WGU = WS_WO + 4 * SZ_WO, WS_WDN = WS_WGU + 2 * SZ_WGU, WS_WEGU = WS_WDN + 2 * SZ_WDN, WS_WEDN = WS_WEGU + 16 * SZ_WGU, WS_WLORA = WS_WEDN + 16 * SZ_WDN;
constexpr size_t WS_XB = WS_WLORA + 2 * SZ_WLORA, WS_XB1 = WS_XB + (size_t)M * DM * 2, WS_MEMB = WS_XB1 + (size_t)M * DM * 2, WS_MKV = WS_MEMB + (size_t)1024 * DM * 2;
constexpr size_t WS_XF0 = WS_MKV + (size_t)1024 * 2048 * 2, WS_XF1 = WS_XF0 + (size_t)M * DM * 4, WS_PRE = WS_XF1 + (size_t)M * DM * 4, WS_VFIRST = WS_PRE + (size_t)M * DM * 4;
constexpr size_t WS_MIX = WS_VFIRST + (size_t)M * MIXW * 4, WS_KV = WS_MIX + (size_t)M * DM * 2, WS_ROUTE = WS_KV + (size_t)M * 1536 * 2;
constexpr size_t RO_E = 0, RO_W = RO_E + (size_t)M * 4, RO_SLOT = RO_W + (size_t)M * 8, RO_CNTC = RO_SLOT + (size_t)M * 8, RO_TILE = RO_CNTC + 256 * 8 * 4, RO_END = RO_TILE + 256 * 4;
constexpr size_t WS_SCR = al256(WS_ROUTE + RO_END);
constexpr size_t SC_P = 0, SC_U = SC_P + (size_t)M * NP1 * 2, SC_VG = SC_U + (size_t)M * 512 * 2, SC_PUV_END = SC_VG + (size_t)M * MIXW * 4;
constexpr size_t CK_NUNIT = (size_t)NB * MIXH * (T / 64);
constexpr size_t SC_S2IN = 0, SC_S3IN = SC_S2IN + CK_NUNIT * 41216, SC_SU = SC_S3IN + CK_NUNIT * 24576, SC_CK_END = SC_SU + CK_NUNIT * 16384;
constexpr size_t SC_WDEC = al256(SC_PUV_END > SC_CK_END ? SC_PUV_END : SC_CK_END), SC_AI = SC_WDEC + (size_t)M * MIXW * 4, SC_G = SC_AI + (size_t)M * MIXW * 4;
constexpr size_t SC_R = SC_G + (size_t)M * MIXW * 4, SC_K2 = SC_R + (size_t)M * MIXW * 4, SC_V = SC_K2 + (size_t)M * MIXW * 4, SC_KK = SC_V + (size_t)M * MIXW * 4, SC_Y = SC_KK + (size_t)M * MIXW * 4, SC_SRK = SC_Y + (size_t)M * MIXW * 4, SC_MIXEND = SC_SRK + (size_t)M * MIXH * 4;
constexpr size_t SC_H = 0, SC_XG = SC_H + (size_t)MAXSLOT * FF * 2, SC_YE = SC_XG + (size_t)MAXSLOT * DM * 2, SC_FFNEND = SC_YE + (size_t)MAXSLOT * DM * 4;
constexpr size_t WS_END = WS_SCR + (SC_MIXEND > SC_FFNEND ? SC_MIXEND : SC_FFNEND);
constexpr int CW_BAR = 4096;
constexpr int RING_OFF = 0, RING_BYTES = 131072, LDSCTL_OFF = RING_BYTES, MISC_OFF = LDSCTL_OFF + 320, LDS_BYTES = 147456;

#define GAS __attribute__((address_space(1)))
#define LAS __attribute__((address_space(3)))
typedef unsigned v4u __attribute__((ext_vector_type(4)));
typedef float f32x4 __attribute__((ext_vector_type(4)));
typedef GAS unsigned gu32;
#define RLX_AGENT __ATOMIC_RELAXED, __HIP_MEMORY_SCOPE_AGENT
#define LDS_WAIT() asm volatile("s_waitcnt lgkmcnt(0)" ::: "memory")
__device__ __forceinline__ unsigned f2bf(float f) { unsigned u = __builtin_bit_cast(unsigned, f); return (u + 0x7fffu + ((u >> 16) & 1u)) >> 16; }
__device__ __forceinline__ unsigned pk2(float lo, float hi) { return f2bf(lo) | (f2bf(hi) << 16); }
__device__ __forceinline__ float bf2f(unsigned short b) { return __builtin_bit_cast(float, (unsigned)b << 16); }
__device__ __forceinline__ float bflo(unsigned w) { return __builtin_bit_cast(float, w << 16); }
__device__ __forceinline__ float bfhi(unsigned w) { return __builtin_bit_cast(float, w & 0xffff0000u); }
__device__ __forceinline__ int ld_relaxed(const int* p) { return __hip_atomic_load(p, __ATOMIC_RELAXED, __HIP_MEMORY_SCOPE_AGENT); }

#define XB_TMO      128
#define XB_XCNT(j)  (256  + 64 * (j))
#define XB_XSUB(j)  (1280 + 64 * (j))
#define XB_XGEN(j)  (2304 + 64 * (j))
#define XB_TOP      3328
#define XB_TOPGEN   3392
#define XCD_BAR_WORDS 3456
#define XB_SPIN_CAP (1u << 18)
__device__ __forceinline__ unsigned xb_ld(unsigned* p)              { return __hip_atomic_load(p, __ATOMIC_RELAXED, __HIP_MEMORY_SCOPE_AGENT); }
__device__ __forceinline__ unsigned xb_add(unsigned* p, unsigned v) { return __hip_atomic_fetch_add(p, v, __ATOMIC_RELAXED, __HIP_MEMORY_SCOPE_AGENT); }
__device__ __forceinline__ unsigned xb_xcc_id() { return (unsigned)__builtin_amdgcn_s_getreg((3 << 11) | 20) & 0xFu; }
#define XB_SPIN(cond, bar) do { unsigned _sp = 0; while (cond) { __builtin_amdgcn_s_sleep(1); \
    if ((++_sp & 255u) == 0u) { if (xb_ld(&(bar)[XB_TMO])) break; if (_sp > XB_SPIN_CAP) { atomicAdd(&(bar)[XB_TMO], 1u); break; } } } } while (0)
struct XcdBarrier { unsigned* bar; unsigned x; volatile LAS unsigned* st; };
__device__ __forceinline__ XcdBarrier xcd_barrier_post(unsigned* bar, volatile LAS unsigned* st) {
    XcdBarrier b; b.bar = bar; b.x = xb_xcc_id(); b.st = st;
    if (threadIdx.x == 0) (void)xb_add(&bar[XB_XCNT(b.x)], 1u);
    return b;
}
__device__ __forceinline__ void xcd_barrier_complete(unsigned* bar, unsigned x, unsigned& nloc, unsigned& nx) {
    const unsigned G = gridDim.x * gridDim.y * gridDim.z;
    unsigned sum, cnt, mine, sp = 0u;
    for (;;) {
        sum = 0u; cnt = 0u; mine = 0u;
#pragma unroll
        for (unsigned j = 0; j < 16; ++j) { const unsigned c = xb_ld(&bar[XB_XCNT(j)]); sum += c; cnt += (c > 0u) ? 1u : 0u; mine = (j == x) ? c : mine; }
        if (sum == G) break;
        __builtin_amdgcn_s_sleep(1);
        if ((++sp & 255u) == 0u) { if (xb_ld(&bar[XB_TMO])) break; if (sp > XB_SPIN_CAP) { atomicAdd(&bar[XB_TMO], 1u); break; } }
    }
    nloc = mine > 0u ? mine : 1u; nx = cnt > 0u ? cnt : 1u;
}
__device__ __forceinline__ void xcd_barrier(const XcdBarrier& b) {
    asm volatile("s_waitcnt vmcnt(0)" ::: "memory");
    __syncthreads();
    if (threadIdx.x == 0) {
        unsigned* bar = b.bar;
        __builtin_amdgcn_s_waitcnt(0);
        unsigned nloc = b.st[0], nx = b.st[1];
        if (nloc == 0u) { xcd_barrier_complete(bar, b.x, nloc, nx); b.st[0] = nloc; b.st[1] = nx; }
        const unsigned old = xb_add(&bar[XB_XSUB(b.x)], 1u);
        const unsigned gen = old / nloc;
        if (old + 1u == (gen + 1u) * nloc) {
            __builtin_amdgcn_fence(__ATOMIC_RELEASE, "agent");
            asm volatile("s_waitcnt vmcnt(0)" ::: "memory");
            const unsigned og = xb_add(&bar[XB_TOP], 1u);
            const unsigned tg = og / nx;
            if (og + 1u == (tg + 1u) * nx) xb_add(&bar[XB_TOPGEN], 1u);
            else XB_SPIN(xb_ld(&bar[XB_TOPGEN]) == tg, bar);
            __builtin_amdgcn_fence(__ATOMIC_ACQUIRE, "agent");
            xb_add(&bar[XB_XGEN(b.x)], 1u);
            asm volatile("s_waitcnt vmcnt(0)" ::: "memory");
        } else {
            XB_SPIN(xb_ld(&bar[XB_XGEN(b.x)]) == gen, bar);
            __builtin_amdgcn_fence(__ATOMIC_ACQUIRE, "agent");
            asm volatile("s_waitcnt vmcnt(0)" ::: "memory");
        }
    }
    __syncthreads();
}

struct Frame {
    LAS unsigned char* lds;
    unsigned char* ws;
    int tid, lane, wave, vcu, G;
};
typedef __attribute__((address_space(4))) const unsigned char* kptr_t;
__device__ __forceinline__ const float* inp(int k) { kptr_t ka = (kptr_t)__builtin_amdgcn_kernarg_segment_ptr(); asm volatile("" : "+s"(ka)); return *(const float* const __attribute__((address_space(4)))*)(ka + 8 * k); }
#define ENTER(F) do { int t_ = threadIdx.x; asm volatile("" : "+v"(t_)); (F).tid = t_; (F).lane = t_ & 63; (F).wave = __builtin_amdgcn_readfirstlane(t_ >> 6); unsigned char* w_ = (unsigned char*)inp(24); (F).ws = w_; } while (0)
__device__ __forceinline__ float wave_sum(float v) {
#pragma unroll
    for (int o = 1; o < 64; o <<= 1) v += __shfl_xor(v, o);
    return v;
}
template <int CTRL> __device__ __forceinline__ float dpp(float x) { return __builtin_bit_cast(float, __builtin_amdgcn_mov_dpp(__builtin_bit_cast(int, x), CTRL, 0xf, 0xf, true)); }
__device__ __forceinline__ float red16(float x) { x += dpp<0xB1>(x); x += dpp<0x4E>(x); x += dpp<0x141>(x); x += dpp<0x128>(x); return x; }
static_assert(WS_END <= 1476395008ull, "workspace map exceeds the guaranteed d_ws size");
static_assert(SC_CK_END <= SC_WDEC && SC_PUV_END <= SC_WDEC, "chunk records overlay only P | U | VG");
__device__ __forceinline__ void conv_item(const float* W, int K, int N, bf16* WT, int ldt, int drow0, LAS float* scr, int kb, int nb, int lane) {
    const int k0 = 64 * kb, n0 = 32 * nb;
#pragma unroll 8
    for (int i = 0; i < 32; ++i) { const int kk = 2 * i + (lane >> 5); scr[kk * 33 + (lane & 31)] = W[(size_t)(k0 + kk) * N + n0 + (lane & 31)]; }
    LDS_WAIT(); asm volatile("" ::: "memory");
    const int c = lane & 7;
#pragma unroll
    for (int j = 0; j < 4; ++j) { const int n = (lane >> 3) + 8 * j; const LAS float* s = scr + (8 * c) * 33 + n;
        v4u o; o.x = pk2(s[0 * 33], s[1 * 33]); o.y = pk2(s[2 * 33], s[3 * 33]); o.z = pk2(s[4 * 33], s[5 * 33]); o.w = pk2(s[6 * 33], s[7 * 33]);
        *(GAS v4u*)(WT + (size_t)(drow0 + n) * ldt + k0 + 8 * c) = o; }
    LDS_WAIT(); asm volatile("" ::: "memory");
}
__device__ __forceinline__ int swiglu_row(int n0) { const int up = n0 >= FF, h = up ? n0 - FF : n0; return 256 * (h >> 7) + (up ? 128 : 0) + (h & 127); }
__device__ __forceinline__ void conv_mat(const float* W, int K, int N, bf16* WT, int mode, int row_off, LAS float* scr, int r, int lane) {
    const int nblk = N / 32, kb = r / nblk, nb = r % nblk, n0 = 32 * nb;
    const int d0 = mode == 1 ? swiglu_row(n0) : mode == 2 ? (n0 < NC1 ? n0 : n0 - NC1 + NP0) : row_off + n0;
    conv_item(W, K, N, WT, K, d0, scr, kb, nb, lane);
}
__device__ __forceinline__ void p0_prologue(Frame& F) {
    ENTER(F);
    LAS float* scr = (LAS float*)(F.lds + RING_OFF + F.wave * 16384);
    const int gw = F.vcu * NWAVES + F.wave, NGW = F.G * NWAVES;
    unsigned char* ws = F.ws;
    constexpr int I_IN0 = 16 * (NP0 / 32), I_IN1 = 16 * (2848 / 32), I_SQ = 16 * 32, I_KV = 16 * 48, I_MKV = 16 * 16, I_GU = 16 * (2 * FF / 32), I_DN = (FF / 64) * 32;
    constexpr int NITEMS = I_IN0 + I_IN1 + 2 * I_SQ + I_KV + 4 * I_MKV + 4 * I_SQ + 2 * I_GU + 2 * I_DN + 16 * I_GU + 16 * I_DN;
    for (int it = gw; it < NITEMS; it += NGW) {
        int r = it;
        if (r < I_IN0) { conv_mat(inp(2), DM, NP0, (bf16*)(ws + WS_WIN0), 0, 0, scr, r, F.lane); continue; } r -= I_IN0;
        if (r < I_IN1) { conv_mat(inp(3), DM, 2848, (bf16*)(ws + WS_WIN1), 2, 0, scr, r, F.lane); continue; } r -= I_IN1;
        if (r < 2 * I_SQ) { const int j = r / I_SQ; conv_mat(inp(13) + (size_t)j * DM * DM, DM, DM, (bf16*)(ws + WS_WIN2 + j * SZ_WINB), 0, 0, scr, r % I_SQ, F.lane); continue; } r -= 2 * I_SQ;
        if (r < I_KV) { conv_mat(inp(14), DM, 1536, (bf16*)(ws + WS_WKV), 0, 0, scr, r, F.lane); continue; } r -= I_KV;
        if (r < 4 * I_MKV) { const int j = r / I_MKV; conv_mat(inp(15) + (size_t)j * DM * 512, DM, 512, (bf16*)(ws + WS_WMKV), 0, j * 512, scr, r % I_MKV, F.lane); continue; } r -= 4 * I_MKV;
        if (r < 4 * I_SQ) { const int j = r / I_SQ; conv_mat(inp(16) + (size_t)j * DM * DM, DM, DM, (bf16*)(ws + WS_WO + j * SZ_WO), 0, 0, scr, r % I_SQ, F.lane); continue; } r -= 4 * I_SQ;
        if (r < 2 * I_GU) { const int j = r / I_GU; conv_mat(inp(18) + (size_t)j * DM * 2 * FF, DM, 2 * FF, (bf16*)(ws + WS_WGU + j * SZ_WGU), 1, 0, scr, r % I_GU, F.lane); continue; } r -= 2 * I_GU;
        if (r < 2 * I_DN) { const int j = r / I_DN; conv_mat(inp(19) + (size_t)j * FF * DM, FF, DM, (bf16*)(ws + WS_WDN + j * SZ_WDN), 0, 0, scr, r % I_DN, F.lane); continue; } r -= 2 * I_DN;
        if (r < 16 * I_GU) { const int j = r / I_GU; conv_mat(inp(21) + (size_t)j * DM * 2 * FF, DM, 2 * FF, (bf16*)(ws + WS_WEGU + j * SZ_WGU), 1, 0, scr, r % I_GU, F.lane); continue; } r -= 16 * I_GU;
        { const int j = r / I_DN; conv_mat(inp(22) + (size_t)j * FF * DM, FF, DM, (bf16*)(ws + WS_WEDN + j * SZ_WDN), 0, 0, scr, r % I_DN, F.lane); }
    }
    const int gt = F.vcu * (NWAVES * 64) + F.tid, NGT = F.G * NWAVES * 64;
    { GAS v4u* z = (GAS v4u*)(ws + WS_WIN1 + (size_t)NC1 * DM * 2); const int n16 = (NP0 - NC1) * DM * 2 / 16; for (int i = gt; i < n16; i += NGT) z[i] = (v4u){0u, 0u, 0u, 0u}; }
    const float* wup = inp(7); const float* aup = inp(8); const float* gup = inp(9); const float* vup = inp(11);
    for (int i = gt; i < 2 * 3072 * 256; i += NGT) { const int l = i / (3072 * 256), rem = i % (3072 * 256), n = rem / 256, k = (rem % 256) * 2, blk = n / 768, c = n % 768;
        float v0 = 0.f, v1 = 0.f;
        if (blk == 0 && k < 64) { v0 = wup[((size_t)l * 64 + k) * 768 + c]; v1 = wup[((size_t)l * 64 + k + 1) * 768 + c]; }
        else if (blk == 1 && k >= 128 && k < 192) { v0 = aup[((size_t)l * 64 + k - 128) * 768 + c]; v1 = aup[((size_t)l * 64 + k - 127) * 768 + c]; }
        else if (blk == 2 && l == 1 && k >= 256 && k < 288) { v0 = vup[(size_t)(k - 256) * 768 + c]; v1 = vup[(size_t)(k - 255) * 768 + c]; }
        else if (blk == 3 && k >= 384) { v0 = gup[((size_t)l * 128 + k - 384) * 768 + c]; v1 = gup[((size_t)l * 128 + k - 383) * 768 + c]; }
        ((GAS unsigned*)(ws + WS_WLORA))[i] = pk2(v0, v1); }
    { const GAS f32x4* x4 = (const GAS f32x4*)inp(0); GAS v4u* o = (GAS v4u*)(ws + WS_XB);
      for (int i = gt; i < M * DM / 8; i += NGT) { const f32x4 a = x4[2 * i], b = x4[2 * i + 1]; o[i] = (v4u){pk2(a.x, a.y), pk2(a.z, a.w), pk2(b.x, b.y), pk2(b.z, b.w)}; } }
    { const GAS f32x4* x4 = (const GAS f32x4*)inp(1); GAS v4u* o = (GAS v4u*)(ws + WS_MEMB);
      for (int i = gt; i < 1024 * DM / 8; i += NGT) { const f32x4 a = x4[2 * i], b = x4[2 * i + 1]; o[i] = (v4u){pk2(a.x, a.y), pk2(a.z, a.w), pk2(b.x, b.y), pk2(b.z, b.w)}; } }
}

__device__ __forceinline__ float sigmoidf_(float x) { return 1.0f / (1.0f + __expf(-x)); }
__device__ __forceinline__ void ph_lora_in(Frame& F, int l) {
    ENTER(F);
    const int NP = l == 0 ? NP0 : NP1, GD0 = l == 0 ? 2432 : 2464;
    const bf16* P = (const bf16*)(F.ws + WS_SCR + SC_P); bf16* U = (bf16*)(F.ws + WS_SCR + SC_U);
    const float* mu = l == 0 ? inp(4) : inp(5);
    const int gw = F.vcu * NWAVES + F.wave, NGW = F.G * NWAVES;
    const int cu = 8 * F.lane, reg = cu >> 7, off = cu & 127;
    int src = -1, mode = 0;
    if (reg == 0 && off < 64) { src = 2304 + off; mode = 1; }
    else if (reg == 1 && off < 64) { src = 2368 + off; mode = 0; }
    else if (reg == 2 && l == 1 && off < 32) { src = 2432 + off; mode = 0; }
    else if (reg == 3) { src = GD0 + off; mode = 2; }
    for (int m = gw; m < M; m += NGW) {
        v4u o = (v4u){0u, 0u, 0u, 0u};
        if (src >= 0) {
            const v4u pc = *(const GAS v4u*)(P + (size_t)m * NP + src);
            v4u pp = (v4u){0u, 0u, 0u, 0u}; if ((m & (T - 1)) != 0) pp = *(const GAS v4u*)(P + (size_t)(m - 1) * NP + src);
            float v[8];
#pragma unroll
            for (int j = 0; j < 4; ++j) { const float c0 = bflo(pc[j]), c1 = bfhi(pc[j]), q0 = bflo(pp[j]), q1 = bfhi(pp[j]);
                v[2 * j] = c0 + mu[src + 2 * j] * (q0 - c0); v[2 * j + 1] = c1 + mu[src + 2 * j + 1] * (q1 - c1); }
#pragma unroll
            for (int j = 0; j < 8; ++j) { if (mode == 1) v[j] = tanhf(v[j]); else if (mode == 2) v[j] = sigmoidf_(v[j]); }
            o = (v4u){pk2(v[0], v[1]), pk2(v[2], v[3]), pk2(v[4], v[5]), pk2(v[6], v[7])};
        }
        *(GAS v4u*)(U + (size_t)m * 512 + cu) = o;
    }
}
__device__ __forceinline__ void ph_finalize(Frame& F, int l) {
    ENTER(F);
    const int NP = l == 0 ? NP0 : NP1;
    const bf16* P = (const bf16*)(F.ws + WS_SCR + SC_P);
    const float* mu = l == 0 ? inp(4) : inp(5);
    const float* vec = inp(6) + (size_t)l * 6 * MIXW; const float* k_k = vec + 2 * MIXW; const float* k_a = vec + 3 * MIXW; const float* r_k = inp(12) + (size_t)l * MIXW;
    const float* AI = (const float*)(F.ws + WS_SCR + SC_AI); const float* VG = (const float*)(F.ws + WS_SCR + SC_VG);
    float* R = (float*)(F.ws + WS_SCR + SC_R); float* K2 = (float*)(F.ws + WS_SCR + SC_K2); float* V = (float*)(F.ws + WS_SCR + SC_V); float* KK = (float*)(F.ws + WS_SCR + SC_KK);
    float* SRK = (float*)(F.ws + WS_SCR + SC_SRK); float* VF = (float*)(F.ws + WS_VFIRST);
    const int gw = F.vcu * NWAVES + F.wave, NGW = F.G * NWAVES;
    for (int m = gw; m < M; m += NGW) {
        const bool first = (m & (T - 1)) == 0;
        const bf16* pc = P + (size_t)m * NP; const bf16* pp = pc - NP;
        for (int h = 0; h < MIXH; ++h) { const int c = h * 64 + F.lane;
            float r = bf2f(pc[c]), k = bf2f(pc[768 + c]), v = bf2f(pc[1536 + c]);
            const float pr = first ? 0.f : bf2f(pp[c]), pk = first ? 0.f : bf2f(pp[768 + c]), pvv = first ? 0.f : bf2f(pp[1536 + c]);
            r += mu[c] * (pr - r); k += mu[768 + c] * (pk - k); v += mu[1536 + c] * (pvv - v);
            const float a = AI[(size_t)m * MIXW + c];
            float kk = k * k_k[c]; const float nrm = sqrtf(wave_sum(kk * kk)); kk = kk / fmaxf(nrm, 1e-12f);
            const float k2 = k * (1.0f + (a - 1.0f) * k_a[c]);
            if (l == 0) VF[(size_t)m * MIXW + c] = v; else { const float vf = VF[(size_t)m * MIXW + c]; v = v + (vf - v) * VG[(size_t)m * MIXW + c]; }
            const float s = wave_sum(r * k2 * r_k[c]);
            R[(size_t)m * MIXW + c] = r; K2[(size_t)m * MIXW + c] = k2; V[(size_t)m * MIXW + c] = v; KK[(size_t)m * MIXW + c] = kk;
            if (F.lane == 0) SRK[(size_t)m * MIXH + h] = s;
        }
    }
}
__device__ __forceinline__ void ph_gn(Frame& F, int l) {
    ENTER(F);
    const float* vec = inp(6) + (size_t)l * 6 * MIXW; const float* lg = vec + 4 * MIXW; const float* lb = vec + 5 * MIXW;
    const float* Y = (const float*)(F.ws + WS_SCR + SC_Y); const float* V = (const float*)(F.ws + WS_SCR + SC_V); const float* Gt = (const float*)(F.ws + WS_SCR + SC_G); const float* SRK = (const float*)(F.ws + WS_SCR + SC_SRK);
    bf16* MIX = (bf16*)(F.ws + WS_MIX);
    const int gw = F.vcu * NWAVES + F.wave, NGW = F.G * NWAVES;
    for (int m = gw; m < M; m += NGW)
        for (int h = 0; h < MIXH; ++h) { const int c = h * 64 + F.lane;
            const float y = Y[(size_t)m * MIXW + c]; const float mean = wave_sum(y) * (1.0f / 64.0f); const float d = y - mean; const float var = wave_sum(d * d) * (1.0f / 64.0f);
            float o = d * (1.0f / sqrtf(var + GN_EPS)) * lg[c] + lb[c];
            o += SRK[(size_t)m * MIXH + h] * V[(size_t)m * MIXW + c];
            o *= Gt[(size_t)m * MIXW + c];
            MIX[(size_t)m * DM + c] = (bf16)f2bf(o); }
}

__device__ __forceinline__ void ph_ln(Frame& F, int mode, const float* gain, const float* bias, size_t xf_off, size_t xb_off, int to_out, int route, const float* wr) {
    ENTER(F);
    float* XF = to_out ? (float*)inp(23) : (float*)(F.ws + xf_off); bf16* XB = (bf16*)(F.ws + xb_off);
    const float* PRE = (const float*)(F.ws + WS_PRE); const float* XF1 = (const float*)(F.ws + WS_XF1); const float* YE = (const float*)(F.ws + WS_SCR + SC_YE);
    const int* SLOT = (const int*)(F.ws + WS_ROUTE + RO_SLOT); const float* RW = (const float*)(F.ws + WS_ROUTE + RO_W);
    int* RT_E = (int*)(F.ws + WS_ROUTE + RO_E); float* RT_W = (float*)(F.ws + WS_ROUTE + RO_W); int* CNTC = (int*)(F.ws + WS_ROUTE + RO_CNTC);
    LAS int* cnt = (LAS int*)(F.lds + RING_OFF);
    f32x4 gv[4], bv[4];
#pragma unroll
    for (int j = 0; j < 4; ++j) { gv[j] = *(const f32x4*)(gain + 4 * F.lane + 256 * j); bv[j] = *(const f32x4*)(bias + 4 * F.lane + 256 * j); }
    for (int chunk = blockIdx.x; chunk < M / 64; chunk += F.G) {
        if (route) { if (F.tid < NE) cnt[F.tid] = 0; __syncthreads(); }
        for (int rr = 0; rr < 8; ++rr) { const int m = chunk * 64 + F.wave * 8 + rr;
            f32x4 v[4]; float s = 0.f;
            if (mode == 0) {
#pragma unroll
                for (int j = 0; j < 4; ++j) v[j] = *(const GAS f32x4*)(PRE + (size_t)m * DM + 4 * F.lane + 256 * j);
            } else {
                const int s1 = ld_relaxed(SLOT + 2 * m), s2 = ld_relaxed(SLOT + 2 * m + 1); const float w1 = __builtin_bit_cast(float, ld_relaxed((const int*)RW + 2 * m)), w2 = __builtin_bit_cast(float, ld_relaxed((const int*)RW + 2 * m + 1));
#pragma unroll
                for (int j = 0; j < 4; ++j) { const f32x4 x = *(const GAS f32x4*)(XF1 + (size_t)m * DM + 4 * F.lane + 256 * j), y1 = *(const GAS f32x4*)(YE + (size_t)s1 * DM + 4 * F.lane + 256 * j), y2 = *(const GAS f32x4*)(YE + (size_t)s2 * DM + 4 * F.lane + 256 * j);
                    v[j] = x * ALPHA + y1 * w1 + y2 * w2; }
            }
#pragma unroll
            for (int j = 0; j < 4; ++j) s += (v[j].x + v[j].y) + (v[j].z + v[j].w);
            const float mean = wave_sum(s) * (1.f / DM); float s2 = 0.f;
#pragma unroll
            for (int j = 0; j < 4; ++j) { v[j] = v[j] - mean; s2 += (v[j].x * v[j].x + v[j].y * v[j].y) + (v[j].z * v[j].z + v[j].w * v[j].w); }
            const float rstd = 1.f / sqrtf(wave_sum(s2) * (1.f / DM) + LN_EPS);
#pragma unroll
            for (int j = 0; j < 4; ++j) { v[j] = v[j] * rstd * gv[j] + bv[j];
                *(GAS f32x4*)(XF + (size_t)m * DM + 4 * F.lane + 256 * j) = v[j];
                *(GAS unsigned long long*)(XB + (size_t)m * DM + 4 * F.lane + 256 * j) = (unsigned long long)pk2(v[j].x, v[j].y) | ((unsigned long long)pk2(v[j].z, v[j].w) << 32); }
            if (route) {
                float lg[NE];
#pragma unroll
                for (int e = 0; e < NE; ++e) lg[e] = 0.f;
#pragma unroll
                for (int j = 0; j < 4; ++j)
#pragma unroll
                    for (int q = 0; q < 4; ++q) { const int c = 4 * F.lane + 256 * j + q; const f32x4 wa = *(const f32x4*)(wr + (size_t)c * NE), wb = *(const f32x4*)(wr + (size_t)c * NE + 4); const float xv = v[j][q];
                        lg[0] += xv * wa.x; lg[1] += xv * wa.y; lg[2] += xv * wa.z; lg[3] += xv * wa.w; lg[4] += xv * wb.x; lg[5] += xv * wb.y; lg[6] += xv * wb.z; lg[7] += xv * wb.w; }
#pragma unroll
                for (int e = 0; e < NE; ++e) lg[e] = wave_sum(lg[e]);
                int e1 = 0; float b1 = lg[0];
#pragma unroll
                for (int e = 1; e < NE; ++e) if (lg[e] > b1) { b1 = lg[e]; e1 = e; }
                int e2 = -1; float b2 = -INFINITY;
#pragma unroll
                for (int e = 0; e < NE; ++e) if (e != e1 && lg[e] > b2) { b2 = lg[e]; e2 = e; }
                const float w1 = 1.0f / (1.0f + __expf(b2 - b1));
                if (F.lane == 0) { RT_E[m] = e1 | (e2 << 8); RT_W[2 * m] = w1; RT_W[2 * m + 1] = 1.0f - w1; __hip_atomic_fetch_add(&cnt[e1], 1, __ATOMIC_RELAXED, __HIP_MEMORY_SCOPE_WORKGROUP); __hip_atomic_fetch_add(&cnt[e2], 1, __ATOMIC_RELAXED, __HIP_MEMORY_SCOPE_WORKGROUP); }
            }
        }
        if (route) { __syncthreads(); if (F.tid < NE) CNTC[chunk * NE + F.tid] = cnt[F.tid]; __syncthreads(); }
    }
}
__device__ __forceinline__ void ph_route2(Frame& F) {
    ENTER(F);
    const int* CNTC = (const int*)(F.ws + WS_ROUTE + RO_CNTC); const int* RT_E = (const int*)(F.ws + WS_ROUTE + RO_E); int* SLOT = (int*)(F.ws + WS_ROUTE + RO_SLOT); int* TILE = (int*)(F.ws + WS_ROUTE + RO_TILE);
    const bf16* XB1 = (const bf16*)(F.ws + WS_XB1); bf16* XG = (bf16*)(F.ws + WS_SCR + SC_XG);
    LAS int* sh = (LAS int*)(F.lds + RING_OFF);
    for (int chunk = blockIdx.x; chunk < M / 64; chunk += F.G) {
        { const int e = F.wave; int tot = 0, off = 0;
#pragma unroll
          for (int k = 0; k < 4; ++k) { const int c = F.lane + 64 * k; const int v = ld_relaxed(CNTC + c * NE + e); tot += v; off += (c < chunk) ? v : 0; }
          tot = (int)wave_sum((float)tot); off = (int)wave_sum((float)off);
          if (F.lane == 0) { sh[e] = tot; sh[8 + e] = off; } }
        __syncthreads();
        if (F.tid == 0) { int sb = 0; for (int e = 0; e < NE; ++e) { sh[16 + e] = sb; sb += (sh[e] + 255) & ~255; } sh[24] = sb; }
        __syncthreads();
        if (F.wave == 0) { const int m = chunk * 64 + F.lane; const int ee = ld_relaxed(RT_E + m); const int e1 = ee & 0xff, e2 = (ee >> 8) & 0xff;
            const unsigned long long below = (1ull << F.lane) - 1ull; int s1 = 0, s2 = 0;
#pragma unroll
            for (int e = 0; e < NE; ++e) { const unsigned long long m1 = __ballot(e1 == e), m2 = __ballot(e2 == e); const int prior = __popcll(m1 & below) + __popcll(m2 & below);
                const int base = sh[16 + e] + sh[8 + e] + prior; if (e1 == e) s1 = base; if (e2 == e) s2 = base; }
            SLOT[2 * m] = s1; SLOT[2 * m + 1] = s2; sh[32 + 2 * F.lane] = s1; sh[33 + 2 * F.lane] = s2; }
        __syncthreads();
        for (int a = F.wave; a < 128; a += NWAVES) { const int slot = sh[32 + a], m = chunk * 64 + (a >> 1);
            const GAS v4u* s = (const GAS v4u*)(XB1 + (size_t)m * DM); GAS v4u* d = (GAS v4u*)(XG + (size_t)slot * DM);
            d[F.lane] = s[F.lane]; d[64 + F.lane] = s[64 + F.lane]; }
        if (chunk == 0 && F.tid < 256) { const int nt = sh[24] >> 8; int e = 0; for (int q = 1; q < NE; ++q) if (F.tid * 256 >= sh[16 + q]) e = q; TILE[F.tid] = (F.tid == 255) ? nt : e; }
        __syncthreads();
    }
}
namespace ck {
#define CK_LBAR() asm volatile("s_waitcnt lgkmcnt(0)\n\ts_barrier" ::: "memory")
typedef unsigned short bf16;
typedef short bf16x8 __attribute__((ext_vector_type(8)));
typedef float f32x4 __attribute__((ext_vector_type(4)));
typedef float f32x16 __attribute__((ext_vector_type(16)));
typedef unsigned u32x4 __attribute__((ext_vector_type(4)));
typedef unsigned u32x2 __attribute__((ext_vector_type(2)));
typedef LAS bf16* lmat;
constexpr int LD = 72, MATB = 64 * LD * 2;
constexpr int NCH = T / 64, NUNIT = NB * MIXH * NCH;
constexpr size_t S2_AT = 0, S2_MN = 8192, S2_BB = 16384, S2_HK = 24576, S2_HQ = 32768, S2_GC = 40960, S2_BYTES = 41216;
constexpr size_t S3_RT = 0, S3_ARB = 8192, S3_HY = 16384, S3_BYTES = 24576;
constexpr size_t SU_S0 = 0, SU_U = 8192, SU_BYTES = 16384;
__device__ __forceinline__ unsigned pk(float lo, float hi) { typedef float f2 __attribute__((ext_vector_type(2))); typedef __bf16 b2 __attribute__((ext_vector_type(2))); f2 v = {lo, hi}; b2 b = __builtin_convertvector(v, b2); return __builtin_bit_cast(unsigned, b); }
__device__ __forceinline__ int kperm(int p) { const int blk = p & ~15, h = (p >> 3) & 1, e = p & 7; return blk + 8 * (e >> 2) + 4 * h + (e & 3); }
__device__ __forceinline__ void mm(f32x4 (&acc)[2], lmat L, lmat R, int wave, int lane) {
    const int tm = wave >> 1, l15 = lane & 15, kq = lane >> 4;
#pragma unroll
    for (int kk = 0; kk < 2; ++kk) { const bf16x8 a = *(const LAS bf16x8*)(L + (16 * tm + l15) * LD + 32 * kk + 8 * kq);
#pragma unroll
        for (int q = 0; q < 2; ++q) { const bf16x8 b = *(const LAS bf16x8*)(R + (16 * (2 * (wave & 1) + q) + l15) * LD + 32 * kk + 8 * kq); acc[q] = __builtin_amdgcn_mfma_f32_16x16x32_bf16(a, b, acc[q], 0, 0, 0); } }
}
template <int MASK> __device__ __forceinline__ void maskacc(f32x4 (&acc)[2], int wave, int lane) {
    if (MASK == 0) return;
#pragma unroll
    for (int q = 0; q < 2; ++q) { const int n = 16 * (2 * (wave & 1) + q) + (lane & 15);
#pragma unroll
        for (int r = 0; r < 4; ++r) { const int m = 16 * (wave >> 1) + 4 * (lane >> 4) + r; const bool keep = MASK == 1 ? (n < m) : (n <= m); if (!keep) acc[q][r] = 0.f; } }
}
__device__ __forceinline__ void st_rm(lmat D, const f32x4 (&acc)[2], int wave, int lane) {
#pragma unroll
    for (int q = 0; q < 2; ++q) { const int n = 16 * (2 * (wave & 1) + q) + (lane & 15), m0 = 16 * (wave >> 1) + 4 * (lane >> 4);
#pragma unroll
        for (int r = 0; r < 4; ++r) D[(m0 + r) * LD + n] = (bf16)(pk(acc[q][r], 0.f) & 0xffffu); }
}
__device__ __forceinline__ void st_cm(lmat D, const f32x4 (&acc)[2], int wave, int lane) {
#pragma unroll
    for (int q = 0; q < 2; ++q) { const int n = 16 * (2 * (wave & 1) + q) + (lane & 15), m0 = 16 * (wave >> 1) + 4 * (lane >> 4);
        *(LAS u32x2*)(D + n * LD + m0) = (u32x2){pk(acc[q][0], acc[q][1]), pk(acc[q][2], acc[q][3])}; }
}
__device__ __forceinline__ void gst_cm(bf16* G, const f32x4 (&acc)[2], int wave, int lane) {
    if (G == nullptr) return;
#pragma unroll
    for (int q = 0; q < 2; ++q) { const int n = 16 * (2 * (wave & 1) + q) + (lane & 15), m0 = 16 * (wave >> 1) + 4 * (lane >> 4);
        *(GAS u32x2*)(G + n * 64 + m0) = (u32x2){pk(acc[q][0], acc[q][1]), pk(acc[q][2], acc[q][3])}; }
}
template <bool PERM> __device__ __forceinline__ void copy_out(bf16* G, lmat Smat, int tid) {
    if (G == nullptr) return;
    const int row = tid >> 3, p0 = (tid & 7) * 8;
    if (PERM) { unsigned short v[8];
#pragma unroll
        for (int e = 0; e < 8; ++e) v[e] = Smat[row * LD + kperm(p0 + e)];
        *(GAS u32x4*)(G + row * 64 + p0) = (u32x4){(unsigned)v[0] | ((unsigned)v[1] << 16), (unsigned)v[2] | ((unsigned)v[3] << 16), (unsigned)v[4] | ((unsigned)v[5] << 16), (unsigned)v[6] | ((unsigned)v[7] << 16)}; }
    else *(GAS u32x4*)(G + row * 64 + p0) = *(const LAS u32x4*)(Smat + row * LD + p0);
}
__device__ __forceinline__ void copy_in(lmat D, const bf16* G, int tid) { const int row = tid >> 3, p0 = (tid & 7) * 8; *(LAS u32x4*)(D + row * LD + p0) = *(const GAS u32x4*)(G + row * 64 + p0); }

__device__ __forceinline__ void ph_s1(Frame& F, int var) {
    ENTER(F);
    const float* pKK = (const float*)(F.ws + WS_SCR + SC_KK); const float* pAI = (const float*)(F.ws + WS_SCR + SC_AI); const float* pLW = (const float*)(F.ws + WS_SCR + SC_WDEC);
    const float* pK2 = (const float*)(F.ws + WS_SCR + SC_K2); const float* pR = (const float*)(F.ws + WS_SCR + SC_R); const float* pV = (const float*)(F.ws + WS_SCR + SC_V);
    unsigned char* s2in = F.ws + WS_SCR + SC_S2IN; unsigned char* s3in = F.ws + WS_SCR + SC_S3IN;
    LAS unsigned char* base = F.lds + RING_OFF;
#define CKB(k) ((lmat)(base + (k) * MATB))
#define GP(p) ((var & 4) ? (bf16*)nullptr : (bf16*)(p))
    lmat At = CKB(0), Rt = CKB(1), Bh = CKB(2), Kh = CKB(3), VC = CKB(4), KbC = CKB(5), PXr = CKB(6), PXc = CKB(7), AkT = CKB(8), ArkT = CKB(9), ArbT = CKB(10), PYr = CKB(0), PYc = CKB(1), MA = CKB(2), MB = CKB(3);
    LAS float* seg = (LAS float*)(base + 11 * MATB);
    const int j = F.tid & 63, sg = F.wave;
    for (int u = blockIdx.x; u < NUNIT; u += F.G) {
        const int c = u & (NCH - 1), bh = u >> 6, b = bh / MIXH, h = bh % MIXH;
        const size_t g0 = ((size_t)b * T + c * 64 + 8 * sg) * MIXW + h * 64 + j;
        unsigned char* o2 = s2in + (size_t)u * S2_BYTES; unsigned char* o3 = s3in + (size_t)u * S3_BYTES;
        float lw[8], kk[8], ai[8], k2[8], rr[8], vv[8];
#pragma unroll
        for (int q = 0; q < 8; ++q) { const size_t o = g0 + (size_t)q * MIXW; lw[q] = pLW[o]; kk[q] = pKK[o]; ai[q] = pAI[o]; k2[q] = pK2[o]; rr[q] = pR[o]; vv[q] = pV[o]; }
        float pl[8]; { float a = 0.f;
#pragma unroll
            for (int q = 0; q < 8; ++q) { a += lw[q]; pl[q] = a; } }
        seg[sg * 64 + j] = pl[7];
        CK_LBAR();
        float off = 0.f, LC = 0.f;
#pragma unroll
        for (int s = 0; s < 8; ++s) { const float x = seg[s * 64 + j]; LC += x; off += (s < sg) ? x : 0.f; }
        unsigned short at[8], rt[8], bhh[8], khh[8], vb[8], kb[8], bbv[8];
#pragma unroll
        for (int q = 0; q < 8; ++q) { const float L = off + pl[q], Lm1 = L - lw[q]; const float en = __expf(-L), ec = __expf(LC - L), kb_ = kk[q] * ai[q];
            at[q] = (unsigned short)(pk(-kk[q] * __expf(Lm1), 0.f) & 0xffffu); rt[q] = (unsigned short)(pk(rr[q] * __expf(L), 0.f) & 0xffffu);
            bhh[q] = (unsigned short)(pk(kb_ * en, 0.f) & 0xffffu); khh[q] = (unsigned short)(pk(k2[q] * en, 0.f) & 0xffffu);
            bbv[q] = (unsigned short)(pk(kb_ * ec, 0.f) & 0xffffu); kb[q] = (unsigned short)(pk(k2[q] * ec, 0.f) & 0xffffu); vb[q] = (unsigned short)(pk(vv[q], 0.f) & 0xffffu); }
#pragma unroll
        for (int q = 0; q < 8; ++q) { const int t = 8 * sg + q; At[t * LD + j] = at[q]; Rt[t * LD + j] = rt[q]; Bh[t * LD + j] = bhh[q]; Kh[t * LD + j] = khh[q]; }
        *(LAS u32x4*)(VC + j * LD + 8 * sg) = (u32x4){(unsigned)vb[0] | ((unsigned)vb[1] << 16), (unsigned)vb[2] | ((unsigned)vb[3] << 16), (unsigned)vb[4] | ((unsigned)vb[5] << 16), (unsigned)vb[6] | ((unsigned)vb[7] << 16)};
        *(LAS u32x4*)(KbC + j * LD + 8 * sg) = (u32x4){(unsigned)kb[0] | ((unsigned)kb[1] << 16), (unsigned)kb[2] | ((unsigned)kb[3] << 16), (unsigned)kb[4] | ((unsigned)kb[5] << 16), (unsigned)kb[6] | ((unsigned)kb[7] << 16)};
        if (!(var & 4)) {
            bf16* gb = (bf16*)(o2 + S2_BB) + j * 64 + 16 * (sg >> 1) + 4 * (sg & 1);
            *(GAS u32x2*)(gb) = (u32x2){(unsigned)bbv[0] | ((unsigned)bbv[1] << 16), (unsigned)bbv[2] | ((unsigned)bbv[3] << 16)};
            *(GAS u32x2*)(gb + 8) = (u32x2){(unsigned)bbv[4] | ((unsigned)bbv[5] << 16), (unsigned)bbv[6] | ((unsigned)bbv[7] << 16)}; }
        if (sg == 0) ((float*)(o2 + S2_GC))[j] = __expf(LC);
        CK_LBAR();
        if (var & 1) { CK_LBAR(); continue; }
        copy_out<true>(GP(o2 + S2_AT), At, F.tid);
        copy_out<false>(GP(o3 + S3_RT), Rt, F.tid);
        f32x4 mn[2];
        { f32x4 a[2] = {{0.f, 0.f, 0.f, 0.f}, {0.f, 0.f, 0.f, 0.f}}; mm(a, At, Bh, F.wave, F.lane); maskacc<1>(a, F.wave, F.lane); st_rm(PXr, a, F.wave, F.lane); st_cm(PXc, a, F.wave, F.lane); mn[0] = a[0]; mn[1] = a[1]; }
        { f32x4 a[2] = {{0.f, 0.f, 0.f, 0.f}, {0.f, 0.f, 0.f, 0.f}}; mm(a, At, Kh, F.wave, F.lane); maskacc<1>(a, F.wave, F.lane); st_rm(AkT, a, F.wave, F.lane); }
        { f32x4 a[2] = {{0.f, 0.f, 0.f, 0.f}, {0.f, 0.f, 0.f, 0.f}}; mm(a, Rt, Kh, F.wave, F.lane); maskacc<2>(a, F.wave, F.lane); st_rm(ArkT, a, F.wave, F.lane); }
        { f32x4 a[2] = {{0.f, 0.f, 0.f, 0.f}, {0.f, 0.f, 0.f, 0.f}}; mm(a, Rt, Bh, F.wave, F.lane); maskacc<2>(a, F.wave, F.lane); st_rm(ArbT, a, F.wave, F.lane); }
        CK_LBAR();
        copy_out<false>(GP(o3 + S3_ARB), ArbT, F.tid);
        { f32x4 a[2] = {{0.f, 0.f, 0.f, 0.f}, {0.f, 0.f, 0.f, 0.f}}; mm(a, AkT, VC, F.wave, F.lane); gst_cm(GP(o2 + S2_HK), a, F.wave, F.lane); }
        { f32x4 a[2] = {{0.f, 0.f, 0.f, 0.f}, {0.f, 0.f, 0.f, 0.f}}; mm(a, ArkT, VC, F.wave, F.lane); gst_cm(GP(o3 + S3_HY), a, F.wave, F.lane); }
        { f32x4 a[2] = {{0.f, 0.f, 0.f, 0.f}, {0.f, 0.f, 0.f, 0.f}}; mm(a, KbC, VC, F.wave, F.lane); gst_cm(GP(o2 + S2_HQ), a, F.wave, F.lane); }
        lmat Pr_old = PXr, Pc_old = PXc, Pr_new = PYr, Pc_new = PYc, M_old = PXr, M_new = MA;
        if (!(var & 2))
#pragma unroll
        for (int it = 1; it <= 5; ++it) {
            f32x4 p[2] = {{0.f, 0.f, 0.f, 0.f}, {0.f, 0.f, 0.f, 0.f}}; mm(p, Pr_old, Pc_old, F.wave, F.lane);
            st_rm(Pr_new, p, F.wave, F.lane); st_cm(Pc_new, p, F.wave, F.lane);
            CK_LBAR();
            f32x4 a[2] = {mn[0] + p[0], mn[1] + p[1]}; mm(a, M_old, Pc_new, F.wave, F.lane); mn[0] = a[0]; mn[1] = a[1];
            st_rm(M_new, a, F.wave, F.lane);
            CK_LBAR();
            { lmat t1 = Pr_old; Pr_old = Pr_new; Pr_new = t1; t1 = Pc_old; Pc_old = Pc_new; Pc_new = t1; }
            M_old = M_new; M_new = (M_new == MA) ? MB : MA;
        }
        copy_out<true>(GP(o2 + S2_MN), M_old, F.tid);
        CK_LBAR();
    }
#undef CKB
#undef GP
}

__device__ __forceinline__ bf16x8 pack8(const f32x16& x, int s) { const u32x4 w = (u32x4){pk(x[8 * s], x[8 * s + 1]), pk(x[8 * s + 2], x[8 * s + 3]), pk(x[8 * s + 4], x[8 * s + 5]), pk(x[8 * s + 6], x[8 * s + 7])}; return __builtin_bit_cast(bf16x8, w); }
__device__ __forceinline__ void ph_s2(Frame& F, int var) {
    ENTER(F);
    const unsigned char* s2in = F.ws + WS_SCR + SC_S2IN; unsigned char* su = F.ws + WS_SCR + SC_SU;
    LAS unsigned char* base = F.lds + RING_OFF;
    constexpr int BUFB = 5 * MATB + 256;
    const int r32 = F.lane & 31, hi = F.lane >> 5;
    for (int bh = blockIdx.x; bh < NB * MIXH; bh += F.G) {
        f32x16 st[2]; st[0] = f32x16{}; st[1] = f32x16{};
        const int lt = F.tid - 128;
        u32x4 stg[7];
#define S2_IDX(k_) ((lt + 384 * (k_)) < 5 * 512 + 15 ? (lt + 384 * (k_)) : 5 * 512 + 15)
#define S2_LOAD(cc) do { const unsigned char* g_ = s2in + (size_t)(bh * NCH + (cc)) * S2_BYTES; _Pragma("unroll") for (int k_ = 0; k_ < 7; ++k_) stg[k_] = *(const GAS u32x4*)(g_ + (size_t)S2_IDX(k_) * 16); } while (0)
#define S2_WRITE(cc) do { LAS unsigned char* d_ = base + ((cc) & 1) * BUFB; _Pragma("unroll") for (int k_ = 0; k_ < 7; ++k_) { const int idx_ = S2_IDX(k_); const int mtx_ = idx_ >> 9, rem_ = idx_ & 511; \
            const int off_ = idx_ < 5 * 512 ? mtx_ * MATB + (rem_ >> 3) * (LD * 2) + (rem_ & 7) * 16 : 5 * MATB + (idx_ - 5 * 512) * 16; *(LAS u32x4*)(d_ + off_) = stg[k_]; } } while (0)
        if (F.wave >= 2) S2_LOAD(0);
        for (int c = -1; c <= NCH; ++c) {
            if (F.wave >= 2) { if (c + 1 < NCH) S2_WRITE(c + 1); if (c + 2 < NCH) S2_LOAD(c + 2);
                if (c >= 1 && !(var & 1)) {
                    const LAS unsigned char* ob = base + 2 * BUFB + ((c - 1) & 1) * 2 * MATB; unsigned char* so = su + (size_t)(bh * NCH + c - 1) * SU_BYTES;
#pragma unroll
                    for (int k = 0; k < 3; ++k) { const int idx = (lt + 384 * k) < 1023 ? (lt + 384 * k) : 1023; const int mtx = idx >> 9, rem = idx & 511;
                        *(GAS u32x4*)(so + (size_t)idx * 16) = *(const LAS u32x4*)(ob + mtx * MATB + (rem >> 3) * (LD * 2) + (rem & 7) * 16); } } }
            if (F.wave < 2 && c >= 0 && c < NCH && !(var & 2)) {
                const LAS unsigned char* d = base + (c & 1) * BUFB; const int ih = F.wave; const int icol = 32 * ih + r32;
                const lmat AtP = (lmat)d, MnP = (lmat)(d + MATB), BbP = (lmat)(d + 2 * MATB), HkT = (lmat)(d + 3 * MATB), HqT = (lmat)(d + 4 * MATB); const LAS float* gC = (const LAS float*)(d + 5 * MATB);
                LAS unsigned char* ob = base + 2 * BUFB + (c & 1) * 2 * MATB;
#pragma unroll
                for (int jt = 0; jt < 2; ++jt)
#pragma unroll
                    for (int g4 = 0; g4 < 4; ++g4) *(LAS u32x2*)((lmat)ob + icol * LD + 32 * jt + 8 * g4 + 4 * hi) = (u32x2){pk(st[jt][4 * g4], st[jt][4 * g4 + 1]), pk(st[jt][4 * g4 + 2], st[jt][4 * g4 + 3])};
                bf16x8 bs[4];
#pragma unroll
                for (int ks = 0; ks < 4; ++ks) bs[ks] = pack8(st[ks >> 1], ks & 1);
                f32x16 rh[2];
#pragma unroll
                for (int mt = 0; mt < 2; ++mt)
#pragma unroll
                    for (int g4 = 0; g4 < 4; ++g4) { const u32x2 w = *(const LAS u32x2*)(HkT + icol * LD + 32 * mt + 8 * g4 + 4 * hi); rh[mt][4 * g4] = bflo(w.x); rh[mt][4 * g4 + 1] = bfhi(w.x); rh[mt][4 * g4 + 2] = bflo(w.y); rh[mt][4 * g4 + 3] = bfhi(w.y); }
                bf16x8 af[8];
#define S2_AF(Mat) do { _Pragma("unroll") for (int q_ = 0; q_ < 8; ++q_) af[q_] = *(const LAS bf16x8*)((Mat) + (32 * (q_ >> 2) + r32) * LD + 16 * (q_ & 3) + 8 * hi); __builtin_amdgcn_sched_barrier(0); } while (0)
                S2_AF(AtP);
#pragma unroll
                for (int mt = 0; mt < 2; ++mt)
#pragma unroll
                    for (int ks = 0; ks < 4; ++ks) rh[mt] = __builtin_amdgcn_mfma_f32_32x32x16_bf16(af[4 * mt + ks], bs[ks], rh[mt], 0, 0, 0);
                bf16x8 br[4];
#pragma unroll
                for (int ks = 0; ks < 4; ++ks) br[ks] = pack8(rh[ks >> 1], ks & 1);
                f32x16 uu[2]; uu[0] = rh[0]; uu[1] = rh[1];
                S2_AF(MnP);
#pragma unroll
                for (int mt = 0; mt < 2; ++mt)
#pragma unroll
                    for (int ks = 0; ks < 4; ++ks) uu[mt] = __builtin_amdgcn_mfma_f32_32x32x16_bf16(af[4 * mt + ks], br[ks], uu[mt], 0, 0, 0);
#pragma unroll
                for (int mt = 0; mt < 2; ++mt)
#pragma unroll
                    for (int g4 = 0; g4 < 4; ++g4) *(LAS u32x2*)((lmat)(ob + MATB) + icol * LD + 32 * mt + 8 * g4 + 4 * hi) = (u32x2){pk(uu[mt][4 * g4], uu[mt][4 * g4 + 1]), pk(uu[mt][4 * g4 + 2], uu[mt][4 * g4 + 3])};
                bf16x8 bu[4];
#pragma unroll
                for (int ks = 0; ks < 4; ++ks) bu[ks] = pack8(uu[ks >> 1], ks & 1);
#pragma unroll
                for (int jt = 0; jt < 2; ++jt)
#pragma unroll
                    for (int g4 = 0; g4 < 4; ++g4) { const u32x2 w = *(const LAS u32x2*)(HqT + icol * LD + 32 * jt + 8 * g4 + 4 * hi); const f32x4 gc = *(const LAS f32x4*)(gC + 32 * jt + 8 * g4 + 4 * hi);
                        st[jt][4 * g4] = st[jt][4 * g4] * gc.x + bflo(w.x); st[jt][4 * g4 + 1] = st[jt][4 * g4 + 1] * gc.y + bfhi(w.x); st[jt][4 * g4 + 2] = st[jt][4 * g4 + 2] * gc.z + bflo(w.y); st[jt][4 * g4 + 3] = st[jt][4 * g4 + 3] * gc.w + bfhi(w.y); }
                S2_AF(BbP);
#pragma unroll
                for (int jt = 0; jt < 2; ++jt)
#pragma unroll
                    for (int ks = 0; ks < 4; ++ks) st[jt] = __builtin_amdgcn_mfma_f32_32x32x16_bf16(af[4 * jt + ks], bu[ks], st[jt], 0, 0, 0);
#undef S2_AF
            }
            CK_LBAR();
        }
#undef S2_LOAD
#undef S2_WRITE
#undef S2_IDX
    }
}
__device__ __forceinline__ void ph_s3(Frame& F) {
    ENTER(F);
    const unsigned char* s3in = F.ws + WS_SCR + SC_S3IN; const unsigned char* su = F.ws + WS_SCR + SC_SU; float* Y = (float*)(F.ws + WS_SCR + SC_Y);
    LAS unsigned char* base = F.lds + RING_OFF;
    lmat Rt = (lmat)base, S0 = (lmat)(base + MATB), Arb = (lmat)(base + 2 * MATB), Ub = (lmat)(base + 3 * MATB), HyT = (lmat)(base + 4 * MATB);
    for (int u = blockIdx.x; u < NUNIT; u += F.G) {
        const int c = u & (NCH - 1), bh = u >> 6, b = bh / MIXH, h = bh % MIXH;
        const unsigned char* g3 = s3in + (size_t)u * S3_BYTES; const unsigned char* gu = su + (size_t)u * SU_BYTES;
        copy_in(Rt, (const bf16*)(g3 + S3_RT), F.tid); copy_in(Arb, (const bf16*)(g3 + S3_ARB), F.tid); copy_in(HyT, (const bf16*)(g3 + S3_HY), F.tid);
        copy_in(S0, (const bf16*)(gu + SU_S0), F.tid); copy_in(Ub, (const bf16*)(gu + SU_U), F.tid);
        CK_LBAR();
        f32x4 a[2];
#pragma unroll
        for (int q = 0; q < 2; ++q) { const int n = 16 * (2 * (F.wave & 1) + q) + (F.lane & 15), m0 = 16 * (F.wave >> 1) + 4 * (F.lane >> 4); const u32x2 w = *(const LAS u32x2*)(HyT + n * LD + m0); a[q] = (f32x4){bflo(w.x), bfhi(w.x), bflo(w.y), bfhi(w.y)}; }
        mm(a, Rt, S0, F.wave, F.lane); mm(a, Arb, Ub, F.wave, F.lane);
        const size_t y0 = ((size_t)b * T + c * 64) * MIXW + h * 64;
#pragma unroll
        for (int q = 0; q < 2; ++q) { const int n = 16 * (2 * (F.wave & 1) + q) + (F.lane & 15), m0 = 16 * (F.wave >> 1) + 4 * (F.lane >> 4);
#pragma unroll
            for (int r = 0; r < 4; ++r) Y[y0 + (size_t)(m0 + r) * MIXW + n] = a[q][r]; }
        CK_LBAR();
    }
}
}
constexpr int PPL = 14, NPHASE = 1 + PPL * DEPTH;
__host__ __device__ inline bool phase_exists(int ph) {
    if (ph == 0) return true;
    const int l = (ph - 1) / PPL, k = (ph - 1) % PPL; const bool isA = l < 2, moe = l & 1;
    if (k >= 2 && k <= 7) return isA;
    if (k == 10) return moe;
    return true;
}
struct Args { const float* in[23]; float* out; unsigned char* ws; int ph_lo, ph_hi, var, pad; };
struct Order {
    int nM, nN, G, c; const int* tile_e;
    __device__ __forceinline__ bool next(int i, pg8::Unit& u) const { if (!pg8::order_map((long)i * G + c, nM, nN, u.pm, u.pn)) return false;
        int e = 0; if (tile_e) e = __builtin_amdgcn_readfirstlane(ld_relaxed(tile_e + u.pm)); u.bt = e * nN + u.pn; return true; }
};
__global__ void __launch_bounds__(NWAVES * 64, 2) fwd(Args args) {
    extern __shared__ __attribute__((aligned(16))) unsigned char lds[];
    Frame F;
    F.lds = (LAS unsigned char*)lds;
    volatile LAS unsigned* MISC = (volatile LAS unsigned*)(F.lds + MISC_OFF);
    ENTER(F);
    F.G = gridDim.x; { const int bx = blockIdx.x; F.vcu = (F.G % 8 == 0) ? (bx % 8) * (F.G / 8) + bx / 8 : bx; }
    for (int u = F.tid; u < (LDS_BYTES - LDSCTL_OFF) / 4; u += NWAVES * 64) ((LAS unsigned*)(F.lds + LDSCTL_OFF))[u] = 0u;
    __syncthreads();
    const int lo = args.ph_lo, hi = args.ph_hi;
    XcdBarrier bar; bar.bar = (unsigned*)(F.ws + WS_CTL) + CW_BAR; bar.x = 0; bar.st = MISC + 8;
    if (hi - lo > 1) bar = xcd_barrier_post((unsigned*)(F.ws + WS_CTL) + CW_BAR, MISC + 8);
#define IN(k) (lo <= (k) && (k) < hi)
#define SEAM(k) do { if ((k) + 1 < hi) xcd_barrier(bar); } while (0)

    if (IN(0)) { p0_prologue(F); SEAM(0); }

    for (int l = 0; l < DEPTH; ++l) {
        const int pb = 1 + PPL * l; const bool isA = l < 2, moe = (l & 1) != 0;
        const int NP = l == 0 ? NP0 : l == 1 ? NP1 : DM;
        const int QM_OFF = l == 0 ? NC0 : l == 1 ? NP0 : MIXW;
        if (IN(pb)) {
            for (int gi = 0; gi < 2; ++gi) {
                if (gi == 1 && !(l == 0 || l == 2)) break;
                ENTER(F); unsigned char* ws = F.ws;
                pg8::Gemm g; pg8::EpiStore E; Order S; S.G = F.G; S.c = (int)blockIdx.x; S.tile_e = nullptr;
                if (gi == 0) { const size_t wo = l == 0 ? WS_WIN0 : l == 1 ? WS_WIN1 : l == 2 ? WS_WIN2 : WS_WIN3;
                    g = pg8::Gemm{(const bf16*)(ws + WS_XB), (const bf16*)(ws + wo), DM, DM, DM}; S.nM = M / 256; S.nN = NP / 256;
                    E = pg8::EpiStore{(bf16*)(ws + WS_SCR + SC_P), NP, l == 0 ? (1u << 10) : l == 1 ? (1u << 11) : 0xFu, C2}; }
                else if (l == 0) { g = pg8::Gemm{(const bf16*)(ws + WS_MEMB), (const bf16*)(ws + WS_WMKV), DM, DM, DM}; S.nM = 4; S.nN = 8; E = pg8::EpiStore{(bf16*)(ws + WS_MKV), 2048, 0u, 1.f}; }
                else { g = pg8::Gemm{(const bf16*)(ws + WS_XB), (const bf16*)(ws + WS_WKV), DM, DM, DM}; S.nM = M / 256; S.nN = 6; E = pg8::EpiStore{(bf16*)(ws + WS_KV), 1536, 0u, 1.f}; }
                pg8::gemm_phase<pg8::EpiStore, Order>(F.lds + RING_OFF, g, S, E);
            }
            SEAM(pb);
        }
        if (IN(pb + 1)) {
            if (isA) ph_lora_in(F, l);
            else {
                ENTER(F); unsigned char* ws = F.ws;
                unsigned* ctr = (unsigned*)(ws + WS_CTL) + 64 * (8 + l);
                const bf16* KV = (const bf16*)(ws + WS_KV); const bf16* Pb = (const bf16*)(ws + WS_SCR + SC_P); bf16* MIX = (bf16*)(ws + WS_MIX);
                for (;;) {
                    if (F.tid == 0) MISC[16] = atomicAdd(ctr, 1u);
                    __syncthreads(); const int u = (int)MISC[16]; __syncthreads();
                    if (u >= NB * MIXH * 16) break;
                    const int qb = 15 - u / (NB * MIXH), bh = u % (NB * MIXH), b = bh / MIXH, h = bh % MIXH;
                    att::sb_unit(qb, Pb + (size_t)b * T * DM + h * 64, DM, KV + (size_t)b * T * 1536 + h * 64, KV + (size_t)b * T * 1536 + MIXW + h * 64, 1536, MIX + (size_t)b * T * DM + h * 64, DM, (att::lds_ptr)(F.lds + RING_OFF));
                }
            }
            { ENTER(F); unsigned char* ws = F.ws; const bf16* Pb = (const bf16*)(ws + WS_SCR + SC_P); bf16* MIX = (bf16*)(ws + WS_MIX);
              for (int u = blockIdx.x; u < NB * MEMH * 16; u += F.G) { const int b = u >> 6, hm = (u >> 4) & 3, blk = u & 15;
                const bf16* MKV = (const bf16*)(ws + WS_MKV) + (size_t)b * MEMT * 2048 + l * 512 + hm * 64; const size_t row0 = (size_t)b * T + blk * 256;
                att::mem_unit(Pb + row0 * NP + QM_OFF + hm * 64, NP, MKV, MKV + 256, 2048, MIX + row0 * DM + MIXW + hm * 64, DM, (att::lds_ptr)(F.lds + RING_OFF)); } }
            SEAM(pb + 1);
        }
        if (isA) {
            if (IN(pb + 2)) {
                ENTER(F); unsigned char* ws = F.ws;
                pg8::Gemm g{(const bf16*)(ws + WS_SCR + SC_U), (const bf16*)(ws + WS_WLORA + l * SZ_WLORA), 512, 512, 512};
                Order S; S.G = F.G; S.c = (int)blockIdx.x; S.tile_e = nullptr; S.nM = M / 256; S.nN = 12;
                const float* vec = inp(6) + (size_t)l * 6 * MIXW;
                pg8::EpiLora E{(float*)(ws + WS_SCR + SC_WDEC), (SC_AI - SC_WDEC) / 4, ((size_t)WS_SCR + SC_VG - (WS_SCR + SC_WDEC)) / 4, (SC_G - SC_WDEC) / 4, vec, l == 1 ? inp(10) : nullptr};
                pg8::gemm_phase<pg8::EpiLora, Order>(F.lds + RING_OFF, g, S, E);
                SEAM(pb + 2);
            }
            if (IN(pb + 3)) { ph_finalize(F, l); SEAM(pb + 3); }
            if (IN(pb + 4)) { ck::ph_s1(F, args.var); SEAM(pb + 4); }
            if (IN(pb + 5)) { ck::ph_s2(F, args.var); SEAM(pb + 5); }
            if (IN(pb + 6)) { ck::ph_s3(F); SEAM(pb + 6); }
            if (IN(pb + 7)) { ph_gn(F, l); SEAM(pb + 7); }
        }
        if (IN(pb + 8)) {
            ENTER(F); unsigned char* ws = F.ws;
            pg8::Gemm g{(const bf16*)(ws + WS_MIX), (const bf16*)(ws + WS_WO + l * SZ_WO), DM, DM, DM};
            Order S; S.G = F.G; S.c = (int)blockIdx.x; S.tile_e = nullptr; S.nM = M / 256; S.nN = 4;
            pg8::EpiResid E{l == 0 ? inp(0) : (const float*)(ws + WS_XF0), (float*)(ws + WS_PRE), DM, ALPHA};
            pg8::gemm_phase<pg8::EpiResid, Order>(F.lds + RING_OFF, g, S, E);
            SEAM(pb + 8);
        }
        if (IN(pb + 9)) { const float* ln = inp(17) + (size_t)l * 4 * DM; ph_ln(F, 0, ln, ln + DM, WS_XF1, WS_XB1, 0, moe ? 1 : 0, inp(20) + (size_t)(l >> 1) * DM * NE); SEAM(pb + 9); }
        if (moe && IN(pb + 10)) { ph_route2(F); SEAM(pb + 10); }
        if (IN(pb + 11)) {
            ENTER(F); unsigned char* ws = F.ws; const int* TILE = (const int*)(ws + WS_ROUTE + RO_TILE);
            pg8::Gemm g; Order S; S.G = F.G; S.c = (int)blockIdx.x; S.nN = 22;
            if (moe) { g = pg8::Gemm{(const bf16*)(ws + WS_SCR + SC_XG), (const bf16*)(ws + WS_WEGU + (size_t)(l >> 1) * 8 * SZ_WGU), DM, DM, DM}; S.tile_e = TILE; S.nM = __builtin_amdgcn_readfirstlane(ld_relaxed(TILE + 255)); }
            else { g = pg8::Gemm{(const bf16*)(ws + WS_XB1), (const bf16*)(ws + WS_WGU + (size_t)(l >> 1) * SZ_WGU), DM, DM, DM}; S.tile_e = nullptr; S.nM = M / 256; }
            pg8::EpiSwiglu E{(bf16*)(ws + WS_SCR + SC_H), FF};
            pg8::gemm_phase<pg8::EpiSwiglu, Order>(F.lds + RING_OFF, g, S, E);
            SEAM(pb + 11);
        }
        if (IN(pb + 12)) {
            ENTER(F); unsigned char* ws = F.ws; const int* TILE = (const int*)(ws + WS_ROUTE + RO_TILE);
            pg8::Gemm g; Order S; S.G = F.G; S.c = (int)blockIdx.x; S.nN = 4; pg8::EpiResid E;
            if (moe) { g = pg8::Gemm{(const bf16*)(ws + WS_SCR + SC_H), (const bf16*)(ws + WS_WEDN + (size_t)(l >> 1) * 8 * SZ_WDN), FF, FF, FF}; S.tile_e = TILE; S.nM = __builtin_amdgcn_readfirstlane(ld_relaxed(TILE + 255));
                E = pg8::EpiResid{nullptr, (float*)(ws + WS_SCR + SC_YE), DM, 0.f}; }
            else { g = pg8::Gemm{(const bf16*)(ws + WS_SCR + SC_H), (const bf16*)(ws + WS_WDN + (size_t)(l >> 1) * SZ_WDN), FF, FF, FF}; S.tile_e = nullptr; S.nM = M / 256; E = pg8::EpiResid{(const float*)(ws + WS_XF1), (float*)(ws + WS_PRE), DM, ALPHA}; }
            pg8::gemm_phase<pg8::EpiResid, Order>(F.lds + RING_OFF, g, S, E);
            SEAM(pb + 12);
        }
        if (IN(pb + 13)) { const float* ln = inp(17) + (size_t)l * 4 * DM; ph_ln(F, moe ? 1 : 0, ln + 2 * DM, ln + 3 * DM, WS_XF0, WS_XB, l == DEPTH - 1 ? 1 : 0, 0, nullptr); SEAM(pb + 13); }
    }
#undef IN
#undef SEAM
}

#ifndef PROBE_VAR
#define PROBE_VAR 0
#endif
#ifndef PROBE_LIST
#define PROBE_LIST -1
#endif
static const int PROBE_PHS[] = {PROBE_LIST};
#ifndef MK_ONE_LAUNCH
#define MK_ONE_LAUNCH 1
#endif
extern "C" void kernel_launch(void* const* d_in, const int* in_sizes, int n_in, void* d_out, int out_size, void* d_ws, size_t ws_size, hipStream_t stream) {
    static int grid = 0;
    if (grid == 0) {
        if (n_in != 23 || in_sizes[0] != M * DM || out_size != M * DM || ws_size < WS_END) { fprintf(stderr, "kernel_launch: shape/workspace mismatch (n_in %d, ws %zu, need %zu)\n", n_in, ws_size, (size_t)WS_END); grid = -1; return; }
        int dev = 0, cus = 0, per_cu = 0;
        if (hipGetDevice(&dev) != hipSuccess || hipDeviceGetAttribute(&cus, hipDeviceAttributeMultiprocessorCount, dev) != hipSuccess) { grid = -1; return; }
        if (hipFuncSetAttribute((const void*)fwd, hipFuncAttributeMaxDynamicSharedMemorySize, LDS_BYTES) != hipSuccess) { fprintf(stderr, "kernel_launch: hipFuncSetAttribute failed\n"); grid = -1; return; }
        if (hipOccupancyMaxActiveBlocksPerMultiprocessor(&per_cu, (const void*)fwd, NWAVES * 64, LDS_BYTES) != hipSuccess || per_cu < 1) fprintf(stderr, "kernel_launch: occupancy query reports %d\n", per_cu);
        (void)hipGetLastError();
        grid = cus;
    }
    if (grid < 0) return;
    if (hipMemsetAsync((char*)d_ws + WS_CTL, 0, CTL_ZERO_BYTES, stream) != hipSuccess) return;
    Args a{};
    for (int i = 0; i < 23; ++i) a.in[i] = (const float*)d_in[i];
    a.out = (float*)d_out; a.ws = (unsigned char*)d_ws;
    if (MK_ONE_LAUNCH) { a.ph_lo = 0; a.ph_hi = NPHASE; hipLaunchKernelGGL(fwd, dim3(grid), dim3(NWAVES * 64), LDS_BYTES, stream, a); }
    else for (int ph = 0; ph < NPHASE; ++ph) { if (!phase_exists(ph)) continue; a.ph_lo = ph; a.ph_hi = ph + 1;
        int reps = 1; for (int q : PROBE_PHS) if (q == ph) reps = 2;
        for (int r = 0; r < reps; ++r) { if (r) (void)hipMemsetAsync((char*)d_ws + WS_CTL, 0, CTL_ZERO_BYTES, stream); a.var = (reps == 2 && r == 0) ? PROBE_VAR : 0; hipLaunchKernelGGL(fwd, dim3(grid), dim3(NWAVES * 64), LDS_BYTES, stream, a); } }
}
```

```cpp
#include <hip/hip_runtime.h>
#include <cstdio>
#include <cstdint>
#include <cmath>
#define MK_ONE_LAUNCH 1
#define PROBE_LIST -1
#define PROBE_VAR 0
namespace pg8 {
#define PG8_LAS __attribute__((address_space(3)))
typedef unsigned short bf16_t;
typedef short bf16x8 __attribute__((ext_vector_type(8)));
typedef float f32x4 __attribute__((ext_vector_type(4)));
typedef float f32x2 __attribute__((ext_vector_type(2)));
typedef unsigned u32x4 __attribute__((ext_vector_type(4)));
typedef unsigned u32x2 __attribute__((ext_vector_type(2)));
constexpr int BM = 256, BK = 64, HALF = 128, HTB = HALF * BK * 2, STAGE_BYTES = 8 * HTB, NXCD = 8, WGM = 8;

__host__ __device__ __forceinline__ int lds_byte(int r, int c) { const int st = (r >> 4) * 2 + (c >> 5), rr = r & 15, cc = c & 31, ob = rr * 64 + cc * 2; return st * 1024 + (ob ^ (((ob >> 9) & 1) << 5)); }
__host__ __device__ __forceinline__ void stage_rc(int b, int& R, int& C) { const int st = b / 1024, sb = b % 1024, swz = sb ^ (((sb >> 9) & 1) << 5); R = (st >> 1) * 16 + swz / 64; C = (st & 1) * 32 + (swz % 64) / 2; }
__host__ __device__ __forceinline__ int perm32(int rho) { const int n = rho >> 4, i = rho & 15; return 8 * (i >> 2) + 4 * n + (i & 3); }

struct Unit { int pm, pn, bt; };
struct Gemm { const bf16_t* A; const bf16_t* Bt; int lda, ldb, K; };

__device__ __forceinline__ bool order_map(long L, int nM, int nN, int& pm, int& pn) {
    const int nwg = nM * nN; if (L >= nwg) return false;
    int wgid = (int)L; { const int q = nwg / NXCD, r = nwg % NXCD, xcd = wgid % NXCD, off = wgid / NXCD; wgid = (xcd < r ? xcd * (q + 1) : r * (q + 1) + (xcd - r) * q) + off; }
    const int nig = WGM * nN, gid = wgid / nig, fm = gid * WGM, gsz = (nM - fm) < WGM ? (nM - fm) : WGM;
    pm = fm + ((wgid % nig) % gsz); pn = (wgid % nig) / gsz; return true;
}
struct StaticOrder {
    int nM, nN, G, c;
    __device__ void init(int M, int N, int G_, int c_) { nM = M / BM; nN = N / BM; G = G_; c = c_; }
    __device__ __forceinline__ bool next(int i, Unit& u) const { if (!order_map((long)i * G + c, nM, nN, u.pm, u.pn)) return false; u.bt = u.pn; return true; }
};
struct MoeOrder {
    int nM, nN, G, c; const int* tile_e;
    __device__ __forceinline__ bool next(int i, Unit& u) const { if (!order_map((long)i * G + c, nM, nN, u.pm, u.pn)) return false;
        const int e = __builtin_amdgcn_readfirstlane(__hip_atomic_load(tile_e + u.pm, __ATOMIC_RELAXED, __HIP_MEMORY_SCOPE_AGENT)); u.bt = e * nN + u.pn; return true; }
};

__device__ __forceinline__ unsigned cvt_pk_bf16(float lo, float hi) { unsigned r; asm volatile("v_cvt_pk_bf16_f32 %0, %1, %2" : "=v"(r) : "v"(lo), "v"(hi)); return r; }

struct EpiStore {
    static constexpr bool PERM = true;
    bf16_t* O; int ldc; unsigned scale_mask; float scale;
    __device__ __forceinline__ void operator()(const f32x4 (&acc)[2][2][4][2], const Unit& u, int wr, int wc, int fr, int fq) const {
        const int row0 = u.pm * BM + wr * 64 + fr, col0 = u.pn * BM + wc * 32 + 8 * fq;
        const float sc = ((scale_mask >> u.pn) & 1u) ? scale : 1.f;
#pragma unroll
        for (int ai = 0; ai < 2; ++ai)
#pragma unroll
            for (int m = 0; m < 4; ++m) { bf16_t* rowp = O + (size_t)(row0 + ai * HALF + m * 16) * ldc + col0;
#pragma unroll
                for (int bj = 0; bj < 2; ++bj) { const f32x4 v0 = acc[ai][bj][m][0] * sc, v1 = acc[ai][bj][m][1] * sc;
                    u32x4 w; w.x = cvt_pk_bf16(v0[0], v0[1]); w.y = cvt_pk_bf16(v0[2], v0[3]); w.z = cvt_pk_bf16(v1[0], v1[1]); w.w = cvt_pk_bf16(v1[2], v1[3]);
                    *(u32x4*)(rowp + bj * HALF) = w; } }
    }
};
__device__ __forceinline__ float silu_mul(float g, float u) { return g * u * __builtin_amdgcn_rcpf(1.0f + __builtin_amdgcn_exp2f(-1.4426950408889634f * g)); }
struct EpiSwiglu {
    static constexpr bool PERM = true;
    bf16_t* H; int ldc;
    __device__ __forceinline__ void operator()(const f32x4 (&acc)[2][2][4][2], const Unit& u, int wr, int wc, int fr, int fq) const {
        const int row0 = u.pm * BM + wr * 64 + fr, col0 = u.pn * HALF + wc * 32 + 8 * fq;
#pragma unroll
        for (int ai = 0; ai < 2; ++ai)
#pragma unroll
            for (int m = 0; m < 4; ++m) { bf16_t* rowp = H + (size_t)(row0 + ai * HALF + m * 16) * ldc + col0;
                const f32x4 g0 = acc[ai][0][m][0], g1 = acc[ai][0][m][1], u0 = acc[ai][1][m][0], u1 = acc[ai][1][m][1];
                u32x4 w; w.x = cvt_pk_bf16(silu_mul(g0[0], u0[0]), silu_mul(g0[1], u0[1])); w.y = cvt_pk_bf16(silu_mul(g0[2], u0[2]), silu_mul(g0[3], u0[3]));
                w.z = cvt_pk_bf16(silu_mul(g1[0], u1[0]), silu_mul(g1[1], u1[1])); w.w = cvt_pk_bf16(silu_mul(g1[2], u1[2]), silu_mul(g1[3], u1[3]));
                *(u32x4*)rowp = w; }
    }
};
struct EpiResid {
    static constexpr bool PERM = false;
    const float* base; float* out; int ldc; float alpha;
    __device__ __forceinline__ void operator()(const f32x4 (&acc)[2][2][4][2], const Unit& u, int wr, int wc, int fr, int fq) const {
        const int row0 = u.pm * BM + wr * 64 + fr, col0 = u.pn * BM + wc * 32 + 4 * fq;
#pragma unroll
        for (int ai = 0; ai < 2; ++ai)
#pragma unroll
            for (int m = 0; m < 4; ++m) { const size_t off = (size_t)(row0 + ai * HALF + m * 16) * ldc + col0;
#pragma unroll
                for (int bj = 0; bj < 2; ++bj)
#pragma unroll
                    for (int n = 0; n < 2; ++n) { f32x4 o = acc[ai][bj][m][n];
                        if (base) { const f32x4 bs = *(const f32x4*)(base + off + bj * HALF + n * 16); o = o + bs * alpha; }
                        *(f32x4*)(out + off + bj * HALF + n * 16) = o; } }
    }
};
struct EpiLora {
    static constexpr bool PERM = false;
    float* out0; size_t off1, off2, off3; const float* vec; const float* v0;
    __device__ __forceinline__ void operator()(const f32x4 (&acc)[2][2][4][2], const Unit& u, int wr, int wc, int fr, int fq) const {
        const int blk = u.pn / 3, cb0 = (u.pn - 3 * blk) * BM + wc * 32 + 4 * fq, row0 = u.pm * BM + wr * 64 + fr;
        if (blk == 2 && v0 == nullptr) return;
        float* outp = out0 + (blk == 0 ? (size_t)0 : blk == 1 ? off1 : blk == 2 ? off2 : off3);
        const float* bias = blk == 2 ? v0 : vec + (blk & 1) * 768;
#pragma unroll
        for (int bj = 0; bj < 2; ++bj)
#pragma unroll
            for (int n = 0; n < 2; ++n) { const int cb = cb0 + bj * HALF + n * 16;
                f32x4 bv = (f32x4){0.f, 0.f, 0.f, 0.f}; if (blk < 3) bv = *(const f32x4*)(bias + cb);
#pragma unroll
                for (int ai = 0; ai < 2; ++ai)
#pragma unroll
                    for (int m = 0; m < 4; ++m) { f32x4 v = acc[ai][bj][m][n] + bv, o;
#pragma unroll
                        for (int j = 0; j < 4; ++j) { const float d = v[j]; float r;
                            if (blk == 0) { const float sp = fmaxf(-d, 0.f) + __logf(1.0f + __expf(-fabsf(d)));
                                r = -__expf(-sp - 0.5f); }
                            else if (blk == 3) r = d;
                            else r = 1.0f / (1.0f + __expf(-d));
                            o[j] = r; }
                        *(f32x4*)(outp + (size_t)(row0 + ai * HALF + m * 16) * 768 + cb) = o; } }
    }
};

template <class Epi, class Sched>
__device__ __forceinline__ void gemm_phase(PG8_LAS unsigned char* lds, const Gemm g, const Sched& S, const Epi& E) {
    int tid = threadIdx.x; asm volatile("" : "+v"(tid));
    const int wid = __builtin_amdgcn_readfirstlane(tid >> 6), lane = tid & 63, wr = wid >> 2, wc = wid & 3, fr = lane & 15, fq = lane >> 4;
    const int K = g.K, nt = K / BK;
    unsigned voffA[2], voffB[2];
#pragma unroll
    for (int i = 0; i < 2; ++i) { int R, C; stage_rc(tid * 16 + i * 8192, R, C); const int Rb = Epi::PERM ? ((R & ~31) + perm32(R & 31)) : R;
        voffA[i] = (unsigned)(R * g.lda + C) * 2u; voffB[i] = (unsigned)(Rb * g.ldb + C) * 2u; }
    const size_t kstep = (size_t)(BK * 2);
    const size_t hstepA = (size_t)HALF * g.lda * 2, hstepB = (size_t)HALF * g.ldb * 2;
    const size_t tstepA = 2 * hstepA, tstepB = 2 * hstepB;
    const unsigned ldsw = (unsigned)wid * 1024u;
    const int aoff = lds_byte(wr * 64 + fr, fq * 8), boff = lds_byte(wc * 32 + fr, fq * 8);
#define PG8_SA(b, h) (((b) * 2 + (h)) * HTB)
#define PG8_SB(b, h) ((4 + (b) * 2 + (h)) * HTB)
#define PG8_STAGE(bufoff, gbase, voff) do { _Pragma("unroll") for (int _i = 0; _i < 2; ++_i) \
        __builtin_amdgcn_global_load_lds((const unsigned*)((const char*)(gbase) + (voff)[_i]), (PG8_LAS unsigned*)(lds + (bufoff) + ldsw + _i * 8192), 16, 0, 0); } while (0)
#define PG8_LDA(dst, b, h) do { _Pragma("unroll") for (int m = 0; m < 4; ++m) _Pragma("unroll") for (int k = 0; k < 2; ++k) dst[m][k] = *(const PG8_LAS bf16x8*)(lds + PG8_SA(b, h) + aoff + m * 2048 + k * 1024); } while (0)
#define PG8_LDB(dst, b, h) do { _Pragma("unroll") for (int n = 0; n < 2; ++n) _Pragma("unroll") for (int k = 0; k < 2; ++k) dst[n][k] = *(const PG8_LAS bf16x8*)(lds + PG8_SB(b, h) + boff + n * 2048 + k * 1024); } while (0)
#define PG8_MMA(ai, bj, At, Bt) do { __builtin_amdgcn_s_setprio(1); _Pragma("unroll") for (int m = 0; m < 4; ++m) _Pragma("unroll") for (int n = 0; n < 2; ++n) _Pragma("unroll") for (int k = 0; k < 2; ++k) \
        acc[ai][bj][m][n] = __builtin_amdgcn_mfma_f32_16x16x32_bf16(Bt[n][k], At[m][k], acc[ai][bj][m][n], 0, 0, 0); __builtin_amdgcn_s_setprio(0); } while (0)
#define PG8_WAIT_V(n) asm volatile("s_waitcnt vmcnt(" #n ")" ::: "memory")
#define PG8_WAIT_L(n) asm volatile("s_waitcnt lgkmcnt(" #n ")" ::: "memory")
#define PG8_BAR __builtin_amdgcn_s_barrier()
#define PG8_SCHED __builtin_amdgcn_sched_barrier(0)
    Unit cur, nxt; int ui = 0;
    if (!S.next(0, cur)) return;
    f32x4 acc[2][2][4][2];
#pragma unroll
    for (int a = 0; a < 2; ++a)
#pragma unroll
        for (int b = 0; b < 2; ++b)
#pragma unroll
            for (int m = 0; m < 4; ++m)
#pragma unroll
                for (int n = 0; n < 2; ++n) acc[a][b][m][n] = (f32x4){0.f, 0.f, 0.f, 0.f};
    bf16x8 At[4][2], B0[2][2], B1[2][2];
    const char* cA = (const char*)g.A + (size_t)cur.pm * tstepA; const char* cB = (const char*)g.Bt + (size_t)cur.bt * tstepB;
    PG8_STAGE(PG8_SB(0, 0), cB, voffB); PG8_STAGE(PG8_SB(0, 1), cB + hstepB, voffB); PG8_STAGE(PG8_SA(0, 0), cA, voffA); PG8_STAGE(PG8_SA(0, 1), cA + hstepA, voffA);
    if (wr == 1) PG8_BAR;
    PG8_WAIT_V(2); PG8_BAR;
    PG8_STAGE(PG8_SB(1, 0), cB + kstep, voffB); PG8_STAGE(PG8_SA(1, 0), cA + kstep, voffA); PG8_STAGE(PG8_SB(1, 1), cB + hstepB + kstep, voffB);
    PG8_WAIT_V(6); PG8_BAR;
    for (;;) {
        const bool has_next = S.next(ui + 1, nxt);
        const char* nA = has_next ? (const char*)g.A + (size_t)nxt.pm * tstepA : cA; const char* nB = has_next ? (const char*)g.Bt + (size_t)nxt.bt * tstepB : cB;
        for (int t = 0; t < nt; t += 2) {
            const bool last = (t == nt - 2);
            const char* a1 = cA + (size_t)(t + 1) * kstep;
            const char* a2 = last ? nA : cA + (size_t)(t + 2) * kstep; const char* b2 = last ? nB : cB + (size_t)(t + 2) * kstep;
            const char* a3 = a2 + kstep; const char* b3 = b2 + kstep;
            PG8_LDB(B0, 0, 0); PG8_LDB(B1, 0, 1); PG8_SCHED; PG8_LDA(At, 0, 0); PG8_STAGE(PG8_SA(1, 1), a1 + hstepA, voffA);
            PG8_WAIT_V(8); PG8_WAIT_L(0); PG8_BAR; PG8_MMA(0, 0, At, B0); PG8_MMA(0, 1, At, B1); PG8_BAR; PG8_SCHED;
            PG8_LDA(At, 0, 1); PG8_STAGE(PG8_SB(0, 0), b2, voffB); PG8_STAGE(PG8_SB(0, 1), b2 + hstepB, voffB); PG8_STAGE(PG8_SA(0, 0), a2, voffA);
            PG8_WAIT_V(8); PG8_WAIT_L(0); PG8_BAR; PG8_MMA(1, 0, At, B0); PG8_MMA(1, 1, At, B1); PG8_BAR; PG8_SCHED;
            PG8_LDB(B0, 1, 0); PG8_LDB(B1, 1, 1); PG8_SCHED; PG8_LDA(At, 1, 0); PG8_STAGE(PG8_SA(0, 1), a2 + hstepA, voffA);
            PG8_WAIT_V(8); PG8_WAIT_L(0); PG8_BAR; PG8_MMA(0, 0, At, B0); PG8_MMA(0, 1, At, B1); PG8_BAR; PG8_SCHED;
            PG8_LDA(At, 1, 1); PG8_STAGE(PG8_SB(1, 0), b3, voffB); PG8_STAGE(PG8_SB(1, 1), b3 + hstepB, voffB); PG8_STAGE(PG8_SA(1, 0), a3, voffA);
            PG8_WAIT_V(8); PG8_WAIT_L(0); PG8_BAR; PG8_MMA(1, 0, At, B0); PG8_MMA(1, 1, At, B1); PG8_BAR; PG8_SCHED;
        }
        if (wr == 0) PG8_BAR;
        E(acc, cur, wr, wc, fr, fq);
        if (!has_next) break;
#pragma unroll
        for (int a = 0; a < 2; ++a)
#pragma unroll
            for (int b = 0; b < 2; ++b)
#pragma unroll
                for (int m = 0; m < 4; ++m)
#pragma unroll
                    for (int n = 0; n < 2; ++n) acc[a][b][m][n] = (f32x4){0.f, 0.f, 0.f, 0.f};
        cur = nxt; cA = nA; cB = nB; ++ui;
        if (wr == 1) PG8_BAR;
    }
    PG8_WAIT_V(0);
    PG8_BAR;
#undef PG8_SA
#undef PG8_SB
#undef PG8_STAGE
#undef PG8_LDA
#undef PG8_LDB
#undef PG8_MMA
#undef PG8_WAIT_V
#undef PG8_WAIT_L
#undef PG8_BAR
#undef PG8_SCHED
}
}
namespace att {
using bf16 = unsigned short;
using bf16x8 = __attribute__((ext_vector_type(8))) short;
using s16x4 = __attribute__((ext_vector_type(4))) short;
using f32x16 = __attribute__((ext_vector_type(16))) float;
using u32x4 = __attribute__((ext_vector_type(4))) unsigned;
typedef short v4i16_t __attribute__((ext_vector_type(4)));
typedef __attribute__((address_space(3))) const char* lds_cptr;
typedef __attribute__((address_space(3))) char* lds_ptr;
typedef float f32x2_t __attribute__((ext_vector_type(2))); typedef __bf16 bf16x2_t __attribute__((ext_vector_type(2)));
__device__ __forceinline__ int crow(int r, int hi) { return (r & 3) + 8 * (r >> 2) + 4 * hi; }
__device__ __forceinline__ unsigned cvtpk_s(float lo, float hi) { f32x2_t v = {lo, hi}; bf16x2_t b = __builtin_convertvector(v, bf16x2_t); return __builtin_bit_cast(unsigned, b); }
#define ATT_SBAR() __builtin_amdgcn_sched_barrier(0)
#define ATT_WAIT_BAR(N) asm volatile("s_waitcnt vmcnt(" #N ") lgkmcnt(0)\n\ts_barrier" ::: "memory")
constexpr int SLOTB = 8192;
__device__ __forceinline__ void glds16(const void* gsrc, unsigned lds_dst) { unsigned keep;
    asm volatile("s_mov_b32 %0, m0\n\ts_mov_b32 m0, %2\n\ts_nop 0\n\tglobal_load_lds_dwordx4 %1, off\n\ts_mov_b32 m0, %0" : "=&s"(keep) : "v"(gsrc), "s"(lds_dst) : "memory"); }
__device__ __forceinline__ void dma_k(const bf16* ktile, int pitch, unsigned slot_lds, int wid, int lane) {
    glds16(ktile + (long)lane * pitch + wid * 8, (unsigned)__builtin_amdgcn_readfirstlane(slot_lds + wid * 1024)); }
__device__ __forceinline__ void dma_v(const bf16* vtile, int pitch, unsigned slot_lds, int wid, int lane) {
    glds16(vtile + (long)(16 * (wid & 3) + (lane >> 2)) * pitch + (wid >> 2) * 32 + (lane & 3) * 8, (unsigned)__builtin_amdgcn_readfirstlane(slot_lds + wid * 1024)); }
__device__ __forceinline__ void qkt(f32x16& p0, f32x16& p1, lds_cptr Kslot, const bf16x8* qr, int r32, int hi) {
    lds_cptr kb = Kslot + hi * 1024 + r32 * 16;
    const f32x16 z = {};
#pragma unroll
    for (int d0 = 0; d0 < 4; ++d0) {
        const bf16x8 b0 = *(const __attribute__((address_space(3))) bf16x8*)(kb + d0 * 2048);
        const bf16x8 b1 = *(const __attribute__((address_space(3))) bf16x8*)(kb + d0 * 2048 + 512);
        if (d0 == 0) { p0 = __builtin_amdgcn_mfma_f32_32x32x16_bf16(b0, qr[0], z, 0, 0, 0); p1 = __builtin_amdgcn_mfma_f32_32x32x16_bf16(b1, qr[0], z, 0, 0, 0); }
        else { p0 = __builtin_amdgcn_mfma_f32_32x32x16_bf16(b0, qr[d0], p0, 0, 0, 0); p1 = __builtin_amdgcn_mfma_f32_32x32x16_bf16(b1, qr[d0], p1, 0, 0, 0); } }
}
__device__ __forceinline__ s16x4 vtr(lds_cptr p) { return __builtin_bit_cast(s16x4, __builtin_amdgcn_ds_read_tr16_b64_v4i16((__attribute__((address_space(3))) v4i16_t*)p)); }
__device__ __forceinline__ void pv(f32x16* o, lds_cptr vp, bf16x8 pa0, bf16x8 pa1, bf16x8 pa2, bf16x8 pa3) {
#pragma unroll
    for (int d0 = 0; d0 < 2; ++d0) { s16x4 lo[4], hi[4];
#pragma unroll
        for (int ks = 0; ks < 4; ++ks) { lo[ks] = vtr(vp + d0 * 4096 + ks * 1024); hi[ks] = vtr(vp + d0 * 4096 + ks * 1024 + 512); }
#define ATT_PK(k) (bf16x8){lo[k][0], lo[k][1], lo[k][2], lo[k][3], hi[k][0], hi[k][1], hi[k][2], hi[k][3]}
        o[d0] = __builtin_amdgcn_mfma_f32_32x32x16_bf16(pa0, ATT_PK(0), o[d0], 0, 0, 0);
        o[d0] = __builtin_amdgcn_mfma_f32_32x32x16_bf16(pa1, ATT_PK(1), o[d0], 0, 0, 0);
        o[d0] = __builtin_amdgcn_mfma_f32_32x32x16_bf16(pa2, ATT_PK(2), o[d0], 0, 0, 0);
        o[d0] = __builtin_amdgcn_mfma_f32_32x32x16_bf16(pa3, ATT_PK(3), o[d0], 0, 0, 0);
#undef ATT_PK
    }
}
__device__ __forceinline__ float swap_lo(float x, float& hi_out) { auto rr = __builtin_amdgcn_permlane32_swap(__float_as_uint(x), __float_as_uint(x), false, false); hi_out = __uint_as_float(rr[1]); return __uint_as_float(rr[0]); }
#define ATT_PKW(P, B) cvtpk_s(P[B], P[B + 1])
#define ATT_PACK4(P0, P1, w0, w1, w2, w3) do { w0 = (u32x4){ATT_PKW(P0, 0), ATT_PKW(P0, 2), ATT_PKW(P0, 4), ATT_PKW(P0, 6)}; w1 = (u32x4){ATT_PKW(P0, 8), ATT_PKW(P0, 10), ATT_PKW(P0, 12), ATT_PKW(P0, 14)}; \
    w2 = (u32x4){ATT_PKW(P1, 0), ATT_PKW(P1, 2), ATT_PKW(P1, 4), ATT_PKW(P1, 6)}; w3 = (u32x4){ATT_PKW(P1, 8), ATT_PKW(P1, 10), ATT_PKW(P1, 12), ATT_PKW(P1, 14)}; } while (0)
__device__ __forceinline__ void store_o(const f32x16* o, const float* rscale, lds_ptr stg, bf16* Ow, int pitch, int lane, int r32, int hi) {
    __attribute__((address_space(3))) bf16* s = (__attribute__((address_space(3))) bf16*)stg;
#pragma unroll
    for (int r = 0; r < 16; ++r) { const int orow = crow(r, hi);
#pragma unroll
        for (int d0 = 0; d0 < 2; ++d0) { const float v = o[d0][r] * rscale[r]; s[orow * 64 + d0 * 32 + r32] = (bf16)(cvtpk_s(v, v) & 0xffffu); } }
    asm volatile("s_waitcnt lgkmcnt(0)" ::: "memory");
#pragma unroll
    for (int i = 0; i < 4; ++i) { const int row = i * 8 + (lane >> 3), ch = lane & 7; const u32x4 v = *(const __attribute__((address_space(3))) u32x4*)(s + row * 64 + ch * 8); *(u32x4*)(Ow + (long)row * pitch + ch * 8) = v; }
}

constexpr int LDS_K = 0, LDS_V = 4 * SLOTB, LDS_WS = 8 * SLOTB, LDS_OST = LDS_WS + 8 * 256, ATT_LDS_BYTES = LDS_OST + 8 * 4096;

__device__ __forceinline__ void sb_unit(int qb, const bf16* Qh, int qp, const bf16* Kh, const bf16* Vh, int kp, bf16* Oh, int op, lds_ptr shm) {
    int tid = threadIdx.x; asm volatile("" : "+v"(tid)); const int lane = tid & 63, r32 = lane & 31, hi = lane >> 5; const int wid = __builtin_amdgcn_readfirstlane(tid >> 6);
    const unsigned lds0 = (unsigned)(size_t)shm;
    const int q0w = qb * 256 + wid * 32;
    const int NT = 4 * qb + 4;
    const lds_cptr kp0 = (lds_cptr)shm + LDS_K, vp0 = (lds_cptr)shm + LDS_V + ((lane >> 4) & 1) * 32 + (lane & 3) * 8 + (4 * hi + ((lane & 15) >> 2)) * 64;
    { const int t = NT - 1, s = t & 1; dma_k(Kh + (long)t * 64 * kp, kp, lds0 + LDS_K + s * SLOTB, wid, lane); dma_v(Vh + (long)t * 64 * kp, kp, lds0 + LDS_V + s * SLOTB, wid, lane); }
    bf16x8 qr[4];
#pragma unroll
    for (int d0 = 0; d0 < 4; ++d0) qr[d0] = *(const bf16x8*)(Qh + (long)(q0w + r32) * qp + d0 * 16 + hi * 8);
    f32x16 o[2]; o[0] = f32x16{}; o[1] = f32x16{};
    float carry = 1.0f;
    const int qabs = q0w + r32;
    for (int t = NT - 1; t >= 0; --t) {
        ATT_WAIT_BAR(0);
        if (t > 0) { const int s = (t - 1) & 1; dma_k(Kh + (long)(t - 1) * 64 * kp, kp, lds0 + LDS_K + s * SLOTB, wid, lane); dma_v(Vh + (long)(t - 1) * 64 * kp, kp, lds0 + LDS_V + s * SLOTB, wid, lane); }
        if (64 * t >= q0w + 31) continue;
        const int sl = (t & 1) * SLOTB;
        f32x16 p0, p1, x0, x1;
        qkt(p0, p1, kp0 + sl, qr, r32, hi);
        const bool need_mask = (64 * t + 63 >= q0w);
        const int kb = 64 * t + 4 * hi;
#pragma unroll
        for (int r = 0; r < 16; ++r) {
            const float z0 = fminf(p0[r], 100.f), z1 = fminf(p1[r], 100.f);
            const float e0 = __builtin_amdgcn_exp2f(z0), e1 = __builtin_amdgcn_exp2f(z1);
            float a0 = __builtin_amdgcn_rcpf(1.0f + e0), a1 = __builtin_amdgcn_rcpf(1.0f + e1);
            float b0 = e0 * a0, b1 = e1 * a1;
            if (need_mask) { const int kv = kb + (r & 3) + 8 * (r >> 2); if (kv >= qabs) { a0 = 1.f; b0 = 0.f; } if (kv + 32 >= qabs) { a1 = 1.f; b1 = 0.f; } }
            x0[r] = a0; x1[r] = a1; p0[r] = b0; p1[r] = b1; }
        float gp[8], lo[8], hv[8], T[8];
#pragma unroll
        for (int m = 0; m < 4; ++m) { gp[m] = (x0[4 * m] * x0[4 * m + 1]) * (x0[4 * m + 2] * x0[4 * m + 3]); gp[4 + m] = (x1[4 * m] * x1[4 * m + 1]) * (x1[4 * m + 2] * x1[4 * m + 3]); }
#pragma unroll
        for (int m = 0; m < 8; ++m) lo[m] = swap_lo(gp[m], hv[m]);
        T[7] = 1.0f;
#pragma unroll
        for (int m = 6; m >= 0; --m) T[m] = T[m + 1] * (lo[m + 1] * hv[m + 1]);
        const float total = T[0] * (lo[0] * hv[0]);
#pragma unroll
        for (int m = 0; m < 8; ++m) {
            float c = carry * T[m]; if (hi == 0) c *= hv[m];
            if (m < 4) { p0[4 * m + 3] *= c; c *= x0[4 * m + 3]; p0[4 * m + 2] *= c; c *= x0[4 * m + 2]; p0[4 * m + 1] *= c; c *= x0[4 * m + 1]; p0[4 * m] *= c; }
            else { const int q = m - 4; p1[4 * q + 3] *= c; c *= x1[4 * q + 3]; p1[4 * q + 2] *= c; c *= x1[4 * q + 2]; p1[4 * q + 1] *= c; c *= x1[4 * q + 1]; p1[4 * q] *= c; } }
        carry *= total;
        u32x4 w0, w1, w2, w3; ATT_PACK4(p0, p1, w0, w1, w2, w3);
        pv(o, vp0 + sl, __builtin_bit_cast(bf16x8, w0), __builtin_bit_cast(bf16x8, w1), __builtin_bit_cast(bf16x8, w2), __builtin_bit_cast(bf16x8, w3));
    }
    float one[16];
#pragma unroll
    for (int r = 0; r < 16; ++r) one[r] = 1.0f;
    store_o(o, one, shm + LDS_OST + wid * 4096, Oh + (long)q0w * op, op, lane, r32, hi);
    asm volatile("s_waitcnt lgkmcnt(0)\n\ts_barrier" ::: "memory");
}

__device__ __forceinline__ void mem_unit(const bf16* Qh, int qp, const bf16* Kh, const bf16* Vh, int kp, bf16* Oh, int op, lds_ptr shm) {
    int tid = threadIdx.x; asm volatile("" : "+v"(tid)); const int lane = tid & 63, r32 = lane & 31, hi = lane >> 5; const int wid = __builtin_amdgcn_readfirstlane(tid >> 6);
    const unsigned lds0 = (unsigned)(size_t)shm;
    const lds_cptr kp0 = (lds_cptr)shm + LDS_K, vp0 = (lds_cptr)shm + LDS_V + ((lane >> 4) & 1) * 32 + (lane & 3) * 8 + (4 * hi + ((lane & 15) >> 2)) * 64;
#pragma unroll
    for (int t = 0; t < 4; ++t) { dma_k(Kh + (long)t * 64 * kp, kp, lds0 + LDS_K + t * SLOTB, wid, lane); dma_v(Vh + (long)t * 64 * kp, kp, lds0 + LDS_V + t * SLOTB, wid, lane); }
    bf16x8 qr[4];
#pragma unroll
    for (int d0 = 0; d0 < 4; ++d0) qr[d0] = *(const bf16x8*)(Qh + (long)(wid * 32 + r32) * qp + d0 * 16 + hi * 8);
    ATT_WAIT_BAR(0);
    f32x16 p[8];
#pragma unroll
    for (int t = 0; t < 4; ++t) qkt(p[2 * t], p[2 * t + 1], kp0 + t * SLOTB, qr, r32, hi);
    float mx = -INFINITY;
#pragma unroll
    for (int t = 0; t < 8; ++t)
#pragma unroll
        for (int r = 0; r < 16; ++r) mx = fmaxf(mx, p[t][r]);
    { float h2; const float l2 = swap_lo(mx, h2); mx = fmaxf(l2, h2); }
    float sum = 0.f;
#pragma unroll
    for (int t = 0; t < 8; ++t)
#pragma unroll
        for (int r = 0; r < 16; ++r) { const float e = __builtin_amdgcn_exp2f(p[t][r] - mx); p[t][r] = e; sum += e; }
    { float h2; const float l2 = swap_lo(sum, h2); sum = l2 + h2; }
    f32x16 o[2]; o[0] = f32x16{}; o[1] = f32x16{};
#pragma unroll
    for (int t = 0; t < 4; ++t) { u32x4 w0, w1, w2, w3; ATT_PACK4(p[2 * t], p[2 * t + 1], w0, w1, w2, w3);
        pv(o, vp0 + t * SLOTB, __builtin_bit_cast(bf16x8, w0), __builtin_bit_cast(bf16x8, w1), __builtin_bit_cast(bf16x8, w2), __builtin_bit_cast(bf16x8, w3)); }
    __attribute__((address_space(3))) float* wsf = (__attribute__((address_space(3))) float*)(shm + LDS_WS) + wid * 64;
    if (hi == 0) wsf[r32] = sum;
    asm volatile("s_waitcnt lgkmcnt(0)" ::: "memory");
    float rli[16];
#pragma unroll
    for (int r = 0; r < 16; ++r) rli[r] = __builtin_amdgcn_rcpf(wsf[crow(r, hi)]);
    store_o(o, rli, shm + LDS_OST + wid * 4096, Oh + (long)(wid * 32) * op, op, lane, r32, hi);
    asm volatile("s_waitcnt lgkmcnt(0)\n\ts_barrier" ::: "memory");
}
}
constexpr int NWAVES = 8;
constexpr int DM = 1024, NB = 4, T = 4096, M = NB * T, DEPTH = 4, HD = 64, MIXH = 12, MIXW = 768, MEMH = 4, MEMW = 256, MEMT = 256;
constexpr int FF = 2816, NE = 8, NC0 = 2560, NC1 = 2592, NP0 = 2816, NP1 = 3072;
constexpr int MAXSLOT = 2 * M + NE * 256;
constexpr float LN_EPS = 1e-5f, GN_EPS = 64e-5f, ALPHA = 1.681792830507429f;
constexpr float C2 = 0.125f * 1.4426950408889634f;
typedef unsigned short bf16;

constexpr size_t al256(size_t x) { return (x + 255) & ~(size_t)255; }
constexpr size_t WS_CTL = 0, CTL_ZERO_BYTES = 1u << 20;
constexpr size_t SZ_WIN0 = (size_t)NP0 * DM * 2, SZ_WIN1 = (size_t)NP1 * DM * 2, SZ_WINB = (size_t)DM * DM * 2, SZ_WKV = (size_t)1536 * DM * 2, SZ_WMKV = (size_t)2048 * DM * 2, SZ_WO = (size_t)DM * DM * 2;
constexpr size_t SZ_WGU = (size_t)2 * FF * DM * 2, SZ_WDN = (size_t)DM * FF * 2, SZ_WLORA = (size_t)3072 * 512 * 2;
constexpr size_t WS_WIN0 = CTL_ZERO_BYTES, WS_WIN1 = WS_WIN0 + SZ_WIN0, WS_WIN2 = WS_WIN1 + SZ_WIN1, WS_WIN3 = WS_WIN2 + SZ_WINB, WS_WKV = WS_WIN3 + SZ_WINB, WS_WMKV = WS_WKV + SZ_WKV;
constexpr size_t WS_WO = WS_WMKV + SZ_WMKV, WS_WGU = WS_WO + 4 * SZ_WO, WS_WDN = WS_WGU + 2 * SZ_WGU, WS_WEGU = WS_WDN + 2 * SZ_WDN, WS_WEDN = WS_WEGU + 16 * SZ_WGU, WS_WLORA = WS_WEDN + 16 * SZ_WDN;
constexpr size_t WS_XB = WS_WLORA + 2 * SZ_WLORA, WS_XB1 = WS_XB + (size_t)M * DM * 2, WS_MEMB = WS_XB1 + (size_t)M * DM * 2, WS_MKV = WS_MEMB + (size_t)1024 * DM * 2;
constexpr size_t WS_XF0 = WS_MKV + (size_t)1024 * 2048 * 2, WS_XF1 = WS_XF0 + (size_t)M * DM * 4, WS_PRE = WS_XF1 + (size_t)M * DM * 4, WS_VFIRST = WS_PRE + (size_t)M * DM * 4;
constexpr size_t WS_MIX = WS_VFIRST + (size_t)M * MIXW * 4, WS_KV = WS_MIX + (size_t)M * DM * 2, WS_ROUTE = WS_KV + (size_t)M * 1536 * 2;
constexpr size_t RO_E = 0, RO_W = RO_E + (size_t)M * 4, RO_SLOT = RO_W + (size_t)M * 8, RO_CNTC = RO_SLOT + (size_t)M * 8, RO_TILE = RO_CNTC + 256 * 8 * 4, RO_END = RO_TILE + 256 * 4;
constexpr size_t WS_SCR = al256(WS_ROUTE + RO_END);
constexpr size_t SC_P = 0, SC_U = SC_P + (size_t)M * NP1 * 2, SC_WDEC = SC_U + (size_t)M * 512 * 2;
constexpr size_t SC_AI = SC_WDEC + (size_t)M * MIXW * 4, SC_VG = SC_AI + (size_t)M * MIXW * 4, SC_G = SC_VG + (size_t)M * MIXW * 4, SC_V = SC_G + (size_t)M * MIXW * 4, SC_SRK = SC_V + (size_t)M * MIXW * 4;
static_assert(SC_WDEC < SC_AI && SC_AI < SC_VG && SC_VG < SC_G, "EpiLora offsets are unsigned");
constexpr size_t CK_NUNIT = (size_t)NB * MIXH * (T / 64);
constexpr size_t SC_S2IN = al256(SC_SRK + (size_t)M * MIXH * 4), SC_S3IN = SC_S2IN + CK_NUNIT * 41216, SC_SU = SC_S3IN + CK_NUNIT * 24576, SC_MIXEND = SC_SU + CK_NUNIT * 16384;
constexpr size_t SC_H = 0, SC_XG = SC_H + (size_t)MAXSLOT * FF * 2, SC_YE = SC_XG + (size_t)MAXSLOT * DM * 2, SC_FFNEND = SC_YE + (size_t)MAXSLOT * DM * 4;
constexpr size_t WS_END = WS_SCR + (SC_MIXEND > SC_FFNEND ? SC_MIXEND : SC_FFNEND);
constexpr int CW_BAR = 4096;
constexpr int RING_OFF = 0, RING_BYTES = 131072, LDSCTL_OFF = RING_BYTES, MISC_OFF = LDSCTL_OFF + 320, LDS_BYTES = 147456;

#define GAS __attribute__((address_space(1)))
#define LAS __attribute__((address_space(3)))
typedef unsigned v4u __attribute__((ext_vector_type(4)));
typedef float f32x4 __attribute__((ext_vector_type(4)));
typedef GAS unsigned gu32;
#define RLX_AGENT __ATOMIC_RELAXED, __HIP_MEMORY_SCOPE_AGENT
#define LDS_WAIT() asm volatile("s_waitcnt lgkmcnt(0)" ::: "memory")
__device__ __forceinline__ unsigned f2bf(float f) { unsigned u = __builtin_bit_cast(unsigned, f); return (u + 0x7fffu + ((u >> 16) & 1u)) >> 16; }
__device__ __forceinline__ unsigned pk2(float lo, float hi) { return f2bf(lo) | (f2bf(hi) << 16); }
__device__ __forceinline__ float bf2f(unsigned short b) { return __builtin_bit_cast(float, (unsigned)b << 16); }
__device__ __forceinline__ float bflo(unsigned w) { return __builtin_bit_cast(float, w << 16); }
__device__ __forceinline__ float bfhi(unsigned w) { return __builtin_bit_cast(float, w & 0xffff0000u); }
__device__ __forceinline__ int ld_relaxed(const int* p) { return __hip_atomic_load(p, __ATOMIC_RELAXED, __HIP_MEMORY_SCOPE_AGENT); }

#define XB_TMO      128
#define XB_XCNT(j)  (256  + 64 * (j))
#define XB_XSUB(j)  (1280 + 64 * (j))
#define XB_XGEN(j)  (2304 + 64 * (j))
#define XB_TOP      3328
#define XB_TOPGEN   3392
#define XCD_BAR_WORDS 3456
#define XB_SPIN_CAP (1u << 18)
__device__ __forceinline__ unsigned xb_ld(unsigned* p)              { return __hip_atomic_load(p, __ATOMIC_RELAXED, __HIP_MEMORY_SCOPE_AGENT); }
__device__ __forceinline__ unsigned xb_add(unsigned* p, unsigned v) { return __hip_atomic_fetch_add(p, v, __ATOMIC_RELAXED, __HIP_MEMORY_SCOPE_AGENT); }
__device__ __forceinline__ unsigned xb_xcc_id() { return (unsigned)__builtin_amdgcn_s_getreg((3 << 11) | 20) & 0xFu; }
#define XB_SPIN(cond, bar) do { unsigned _sp = 0; while (cond) { __builtin_amdgcn_s_sleep(1); \
    if ((++_sp & 255u) == 0u) { if (xb_ld(&(bar)[XB_TMO])) break; if (_sp > XB_SPIN_CAP) { atomicAdd(&(bar)[XB_TMO], 1u); break; } } } } while (0)
struct XcdBarrier { unsigned* bar; unsigned x; volatile LAS unsigned* st; };
__device__ __forceinline__ XcdBarrier xcd_barrier_post(unsigned* bar, volatile LAS unsigned* st) {
    XcdBarrier b; b.bar = bar; b.x = xb_xcc_id(); b.st = st;
    if (threadIdx.x == 0) (void)xb_add(&bar[XB_XCNT(b.x)], 1u);
    return b;
}
__device__ __forceinline__ void xcd_barrier_complete(unsigned* bar, unsigned x, unsigned& nloc, unsigned& nx) {
    const unsigned G = gridDim.x * gridDim.y * gridDim.z;
    unsigned sum, cnt, mine, sp = 0u;
    for (;;) {
        sum = 0u; cnt = 0u; mine = 0u;
#pragma unroll
        for (unsigned j = 0; j < 16; ++j) { const unsigned c = xb_ld(&bar[XB_XCNT(j)]); sum += c; cnt += (c > 0u) ? 1u : 0u; mine = (j == x) ? c : mine; }
        if (sum == G) break;
        __builtin_amdgcn_s_sleep(1);
        if ((++sp & 255u) == 0u) { if (xb_ld(&bar[XB_TMO])) break; if (sp > XB_SPIN_CAP) { atomicAdd(&bar[XB_TMO], 1u); break; } }
    }
    nloc = mine > 0u ? mine : 1u; nx = cnt > 0u ? cnt : 1u;
}
__device__ __forceinline__ void xcd_barrier(const XcdBarrier& b) {
    asm volatile("s_waitcnt vmcnt(0)" ::: "memory");
    __syncthreads();
    if (threadIdx.x == 0) {
        unsigned* bar = b.bar;
        __builtin_amdgcn_s_waitcnt(0);
        unsigned nloc = b.st[0], nx = b.st[1];
        if (nloc == 0u) { xcd_barrier_complete(bar, b.x, nloc, nx); b.st[0] = nloc; b.st[1] = nx; }
        const unsigned old = xb_add(&bar[XB_XSUB(b.x)], 1u);
        const unsigned gen = old / nloc;
        if (old + 1u == (gen + 1u) * nloc) {
            __builtin_amdgcn_fence(__ATOMIC_RELEASE, "agent");
            asm volatile("s_waitcnt vmcnt(0)" ::: "memory");
            const unsigned og = xb_add(&bar[XB_TOP], 1u);
            const unsigned tg = og / nx;
            if (og + 1u == (tg + 1u) * nx) xb_add(&bar[XB_TOPGEN], 1u);
            else XB_SPIN(xb_ld(&bar[XB_TOPGEN]) == tg, bar);
            __builtin_amdgcn_fence(__ATOMIC_ACQUIRE, "agent");
            xb_add(&bar[XB_XGEN(b.x)], 1u);
            asm volatile("s_waitcnt vmcnt(0)" ::: "memory");
        } else {
            XB_SPIN(xb_ld(&bar[XB_XGEN(b.x)]) == gen, bar);
            __builtin_amdgcn_fence(__ATOMIC_ACQUIRE, "agent");
            asm volatile("s_waitcnt vmcnt(0)" ::: "memory");
        }
    }
    __syncthreads();
}

struct Frame {
    LAS unsigned char* lds;
    unsigned char* ws;
    int tid, lane, wave, vcu, G;
};
typedef __attribute__((address_space(4))) const unsigned char* kptr_t;
__device__ __forceinline__ const float* inp(int k) { kptr_t ka = (kptr_t)__builtin_amdgcn_kernarg_segment_ptr(); asm volatile("" : "+s"(ka)); return *(const float* const __attribute__((address_space(4)))*)(ka + 8 * k); }
#define ENTER(F) do { int t_ = threadIdx.x; asm volatile("" : "+v"(t_)); (F).tid = t_; (F).lane = t_ & 63; (F).wave = __builtin_amdgcn_readfirstlane(t_ >> 6); unsigned char* w_ = (unsigned char*)inp(24); (F).ws = w_; } while (0)
__device__ __forceinline__ float wave_sum(float v) {
#pragma unroll
    for (int o = 1; o < 64; o <<= 1) v += __shfl_xor(v, o);
    return v;
}
template <int CTRL> __device__ __forceinline__ float dpp(float x) { return __builtin_bit_cast(float, __builtin_amdgcn_mov_dpp(__builtin_bit_cast(int, x), CTRL, 0xf, 0xf, true)); }
__device__ __forceinline__ float red16(float x) { x += dpp<0xB1>(x); x += dpp<0x4E>(x); x += dpp<0x141>(x); x += dpp<0x128>(x); return x; }
static_assert(WS_END <= 1476395008ull, "workspace map exceeds the guaranteed d_ws size");
__device__ __forceinline__ void conv_item(const float* W, int K, int N, bf16* WT, int ldt, int drow0, LAS float* scr, int kb, int nb, int lane) {
    const int k0 = 64 * kb, n0 = 32 * nb;
#pragma unroll 8
    for (int i = 0; i < 32; ++i) { const int kk = 2 * i + (lane >> 5); scr[kk * 33 + (lane & 31)] = W[(size_t)(k0 + kk) * N + n0 + (lane & 31)]; }
    LDS_WAIT(); asm volatile("" ::: "memory");
    const int c = lane & 7;
#pragma unroll
    for (int j = 0; j < 4; ++j) { const int n = (lane >> 3) + 8 * j; const LAS float* s = scr + (8 * c) * 33 + n;
        v4u o; o.x = pk2(s[0 * 33], s[1 * 33]); o.y = pk2(s[2 * 33], s[3 * 33]); o.z = pk2(s[4 * 33], s[5 * 33]); o.w = pk2(s[6 * 33], s[7 * 33]);
        *(GAS v4u*)(WT + (size_t)(drow0 + n) * ldt + k0 + 8 * c) = o; }
    LDS_WAIT(); asm volatile("" ::: "memory");
}
__device__ __forceinline__ int swiglu_row(int n0) { const int up = n0 >= FF, h = up ? n0 - FF : n0; return 256 * (h >> 7) + (up ? 128 : 0) + (h & 127); }
__device__ __forceinline__ void conv_mat(const float* W, int K, int N, bf16* WT, int mode, int row_off, LAS float* scr, int r, int lane) {
    const int nblk = N / 32, kb = r / nblk, nb = r % nblk, n0 = 32 * nb;
    const int d0 = mode == 1 ? swiglu_row(n0) : mode == 2 ? (n0 < NC1 ? n0 : n0 - NC1 + NP0) : row_off + n0;
    conv_item(W, K, N, WT, K, d0, scr, kb, nb, lane);
}
__device__ __forceinline__ void p0_prologue(Frame& F) {
    ENTER(F);
    LAS float* scr = (LAS float*)(F.lds + RING_OFF + F.wave * 16384);
    const int gw = F.vcu * NWAVES + F.wave, NGW = F.G * NWAVES;
    unsigned char* ws = F.ws;
    constexpr int I_IN0 = 16 * (NP0 / 32), I_IN1 = 16 * (2848 / 32), I_SQ = 16 * 32, I_KV = 16 * 48, I_MKV = 16 * 16, I_GU = 16 * (2 * FF / 32), I_DN = (FF / 64) * 32;
    constexpr int NITEMS = I_IN0 + I_IN1 + 2 * I_SQ + I_KV + 4 * I_MKV + 4 * I_SQ + 2 * I_GU + 2 * I_DN + 16 * I_GU + 16 * I_DN;
    for (int it = gw; it < NITEMS; it += NGW) {
        int r = it;
        if (r < I_IN0) { conv_mat(inp(2), DM, NP0, (bf16*)(ws + WS_WIN0), 0, 0, scr, r, F.lane); continue; } r -= I_IN0;
        if (r < I_IN1) { conv_mat(inp(3), DM, 2848, (bf16*)(ws + WS_WIN1), 2, 0, scr, r, F.lane); continue; } r -= I_IN1;
        if (r < 2 * I_SQ) { const int j = r / I_SQ; conv_mat(inp(13) + (size_t)j * DM * DM, DM, DM, (bf16*)(ws + WS_WIN2 + j * SZ_WINB), 0, 0, scr, r % I_SQ, F.lane); continue; } r -= 2 * I_SQ;
        if (r < I_KV) { conv_mat(inp(14), DM, 1536, (bf16*)(ws + WS_WKV), 0, 0, scr, r, F.lane); continue; } r -= I_KV;
        if (r < 4 * I_MKV) { const int j = r / I_MKV; conv_mat(inp(15) + (size_t)j * DM * 512, DM, 512, (bf16*)(ws + WS_WMKV), 0, j * 512, scr, r % I_MKV, F.lane); continue; } r -= 4 * I_MKV;
        if (r < 4 * I_SQ) { const int j = r / I_SQ; conv_mat(inp(16) + (size_t)j * DM * DM, DM, DM, (bf16*)(ws + WS_WO + j * SZ_WO), 0, 0, scr, r % I_SQ, F.lane); continue; } r -= 4 * I_SQ;
        if (r < 2 * I_GU) { const int j = r / I_GU; conv_mat(inp(18) + (size_t)j * DM * 2 * FF, DM, 2 * FF, (bf16*)(ws + WS_WGU + j * SZ_WGU), 1, 0, scr, r % I_GU, F.lane); continue; } r -= 2 * I_GU;
        if (r < 2 * I_DN) { const int j = r / I_DN; conv_mat(inp(19) + (size_t)j * FF * DM, FF, DM, (bf16*)(ws + WS_WDN + j * SZ_WDN), 0, 0, scr, r % I_DN, F.lane); continue; } r -= 2 * I_DN;
        if (r < 16 * I_GU) { const int j = r / I_GU; conv_mat(inp(21) + (size_t)j * DM * 2 * FF, DM, 2 * FF, (bf16*)(ws + WS_WEGU + j * SZ_WGU), 1, 0, scr, r % I_GU, F.lane); continue; } r -= 16 * I_GU;
        { const int j = r / I_DN; conv_mat(inp(22) + (size_t)j * FF * DM, FF, DM, (bf16*)(ws + WS_WEDN + j * SZ_WDN), 0, 0, scr, r % I_DN, F.lane); }
    }
    const int gt = F.vcu * (NWAVES * 64) + F.tid, NGT = F.G * NWAVES * 64;
    { GAS v4u* z = (GAS v4u*)(ws + WS_WIN1 + (size_t)NC1 * DM * 2); const int n16 = (NP0 - NC1) * DM * 2 / 16; for (int i = gt; i < n16; i += NGT) z[i] = (v4u){0u, 0u, 0u, 0u}; }
    const float* wup = inp(7); const float* aup = inp(8); const float* gup = inp(9); const float* vup = inp(11);
    for (int i = gt; i < 2 * 3072 * 256; i += NGT) { const int l = i / (3072 * 256), rem = i % (3072 * 256), n = rem / 256, k = (rem % 256) * 2, blk = n / 768, c = n % 768;
        float v0 = 0.f, v1 = 0.f;
        if (blk == 0 && k < 64) { v0 = wup[((size_t)l * 64 + k) * 768 + c]; v1 = wup[((size_t)l * 64 + k + 1) * 768 + c]; }
        else if (blk == 1 && k >= 128 && k < 192) { v0 = aup[((size_t)l * 64 + k - 128) * 768 + c]; v1 = aup[((size_t)l * 64 + k - 127) * 768 + c]; }
        else if (blk == 2 && l == 1 && k >= 256 && k < 288) { v0 = vup[(size_t)(k - 256) * 768 + c]; v1 = vup[(size_t)(k - 255) * 768 + c]; }
        else if (blk == 3 && k >= 384) { v0 = gup[((size_t)l * 128 + k - 384) * 768 + c]; v1 = gup[((size_t)l * 128 + k - 383) * 768 + c]; }
        ((GAS unsigned*)(ws + WS_WLORA))[i] = pk2(v0, v1); }
    { const GAS f32x4* x4 = (const GAS f32x4*)inp(0); GAS v4u* o = (GAS v4u*)(ws + WS_XB);
      for (int i = gt; i < M * DM / 8; i += NGT) { const f32x4 a = x4[2 * i], b = x4[2 * i + 1]; o[i] = (v4u){pk2(a.x, a.y), pk2(a.z, a.w), pk2(b.x, b.y), pk2(b.z, b.w)}; } }
    { const GAS f32x4* x4 = (const GAS f32x4*)inp(1); GAS v4u* o = (GAS v4u*)(ws + WS_MEMB);
      for (int i = gt; i < 1024 * DM / 8; i += NGT) { const f32x4 a = x4[2 * i], b = x4[2 * i + 1]; o[i] = (v4u){pk2(a.x, a.y), pk2(a.z, a.w), pk2(b.x, b.y), pk2(b.z, b.w)}; } }
}

__device__ __forceinline__ float sigmoidf_(float x) { return 1.0f / (1.0f + __expf(-x)); }
__device__ __forceinline__ void ph_lora_in(Frame& F, int l) {
    ENTER(F);
    const int NP = l == 0 ? NP0 : NP1, GD0 = l == 0 ? 2432 : 2464;
    const bf16* P = (const bf16*)(F.ws + WS_SCR + SC_P); bf16* U = (bf16*)(F.ws + WS_SCR + SC_U);
    const float* mu = l == 0 ? inp(4) : inp(5);
    const int gw = F.vcu * NWAVES + F.wave, NGW = F.G * NWAVES;
    const int cu = 8 * F.lane, reg = cu >> 7, off = cu & 127;
    int src = -1, mode = 0;
    if (reg == 0 && off < 64) { src = 2304 + off; mode = 1; }
    else if (reg == 1 && off < 64) { src = 2368 + off; mode = 0; }
    else if (reg == 2 && l == 1 && off < 32) { src = 2432 + off; mode = 0; }
    else if (reg == 3) { src = GD0 + off; mode = 2; }
    for (int m = gw; m < M; m += NGW) {
        v4u o = (v4u){0u, 0u, 0u, 0u};
        if (src >= 0) {
            const v4u pc = *(const GAS v4u*)(P + (size_t)m * NP + src);
            v4u pp = (v4u){0u, 0u, 0u, 0u}; if ((m & (T - 1)) != 0) pp = *(const GAS v4u*)(P + (size_t)(m - 1) * NP + src);
            float v[8];
#pragma unroll
            for (int j = 0; j < 4; ++j) { const float c0 = bflo(pc[j]), c1 = bfhi(pc[j]), q0 = bflo(pp[j]), q1 = bfhi(pp[j]);
                v[2 * j] = c0 + mu[src + 2 * j] * (q0 - c0); v[2 * j + 1] = c1 + mu[src + 2 * j + 1] * (q1 - c1); }
#pragma unroll
            for (int j = 0; j < 8; ++j) { if (mode == 1) v[j] = tanhf(v[j]); else if (mode == 2) v[j] = sigmoidf_(v[j]); }
            o = (v4u){pk2(v[0], v[1]), pk2(v[2], v[3]), pk2(v[4], v[5]), pk2(v[6], v[7])};
        }
        *(GAS v4u*)(U + (size_t)m * 512 + cu) = o;
    }
}
__device__ __forceinline__ void ph_ln(Frame& F, int mode, const float* gain, const float* bias, size_t xf_off, size_t xb_off, int to_out, int route, const float* wr) {
    ENTER(F);
    float* XF = to_out ? (float*)inp(23) : (float*)(F.ws + xf_off); bf16* XB = (bf16*)(F.ws + xb_off);
    const float* PRE = (const float*)(F.ws + WS_PRE); const float* XF1 = (const float*)(F.ws + WS_XF1); const float* YE = (const float*)(F.ws + WS_SCR + SC_YE);
    const int* SLOT = (const int*)(F.ws + WS_ROUTE + RO_SLOT); const float* RW = (const float*)(F.ws + WS_ROUTE + RO_W);
    int* RT_E = (int*)(F.ws + WS_ROUTE + RO_E); float* RT_W = (float*)(F.ws + WS_ROUTE + RO_W); int* CNTC = (int*)(F.ws + WS_ROUTE + RO_CNTC);
    LAS int* cnt = (LAS int*)(F.lds + RING_OFF);
    f32x4 gv[4], bv[4];
#pragma unroll
    for (int j = 0; j < 4; ++j) { gv[j] = *(const f32x4*)(gain + 4 * F.lane + 256 * j); bv[j] = *(const f32x4*)(bias + 4 * F.lane + 256 * j); }
    for (int chunk = blockIdx.x; chunk < M / 64; chunk += F.G) {
        if (route) { if (F.tid < NE) cnt[F.tid] = 0; __syncthreads(); }
        for (int rr = 0; rr < 8; ++rr) { const int m = chunk * 64 + F.wave * 8 + rr;
            f32x4 v[4]; float s = 0.f;
            if (mode == 0) {
#pragma unroll
                for (int j = 0; j < 4; ++j) v[j] = *(const GAS f32x4*)(PRE + (size_t)m * DM + 4 * F.lane + 256 * j);
            } else {
                const int s1 = ld_relaxed(SLOT + 2 * m), s2 = ld_relaxed(SLOT + 2 * m + 1); const float w1 = __builtin_bit_cast(float, ld_relaxed((const int*)RW + 2 * m)), w2 = __builtin_bit_cast(float, ld_relaxed((const int*)RW + 2 * m + 1));
#pragma unroll
                for (int j = 0; j < 4; ++j) { const f32x4 x = *(const GAS f32x4*)(XF1 + (size_t)m * DM + 4 * F.lane + 256 * j), y1 = *(const GAS f32x4*)(YE + (size_t)s1 * DM + 4 * F.lane + 256 * j), y2 = *(const GAS f32x4*)(YE + (size_t)s2 * DM + 4 * F.lane + 256 * j);
                    v[j] = x * ALPHA + y1 * w1 + y2 * w2; }
            }
#pragma unroll
            for (int j = 0; j < 4; ++j) s += (v[j].x + v[j].y) + (v[j].z + v[j].w);
            const float mean = wave_sum(s) * (1.f / DM); float s2 = 0.f;
#pragma unroll
            for (int j = 0; j < 4; ++j) { v[j] = v[j] - mean; s2 += (v[j].x * v[j].x + v[j].y * v[j].y) + (v[j].z * v[j].z + v[j].w * v[j].w); }
            const float rstd = 1.f / sqrtf(wave_sum(s2) * (1.f / DM) + LN_EPS);
#pragma unroll
            for (int j = 0; j < 4; ++j) { v[j] = v[j] * rstd * gv[j] + bv[j];
                *(GAS f32x4*)(XF + (size_t)m * DM + 4 * F.lane + 256 * j) = v[j];
                *(GAS unsigned long long*)(XB + (size_t)m * DM + 4 * F.lane + 256 * j) = (unsigned long long)pk2(v[j].x, v[j].y) | ((unsigned long long)pk2(v[j].z, v[j].w) << 32); }
            if (route) {
                float lg[NE];
#pragma unroll
                for (int e = 0; e < NE; ++e) lg[e] = 0.f;
#pragma unroll
                for (int j = 0; j < 4; ++j)
#pragma unroll
                    for (int q = 0; q < 4; ++q) { const int c = 4 * F.lane + 256 * j + q; const f32x4 wa = *(const f32x4*)(wr + (size_t)c * NE), wb = *(const f32x4*)(wr + (size_t)c * NE + 4); const float xv = v[j][q];
                        lg[0] += xv * wa.x; lg[1] += xv * wa.y; lg[2] += xv * wa.z; lg[3] += xv * wa.w; lg[4] += xv * wb.x; lg[5] += xv * wb.y; lg[6] += xv * wb.z; lg[7] += xv * wb.w; }
#pragma unroll
                for (int e = 0; e < NE; ++e) lg[e] = wave_sum(lg[e]);
                int e1 = 0; float b1 = lg[0];
#pragma unroll
                for (int e = 1; e < NE; ++e) if (lg[e] > b1) { b1 = lg[e]; e1 = e; }
                int e2 = -1; float b2 = -INFINITY;
#pragma unroll
                for (int e = 0; e < NE; ++e) if (e != e1 && lg[e] > b2) { b2 = lg[e]; e2 = e; }
                const float w1 = 1.0f / (1.0f + __expf(b2 - b1));
                if (F.lane == 0) { RT_E[m] = e1 | (e2 << 8); RT_W[2 * m] = w1; RT_W[2 * m + 1] = 1.0f - w1; __hip_atomic_fetch_add(&cnt[e1], 1, __ATOMIC_RELAXED, __HIP_MEMORY_SCOPE_WORKGROUP); __hip_atomic_fetch_add(&cnt[e2], 1, __ATOMIC_RELAXED, __HIP_MEMORY_SCOPE_WORKGROUP); }
            }
        }
        if (route) { __syncthreads(); if (F.tid < NE) CNTC[chunk * NE + F.tid] = cnt[F.tid]; __syncthreads(); }
    }
}
__device__ __forceinline__ void ph_route2(Frame& F) {
    ENTER(F);
    const int* CNTC = (const int*)(F.ws + WS_ROUTE + RO_CNTC); const int* RT_E = (const int*)(F.ws + WS_ROUTE + RO_E); int* SLOT = (int*)(F.ws + WS_ROUTE + RO_SLOT); int* TILE = (int*)(F.ws + WS_ROUTE + RO_TILE);
    const bf16* XB1 = (const bf16*)(F.ws + WS_XB1); bf16* XG = (bf16*)(F.ws + WS_SCR + SC_XG);
    LAS int* sh = (LAS int*)(F.lds + RING_OFF);
    for (int chunk = blockIdx.x; chunk < M / 64; chunk += F.G) {
        { const int e = F.wave; int tot = 0, off = 0;
#pragma unroll
          for (int k = 0; k < 4; ++k) { const int c = F.lane + 64 * k; const int v = ld_relaxed(CNTC + c * NE + e); tot += v; off += (c < chunk) ? v : 0; }
          tot = (int)wave_sum((float)tot); off = (int)wave_sum((float)off);
          if (F.lane == 0) { sh[e] = tot; sh[8 + e] = off; } }
        __syncthreads();
        if (F.tid == 0) { int sb = 0; for (int e = 0; e < NE; ++e) { sh[16 + e] = sb; sb += (sh[e] + 255) & ~255; } sh[24] = sb; }
        __syncthreads();
        if (F.wave == 0) { const int m = chunk * 64 + F.lane; const int ee = ld_relaxed(RT_E + m); const int e1 = ee & 0xff, e2 = (ee >> 8) & 0xff;
            const unsigned long long below = (1ull << F.lane) - 1ull; int s1 = 0, s2 = 0;
#pragma unroll
            for (int e = 0; e < NE; ++e) { const unsigned long long m1 = __ballot(e1 == e), m2 = __ballot(e2 == e); const int prior = __popcll(m1 & below) + __popcll(m2 & below);
                const int base = sh[16 + e] + sh[8 + e] + prior; if (e1 == e) s1 = base; if (e2 == e) s2 = base; }
            SLOT[2 * m] = s1; SLOT[2 * m + 1] = s2; sh[32 + 2 * F.lane] = s1; sh[33 + 2 * F.lane] = s2; }
        __syncthreads();
        for (int a = F.wave; a < 128; a += NWAVES) { const int slot = sh[32 + a], m = chunk * 64 + (a >> 1);
            const GAS v4u* s = (const GAS v4u*)(XB1 + (size_t)m * DM); GAS v4u* d = (GAS v4u*)(XG + (size_t)slot * DM);
            d[F.lane] = s[F.lane]; d[64 + F.lane] = s[64 + F.lane]; }
        if (chunk == 0 && F.tid < 256) { const int nt = sh[24] >> 8; int e = 0; for (int q = 1; q < NE; ++q) if (F.tid * 256 >= sh[16 + q]) e = q; TILE[F.tid] = (F.tid == 255) ? nt : e; }
        __syncthreads();
    }
}
namespace ck {
#define CK_LBAR() asm volatile("s_waitcnt lgkmcnt(0)\n\ts_barrier" ::: "memory")
typedef unsigned short bf16;
typedef short bf16x8 __attribute__((ext_vector_type(8)));
typedef float f32x4 __attribute__((ext_vector_type(4)));
typedef float f32x16 __attribute__((ext_vector_type(16)));
typedef unsigned u32x4 __attribute__((ext_vector_type(4)));
typedef unsigned u32x2 __attribute__((ext_vector_type(2)));
typedef LAS bf16* lmat;
constexpr int LD = 72, MATB = 64 * LD * 2;
constexpr int NCH = T / 64, NUNIT = NB * MIXH * NCH;
constexpr size_t S2_AT = 0, S2_MN = 8192, S2_BB = 16384, S2_HK = 24576, S2_HQ = 32768, S2_GC = 40960, S2_BYTES = 41216;
constexpr size_t S3_RT = 0, S3_ARB = 8192, S3_HY = 16384, S3_BYTES = 24576;
constexpr size_t SU_S0 = 0, SU_U = 8192, SU_BYTES = 16384;
__device__ __forceinline__ unsigned pk(float lo, float hi) { typedef float f2 __attribute__((ext_vector_type(2))); typedef __bf16 b2 __attribute__((ext_vector_type(2))); f2 v = {lo, hi}; b2 b = __builtin_convertvector(v, b2); return __builtin_bit_cast(unsigned, b); }
__device__ __forceinline__ int kperm(int p) { const int blk = p & ~15, h = (p >> 3) & 1, e = p & 7; return blk + 8 * (e >> 2) + 4 * h + (e & 3); }
__device__ __forceinline__ void mm(f32x4 (&acc)[2], lmat L, lmat R, int wave, int lane) {
    const int tm = wave >> 1, l15 = lane & 15, kq = lane >> 4;
#pragma unroll
    for (int kk = 0; kk < 2; ++kk) { const bf16x8 a = *(const LAS bf16x8*)(L + (16 * tm + l15) * LD + 32 * kk + 8 * kq);
#pragma unroll
        for (int q = 0; q < 2; ++q) { const bf16x8 b = *(const LAS bf16x8*)(R + (16 * (2 * (wave & 1) + q) + l15) * LD + 32 * kk + 8 * kq); acc[q] = __builtin_amdgcn_mfma_f32_16x16x32_bf16(a, b, acc[q], 0, 0, 0); } }
}
template <int MASK> __device__ __forceinline__ void maskacc(f32x4 (&acc)[2], int wave, int lane) {
    if (MASK == 0) return;
#pragma unroll
    for (int q = 0; q < 2; ++q) { const int n = 16 * (2 * (wave & 1) + q) + (lane & 15);
#pragma unroll
        for (int r = 0; r < 4; ++r) { const int m = 16 * (wave >> 1) + 4 * (lane >> 4) + r; const bool keep = MASK == 1 ? (n < m) : (n <= m); if (!keep) acc[q][r] = 0.f; } }
}
__device__ __forceinline__ void st_rm(lmat D, const f32x4 (&acc)[2], int wave, int lane) {
#pragma unroll
    for (int q = 0; q < 2; ++q) { const int n = 16 * (2 * (wave & 1) + q) + (lane & 15), m0 = 16 * (wave >> 1) + 4 * (lane >> 4);
#pragma unroll
        for (int r = 0; r < 4; ++r) D[(m0 + r) * LD + n] = (bf16)(pk(acc[q][r], 0.f) & 0xffffu); }
}
__device__ __forceinline__ void st_cm(lmat D, const f32x4 (&acc)[2], int wave, int lane) {
#pragma unroll
    for (int q = 0; q < 2; ++q) { const int n = 16 * (2 * (wave & 1) + q) + (lane & 15), m0 = 16 * (wave >> 1) + 4 * (lane >> 4);
        *(LAS u32x2*)(D + n * LD + m0) = (u32x2){pk(acc[q][0], acc[q][1]), pk(acc[q][2], acc[q][3])}; }
}
__device__ __forceinline__ void gst_cm(bf16* G, const f32x4 (&acc)[2], int wave, int lane) {
    if (G == nullptr) return;
#pragma unroll
    for (int q = 0; q < 2; ++q) { const int n = 16 * (2 * (wave & 1) + q) + (lane & 15), m0 = 16 * (wave >> 1) + 4 * (lane >> 4);
        *(GAS u32x2*)(G + n * 64 + m0) = (u32x2){pk(acc[q][0], acc[q][1]), pk(acc[q][2], acc[q][3])}; }
}
template <bool PERM> __device__ __forceinline__ void copy_out(bf16* G, lmat Smat, int tid) {
    if (G == nullptr) return;
    const int row = tid >> 3, p0 = (tid & 7) * 8;
    if (PERM) { unsigned short v[8];
#pragma unroll
        for (int e = 0; e < 8; ++e) v[e] = Smat[row * LD + kperm(p0 + e)];
        *(GAS u32x4*)(G + row * 64 + p0) = (u32x4){(unsigned)v[0] | ((unsigned)v[1] << 16), (unsigned)v[2] | ((unsigned)v[3] << 16), (unsigned)v[4] | ((unsigned)v[5] << 16), (unsigned)v[6] | ((unsigned)v[7] << 16)}; }
    else *(GAS u32x4*)(G + row * 64 + p0) = *(const LAS u32x4*)(Smat + row * LD + p0);
}
__device__ __forceinline__ void copy_in(lmat D, const bf16* G, int tid) { const int row = tid >> 3, p0 = (tid & 7) * 8; *(LAS u32x4*)(D + row * LD + p0) = *(const GAS u32x4*)(G + row * 64 + p0); }

__device__ __forceinline__ float wsum64(float x) {
    x = red16(x);
    auto s = __builtin_amdgcn_permlane16_swap(__float_as_uint(x), __float_as_uint(x), false, false); x = __uint_as_float(s[0]) + __uint_as_float(s[1]);
    auto t = __builtin_amdgcn_permlane32_swap(__float_as_uint(x), __float_as_uint(x), false, false); return __uint_as_float(t[0]) + __uint_as_float(t[1]);
}
__device__ __forceinline__ void ph_s1(Frame& F, int l, int var) {
    ENTER(F);
    const int NP = l == 0 ? NP0 : NP1;
    const unsigned short* P = (const unsigned short*)(F.ws + WS_SCR + SC_P);
    const float* mu = l == 0 ? inp(4) : inp(5);
    const float* vec = inp(6) + (size_t)l * 6 * MIXW; const float* rkp = inp(12) + (size_t)l * MIXW;
    const float* pAI = (const float*)(F.ws + WS_SCR + SC_AI); const float* pLW = (const float*)(F.ws + WS_SCR + SC_WDEC); const float* pVG = (const float*)(F.ws + WS_SCR + SC_VG);
    float* pV = (float*)(F.ws + WS_SCR + SC_V); float* SRK = (float*)(F.ws + WS_SCR + SC_SRK); float* VF = (float*)(F.ws + WS_VFIRST);
    unsigned char* s2in = F.ws + WS_SCR + SC_S2IN; unsigned char* s3in = F.ws + WS_SCR + SC_S3IN;
    LAS unsigned char* base = F.lds + RING_OFF;
#define CKB(k) ((lmat)(base + (k) * MATB))
#define GP(p) ((var & 4) ? (bf16*)nullptr : (bf16*)(p))
    lmat At = CKB(0), Rt = CKB(1), Bh = CKB(2), Kh = CKB(3), VC = CKB(4), KbC = CKB(5), PXr = CKB(6), PXc = CKB(7), AkT = CKB(8), ArkT = CKB(9), ArbT = CKB(10), PYr = CKB(0), PYc = CKB(1), MA = CKB(2), MB = CKB(3);
    LAS float* seg = (LAS float*)(base + 11 * MATB);
    const int j = F.tid & 63, sg = F.wave;
    for (int u = blockIdx.x; u < NUNIT; u += F.G) {
        const int c = u & (NCH - 1), bh = u >> 6, b = bh / MIXH, h = bh % MIXH, jc = h * 64 + j;
        const size_t mrow = (size_t)b * T + c * 64 + 8 * sg;
        const size_t g0 = mrow * MIXW + jc;
        unsigned char* o2 = s2in + (size_t)u * S2_BYTES; unsigned char* o3 = s3in + (size_t)u * S3_BYTES;
        float lw[8], kk[8], ai[8], k2[8], rr[8], vv[8];
        { const float mur = mu[jc], muk = mu[768 + jc], muv = mu[1536 + jc], kkc = vec[2 * MIXW + jc], kac = vec[3 * MIXW + jc], rkc = rkp[jc];
          unsigned short pr[9], pk_[9], pv_[9];
          const bool first = (c == 0 && sg == 0);
#pragma unroll
          for (int q = 0; q < 9; ++q) { const unsigned short* row = P + (mrow + q - 1) * NP; const bool ok = !(first && q == 0);
              pr[q] = ok ? row[jc] : (unsigned short)0; pk_[q] = ok ? row[768 + jc] : (unsigned short)0; pv_[q] = ok ? row[1536 + jc] : (unsigned short)0; }
#pragma unroll
          for (int q = 0; q < 8; ++q) { const size_t o = g0 + (size_t)q * MIXW; lw[q] = pLW[o]; ai[q] = pAI[o]; }
          float vgt[8], vft[8];
          if (l == 1) {
#pragma unroll
              for (int q = 0; q < 8; ++q) { const size_t o = g0 + (size_t)q * MIXW; vgt[q] = pVG[o]; vft[q] = VF[o]; } }
#pragma unroll
          for (int q = 0; q < 8; ++q) { const size_t o = g0 + (size_t)q * MIXW;
              float r = bf2f(pr[q + 1]), k = bf2f(pk_[q + 1]), v = bf2f(pv_[q + 1]);
              r += mur * (bf2f(pr[q]) - r); k += muk * (bf2f(pk_[q]) - k); v += muv * (bf2f(pv_[q]) - v);
              float kq = k * kkc; const float nrm = sqrtf(wsum64(kq * kq)); kq = kq / fmaxf(nrm, 1e-12f);
              const float k2q = k * (1.0f + (ai[q] - 1.0f) * kac);
              if (l == 0) VF[o] = v; else v = v + (vft[q] - v) * vgt[q];
              const float sr = wsum64(r * k2q * rkc);
              if (j == 0) SRK[(mrow + q) * MIXH + h] = sr;
              pV[o] = v;
              rr[q] = r; kk[q] = kq; k2[q] = k2q; vv[q] = v; } }
        float pl[8]; { float a = 0.f;
#pragma unroll
            for (int q = 0; q < 8; ++q) { a += lw[q]; pl[q] = a; } }
        seg[sg * 64 + j] = pl[7];
        CK_LBAR();
        float off = 0.f, LC = 0.f;
#pragma unroll
        for (int s = 0; s < 8; ++s) { const float x = seg[s * 64 + j]; LC += x; off += (s < sg) ? x : 0.f; }
        unsigned short at[8], rt[8], bhh[8], khh[8], vb[8], kb[8], bbv[8];
#pragma unroll
        for (int q = 0; q < 8; ++q) { const float L = off + pl[q], Lm1 = L - lw[q]; const float en = __expf(-L), ec = __expf(LC - L), kb_ = kk[q] * ai[q];
            at[q] = (unsigned short)(pk(-kk[q] * __expf(Lm1), 0.f) & 0xffffu); rt[q] = (unsigned short)(pk(rr[q] * __expf(L), 0.f) & 0xffffu);
            bhh[q] = (unsigned short)(pk(kb_ * en, 0.f) & 0xffffu); khh[q] = (unsigned short)(pk(k2[q] * en, 0.f) & 0xffffu);
            bbv[q] = (unsigned short)(pk(kb_ * ec, 0.f) & 0xffffu); kb[q] = (unsigned short)(pk(k2[q] * ec, 0.f) & 0xffffu); vb[q] = (unsigned short)(pk(vv[q], 0.f) & 0xffffu); }
#pragma unroll
        for (int q = 0; q < 8; ++q) { const int t = 8 * sg + q; At[t * LD + j] = at[q]; Rt[t * LD + j] = rt[q]; Bh[t * LD + j] = bhh[q]; Kh[t * LD + j] = khh[q]; }
        *(LAS u32x4*)(VC + j * LD + 8 * sg) = (u32x4){(unsigned)vb[0] | ((unsigned)vb[1] << 16), (unsigned)vb[2] | ((unsigned)vb[3] << 16), (unsigned)vb[4] | ((unsigned)vb[5] << 16), (unsigned)vb[6] | ((unsigned)vb[7] << 16)};
        *(LAS u32x4*)(KbC + j * LD + 8 * sg) = (u32x4){(unsigned)kb[0] | ((unsigned)kb[1] << 16), (unsigned)kb[2] | ((unsigned)kb[3] << 16), (unsigned)kb[4] | ((unsigned)kb[5] << 16), (unsigned)kb[6] | ((unsigned)kb[7] << 16)};
        if (!(var & 4)) {
            bf16* gb = (bf16*)(o2 + S2_BB) + j * 64 + 16 * (sg >> 1) + 4 * (sg & 1);
            *(GAS u32x2*)(gb) = (u32x2){(unsigned)bbv[0] | ((unsigned)bbv[1] << 16), (unsigned)bbv[2] | ((unsigned)bbv[3] << 16)};
            *(GAS u32x2*)(gb + 8) = (u32x2){(unsigned)bbv[4] | ((unsigned)bbv[5] << 16), (unsigned)bbv[6] | ((unsigned)bbv[7] << 16)}; }
        if (sg == 0) ((float*)(o2 + S2_GC))[j] = __expf(LC);
        CK_LBAR();
        if (var & 1) { CK_LBAR(); continue; }
        copy_out<true>(GP(o2 + S2_AT), At, F.tid);
        copy_out<false>(GP(o3 + S3_RT), Rt, F.tid);
        f32x4 mn[2];
        { f32x4 a[2] = {{0.f, 0.f, 0.f, 0.f}, {0.f, 0.f, 0.f, 0.f}}; mm(a, At, Bh, F.wave, F.lane); maskacc<1>(a, F.wave, F.lane); st_rm(PXr, a, F.wave, F.lane); st_cm(PXc, a, F.wave, F.lane); mn[0] = a[0]; mn[1] = a[1]; }
        { f32x4 a[2] = {{0.f, 0.f, 0.f, 0.f}, {0.f, 0.f, 0.f, 0.f}}; mm(a, At, Kh, F.wave, F.lane); maskacc<1>(a, F.wave, F.lane); st_rm(AkT, a, F.wave, F.lane); }
        { f32x4 a[2] = {{0.f, 0.f, 0.f, 0.f}, {0.f, 0.f, 0.f, 0.f}}; mm(a, Rt, Kh, F.wave, F.lane); maskacc<2>(a, F.wave, F.lane); st_rm(ArkT, a, F.wave, F.lane); }
        { f32x4 a[2] = {{0.f, 0.f, 0.f, 0.f}, {0.f, 0.f, 0.f, 0.f}}; mm(a, Rt, Bh, F.wave, F.lane); maskacc<2>(a, F.wave, F.lane); st_rm(ArbT, a, F.wave, F.lane); }
        CK_LBAR();
        copy_out<false>(GP(o3 + S3_ARB), ArbT, F.tid);
        { f32x4 a[2] = {{0.f, 0.f, 0.f, 0.f}, {0.f, 0.f, 0.f, 0.f}}; mm(a, AkT, VC, F.wave, F.lane); gst_cm(GP(o2 + S2_HK), a, F.wave, F.lane); }
        { f32x4 a[2] = {{0.f, 0.f, 0.f, 0.f}, {0.f, 0.f, 0.f, 0.f}}; mm(a, ArkT, VC, F.wave, F.lane); gst_cm(GP(o3 + S3_HY), a, F.wave, F.lane); }
        { f32x4 a[2] = {{0.f, 0.f, 0.f, 0.f}, {0.f, 0.f, 0.f, 0.f}}; mm(a, KbC, VC, F.wave, F.lane); gst_cm(GP(o2 + S2_HQ), a, F.wave, F.lane); }
        lmat Pr_old = PXr, Pc_old = PXc, Pr_new = PYr, Pc_new = PYc, M_old = PXr, M_new = MA;
        if (!(var & 2))
#pragma unroll
        for (int it = 1; it <= 5; ++it) {
            f32x4 p[2] = {{0.f, 0.f, 0.f, 0.f}, {0.f, 0.f, 0.f, 0.f}}; mm(p, Pr_old, Pc_old, F.wave, F.lane);
            st_rm(Pr_new, p, F.wave, F.lane); st_cm(Pc_new, p, F.wave, F.lane);
            CK_LBAR();
            f32x4 a[2] = {mn[0] + p[0], mn[1] + p[1]}; mm(a, M_old, Pc_new, F.wave, F.lane); mn[0] = a[0]; mn[1] = a[1];
            st_rm(M_new, a, F.wave, F.lane);
            CK_LBAR();
            { lmat t1 = Pr_old; Pr_old = Pr_new; Pr_new = t1; t1 = Pc_old; Pc_old = Pc_new; Pc_new = t1; }
            M_old = M_new; M_new = (M_new == MA) ? MB : MA;
        }
        copy_out<true>(GP(o2 + S2_MN), M_old, F.tid);
        CK_LBAR();
    }
#undef CKB
#undef GP
}

__device__ __forceinline__ bf16x8 pack8(const f32x16& x, int s) { const u32x4 w = (u32x4){pk(x[8 * s], x[8 * s + 1]), pk(x[8 * s + 2], x[8 * s + 3]), pk(x[8 * s + 4], x[8 * s + 5]), pk(x[8 * s + 6], x[8 * s + 7])}; return __builtin_bit_cast(bf16x8, w); }
__device__ __forceinline__ void ph_s2(Frame& F, int var) {
    ENTER(F);
    const unsigned char* s2in = F.ws + WS_SCR + SC_S2IN; unsigned char* su = F.ws + WS_SCR + SC_SU;
    LAS unsigned char* base = F.lds + RING_OFF;
    constexpr int BUFB = 5 * MATB + 256;
    const int r32 = F.lane & 31, hi = F.lane >> 5;
    for (int bh = blockIdx.x; bh < NB * MIXH; bh += F.G) {
        f32x16 st[2]; st[0] = f32x16{}; st[1] = f32x16{};
        const int lt = F.tid - 128;
        u32x4 stg[7];
#define S2_IDX(k_) ((lt + 384 * (k_)) < 5 * 512 + 15 ? (lt + 384 * (k_)) : 5 * 512 + 15)
#define S2_LOAD(cc) do { const unsigned char* g_ = s2in + (size_t)(bh * NCH + (cc)) * S2_BYTES; _Pragma("unroll") for (int k_ = 0; k_ < 7; ++k_) stg[k_] = *(const GAS u32x4*)(g_ + (size_t)S2_IDX(k_) * 16); } while (0)
#define S2_WRITE(cc) do { LAS unsigned char* d_ = base + ((cc) & 1) * BUFB; _Pragma("unroll") for (int k_ = 0; k_ < 7; ++k_) { const int idx_ = S2_IDX(k_); const int mtx_ = idx_ >> 9, rem_ = idx_ & 511; \
            const int off_ = idx_ < 5 * 512 ? mtx_ * MATB + (rem_ >> 3) * (LD * 2) + (rem_ & 7) * 16 : 5 * MATB + (idx_ - 5 * 512) * 16; *(LAS u32x4*)(d_ + off_) = stg[k_]; } } while (0)
        if (F.wave >= 2) S2_LOAD(0);
        for (int c = -1; c <= NCH; ++c) {
            if (F.wave >= 2) { if (c + 1 < NCH) S2_WRITE(c + 1); if (c + 2 < NCH) S2_LOAD(c + 2);
                if (c >= 1 && !(var & 1)) {
                    const LAS unsigned char* ob = base + 2 * BUFB + ((c - 1) & 1) * 2 * MATB; unsigned char* so = su + (size_t)(bh * NCH + c - 1) * SU_BYTES;
#pragma unroll
                    for (int k = 0; k < 3; ++k) { const int idx = (lt + 384 * k) < 1023 ? (lt + 384 * k) : 1023; const int mtx = idx >> 9, rem = idx & 511;
                        *(GAS u32x4*)(so + (size_t)idx * 16) = *(const LAS u32x4*)(ob + mtx * MATB + (rem >> 3) * (LD * 2) + (rem & 7) * 16); } } }
            if (F.wave < 2 && c >= 0 && c < NCH && !(var & 2)) {
                const LAS unsigned char* d = base + (c & 1) * BUFB; const int ih = F.wave; const int icol = 32 * ih + r32;
                const lmat AtP = (lmat)d, MnP = (lmat)(d + MATB), BbP = (lmat)(d + 2 * MATB), HkT = (lmat)(d + 3 * MATB), HqT = (lmat)(d + 4 * MATB); const LAS float* gC = (const LAS float*)(d + 5 * MATB);
                LAS unsigned char* ob = base + 2 * BUFB + (c & 1) * 2 * MATB;
#pragma unroll
                for (int jt = 0; jt < 2; ++jt)
#pragma unroll
                    for (int g4 = 0; g4 < 4; ++g4) *(LAS u32x2*)((lmat)ob + icol * LD + 32 * jt + 8 * g4 + 4 * hi) = (u32x2){pk(st[jt][4 * g4], st[jt][4 * g4 + 1]), pk(st[jt][4 * g4 + 2], st[jt][4 * g4 + 3])};
                bf16x8 bs[4];
#pragma unroll
                for (int ks = 0; ks < 4; ++ks) bs[ks] = pack8(st[ks >> 1], ks & 1);
                f32x16 rh[2];
#pragma unroll
                for (int mt = 0; mt < 2; ++mt)
#pragma unroll
                    for (int g4 = 0; g4 < 4; ++g4) { const u32x2 w = *(const LAS u32x2*)(HkT + icol * LD + 32 * mt + 8 * g4 + 4 * hi); rh[mt][4 * g4] = bflo(w.x); rh[mt][4 * g4 + 1] = bfhi(w.x); rh[mt][4 * g4 + 2] = bflo(w.y); rh[mt][4 * g4 + 3] = bfhi(w.y); }
                bf16x8 af[8];
#define S2_AF(Mat) do { _Pragma("unroll") for (int q_ = 0; q_ < 8; ++q_) af[q_] = *(const LAS bf16x8*)((Mat) + (32 * (q_ >> 2) + r32) * LD + 16 * (q_ & 3) + 8 * hi); __builtin_amdgcn_sched_barrier(0); } while (0)
                S2_AF(AtP);
#pragma unroll
                for (int mt = 0; mt < 2; ++mt)
#pragma unroll
                    for (int ks = 0; ks < 4; ++ks) rh[mt] = __builtin_amdgcn_mfma_f32_32x32x16_bf16(af[4 * mt + ks], bs[ks], rh[mt], 0, 0, 0);
                bf16x8 br[4];
#pragma unroll
                for (int ks = 0; ks < 4; ++ks) br[ks] = pack8(rh[ks >> 1], ks & 1);
                f32x16 uu[2]; uu[0] = rh[0]; uu[1] = rh[1];
                S2_AF(MnP);
#pragma unroll
                for (int mt = 0; mt < 2; ++mt)
#pragma unroll
                    for (int ks = 0; ks < 4; ++ks) uu[mt] = __builtin_amdgcn_mfma_f32_32x32x16_bf16(af[4 * mt + ks], br[ks], uu[mt], 0, 0, 0);
#pragma unroll
                for (int mt = 0; mt < 2; ++mt)
#pragma unroll
                    for (int g4 = 0; g4 < 4; ++g4) *(LAS u32x2*)((lmat)(ob + MATB) + icol * LD + 32 * mt + 8 * g4 + 4 * hi) = (u32x2){pk(uu[mt][4 * g4], uu[mt][4 * g4 + 1]), pk(uu[mt][4 * g4 + 2], uu[mt][4 * g4 + 3])};
                bf16x8 bu[4];
#pragma unroll
                for (int ks = 0; ks < 4; ++ks) bu[ks] = pack8(uu[ks >> 1], ks & 1);
#pragma unroll
                for (int jt = 0; jt < 2; ++jt)
#pragma unroll
                    for (int g4 = 0; g4 < 4; ++g4) { const u32x2 w = *(const LAS u32x2*)(HqT + icol * LD + 32 * jt + 8 * g4 + 4 * hi); const f32x4 gc = *(const LAS f32x4*)(gC + 32 * jt + 8 * g4 + 4 * hi);
                        st[jt][4 * g4] = st[jt][4 * g4] * gc.x + bflo(w.x); st[jt][4 * g4 + 1] = st[jt][4 * g4 + 1] * gc.y + bfhi(w.x); st[jt][4 * g4 + 2] = st[jt][4 * g4 + 2] * gc.z + bflo(w.y); st[jt][4 * g4 + 3] = st[jt][4 * g4 + 3] * gc.w + bfhi(w.y); }
                S2_AF(BbP);
#pragma unroll
                for (int jt = 0; jt < 2; ++jt)
#pragma unroll
                    for (int ks = 0; ks < 4; ++ks) st[jt] = __builtin_amdgcn_mfma_f32_32x32x16_bf16(af[4 * jt + ks], bu[ks], st[jt], 0, 0, 0);
#undef S2_AF
            }
            CK_LBAR();
        }
#undef S2_LOAD
#undef S2_WRITE
#undef S2_IDX
    }
}
__device__ __forceinline__ void ph_s3(Frame& F, int l) {
    ENTER(F);
    const unsigned char* s3in = F.ws + WS_SCR + SC_S3IN; const unsigned char* su = F.ws + WS_SCR + SC_SU;
    const float* vec = inp(6) + (size_t)l * 6 * MIXW; const float* lg = vec + 4 * MIXW; const float* lb = vec + 5 * MIXW;
    const float* V = (const float*)(F.ws + WS_SCR + SC_V); const float* Gt = (const float*)(F.ws + WS_SCR + SC_G); const float* SRK = (const float*)(F.ws + WS_SCR + SC_SRK);
    unsigned short* MIX = (unsigned short*)(F.ws + WS_MIX);
    LAS unsigned char* base = F.lds + RING_OFF;
    lmat Rt = (lmat)base, S0 = (lmat)(base + MATB), Arb = (lmat)(base + 2 * MATB), Ub = (lmat)(base + 3 * MATB), HyT = (lmat)(base + 4 * MATB);
    LAS float* Yb = (LAS float*)(base + 5 * MATB);
    for (int u = blockIdx.x; u < NUNIT; u += F.G) {
        const int c = u & (NCH - 1), bh = u >> 6, b = bh / MIXH, h = bh % MIXH;
        const unsigned char* g3 = s3in + (size_t)u * S3_BYTES; const unsigned char* gu = su + (size_t)u * SU_BYTES;
        copy_in(Rt, (const bf16*)(g3 + S3_RT), F.tid); copy_in(Arb, (const bf16*)(g3 + S3_ARB), F.tid); copy_in(HyT, (const bf16*)(g3 + S3_HY), F.tid);
        copy_in(S0, (const bf16*)(gu + SU_S0), F.tid); copy_in(Ub, (const bf16*)(gu + SU_U), F.tid);
        const int tt = F.tid >> 3, i0 = 8 * (F.tid & 7); const size_t m = (size_t)b * T + c * 64 + tt; const int cc = h * 64 + i0;
        const f32x4 v0 = *(const GAS f32x4*)(V + m * MIXW + cc), v1 = *(const GAS f32x4*)(V + m * MIXW + cc + 4), g0 = *(const GAS f32x4*)(Gt + m * MIXW + cc), g1 = *(const GAS f32x4*)(Gt + m * MIXW + cc + 4);
        const float srk = SRK[m * MIXH + h];
        CK_LBAR();
        f32x4 a[2];
#pragma unroll
        for (int q = 0; q < 2; ++q) { const int n = 16 * (2 * (F.wave & 1) + q) + (F.lane & 15), m0 = 16 * (F.wave >> 1) + 4 * (F.lane >> 4); const u32x2 w = *(const LAS u32x2*)(HyT + n * LD + m0); a[q] = (f32x4){bflo(w.x), bfhi(w.x), bflo(w.y), bfhi(w.y)}; }
        mm(a, Rt, S0, F.wave, F.lane); mm(a, Arb, Ub, F.wave, F.lane);
#pragma unroll
        for (int q = 0; q < 2; ++q) { const int n = 16 * (2 * (F.wave & 1) + q) + (F.lane & 15), m0 = 16 * (F.wave >> 1) + 4 * (F.lane >> 4);
#pragma unroll
            for (int r = 0; r < 4; ++r) Yb[(m0 + r) * 68 + n] = a[q][r]; }
        CK_LBAR();
        const f32x4 y0 = *(const LAS f32x4*)(Yb + tt * 68 + i0), y1 = *(const LAS f32x4*)(Yb + tt * 68 + i0 + 4);
        float s = (y0.x + y0.y) + (y0.z + y0.w) + (y1.x + y1.y) + (y1.z + y1.w);
        s += dpp<0xB1>(s); s += dpp<0x4E>(s); s += dpp<0x141>(s);
        const float mean = s * (1.0f / 64.0f);
        const f32x4 d0 = y0 - mean, d1 = y1 - mean;
        float qv = (d0.x * d0.x + d0.y * d0.y) + (d0.z * d0.z + d0.w * d0.w) + (d1.x * d1.x + d1.y * d1.y) + (d1.z * d1.z + d1.w * d1.w);
        qv += dpp<0xB1>(qv); qv += dpp<0x4E>(qv); qv += dpp<0x141>(qv);
        const float rstd = 1.0f / sqrtf(qv * (1.0f / 64.0f) + GN_EPS);
        const f32x4 lg0 = *(const f32x4*)(lg + cc), lg1 = *(const f32x4*)(lg + cc + 4), lb0 = *(const f32x4*)(lb + cc), lb1 = *(const f32x4*)(lb + cc + 4);
        const f32x4 o0 = (d0 * rstd * lg0 + lb0 + v0 * srk) * g0, o1 = (d1 * rstd * lg1 + lb1 + v1 * srk) * g1;
        *(GAS u32x4*)(MIX + m * DM + cc) = (u32x4){pk(o0.x, o0.y), pk(o0.z, o0.w), pk(o1.x, o1.y), pk(o1.z, o1.w)};
        CK_LBAR();
    }
}
}
constexpr int PPL = 14, NPHASE = 1 + PPL * DEPTH;
__host__ __device__ inline bool phase_exists(int ph) {
    if (ph == 0) return true;
    const int l = (ph - 1) / PPL, k = (ph - 1) % PPL; const bool isA = l < 2, moe = l & 1;
    if (k == 3 || k == 7) return false;
    if (k >= 2 && k <= 6) return isA;
    if (k == 10) return moe;
    return true;
}
struct Args { const float* in[23]; float* out; unsigned char* ws; int ph_lo, ph_hi, var, pad; };
struct Order {
    int nM, nN, G, c; const int* tile_e;
    __device__ __forceinline__ bool next(int i, pg8::Unit& u) const { if (!pg8::order_map((long)i * G + c, nM, nN, u.pm, u.pn)) return false;
        int e = 0; if (tile_e) e = __builtin_amdgcn_readfirstlane(ld_relaxed(tile_e + u.pm)); u.bt = e * nN + u.pn; return true; }
};
__global__ void __launch_bounds__(NWAVES * 64, 2) fwd(Args args) {
    extern __shared__ __attribute__((aligned(16))) unsigned char lds[];
    Frame F;
    F.lds = (LAS unsigned char*)lds;
    volatile LAS unsigned* MISC = (volatile LAS unsigned*)(F.lds + MISC_OFF);
    ENTER(F);
    F.G = gridDim.x; { const int bx = blockIdx.x; F.vcu = (F.G % 8 == 0) ? (bx % 8) * (F.G / 8) + bx / 8 : bx; }
    for (int u = F.tid; u < (LDS_BYTES - LDSCTL_OFF) / 4; u += NWAVES * 64) ((LAS unsigned*)(F.lds + LDSCTL_OFF))[u] = 0u;
    __syncthreads();
    const int lo = args.ph_lo, hi = args.ph_hi;
    XcdBarrier bar; bar.bar = (unsigned*)(F.ws + WS_CTL) + CW_BAR; bar.x = 0; bar.st = MISC + 8;
    if (hi - lo > 1) bar = xcd_barrier_post((unsigned*)(F.ws + WS_CTL) + CW_BAR, MISC + 8);
#define IN(k) (lo <= (k) && (k) < hi)
#define SEAM(k) do { if ((k) + 1 < hi) xcd_barrier(bar); } while (0)

    if (IN(0)) { p0_prologue(F); SEAM(0); }

    for (int l = 0; l < DEPTH; ++l) {
        const int pb = 1 + PPL * l; const bool isA = l < 2, moe = (l & 1) != 0;
        const int NP = l == 0 ? NP0 : l == 1 ? NP1 : DM;
        const int QM_OFF = l == 0 ? NC0 : l == 1 ? NP0 : MIXW;
        if (IN(pb)) {
            for (int gi = 0; gi < 2; ++gi) {
                if (gi == 1 && !(l == 0 || l == 2)) break;
                ENTER(F); unsigned char* ws = F.ws;
                pg8::Gemm g; pg8::EpiStore E; Order S; S.G = F.G; S.c = (int)blockIdx.x; S.tile_e = nullptr;
                if (gi == 0) { const size_t wo = l == 0 ? WS_WIN0 : l == 1 ? WS_WIN1 : l == 2 ? WS_WIN2 : WS_WIN3;
                    g = pg8::Gemm{(const bf16*)(ws + WS_XB), (const bf16*)(ws + wo), DM, DM, DM}; S.nM = M / 256; S.nN = NP / 256;
                    E = pg8::EpiStore{(bf16*)(ws + WS_SCR + SC_P), NP, l == 0 ? (1u << 10) : l == 1 ? (1u << 11) : 0xFu, C2}; }
                else if (l == 0) { g = pg8::Gemm{(const bf16*)(ws + WS_MEMB), (const bf16*)(ws + WS_WMKV), DM, DM, DM}; S.nM = 4; S.nN = 8; E = pg8::EpiStore{(bf16*)(ws + WS_MKV), 2048, 0u, 1.f}; }
                else { g = pg8::Gemm{(const bf16*)(ws + WS_XB), (const bf16*)(ws + WS_WKV), DM, DM, DM}; S.nM = M / 256; S.nN = 6; E = pg8::EpiStore{(bf16*)(ws + WS_KV), 1536, 0u, 1.f}; }
                pg8::gemm_phase<pg8::EpiStore, Order>(F.lds + RING_OFF, g, S, E);
            }
            SEAM(pb);
        }
        if (IN(pb + 1)) {
            if (isA) ph_lora_in(F, l);
            else {
                ENTER(F); unsigned char* ws = F.ws;
                unsigned* ctr = (unsigned*)(ws + WS_CTL) + 64 * (8 + l);
                const bf16* KV = (const bf16*)(ws + WS_KV); const bf16* Pb = (const bf16*)(ws + WS_SCR + SC_P); bf16* MIX = (bf16*)(ws + WS_MIX);
                for (;;) {
                    if (F.tid == 0) MISC[16] = atomicAdd(ctr, 1u);
                    __syncthreads(); const int u = (int)MISC[16]; __syncthreads();
                    if (u >= NB * MIXH * 16) break;
                    const int qb = 15 - u / (NB * MIXH), bh = u % (NB * MIXH), b = bh / MIXH, h = bh % MIXH;
                    att::sb_unit(qb, Pb + (size_t)b * T * DM + h * 64, DM, KV + (size_t)b * T * 1536 + h * 64, KV + (size_t)b * T * 1536 + MIXW + h * 64, 1536, MIX + (size_t)b * T * DM + h * 64, DM, (att::lds_ptr)(F.lds + RING_OFF));
                }
            }
            { ENTER(F); unsigned char* ws = F.ws; const bf16* Pb = (const bf16*)(ws + WS_SCR + SC_P); bf16* MIX = (bf16*)(ws + WS_MIX);
              for (int u = blockIdx.x; u < NB * MEMH * 16; u += F.G) { const int b = u >> 6, hm = (u >> 4) & 3, blk = u & 15;
                const bf16* MKV = (const bf16*)(ws + WS_MKV) + (size_t)b * MEMT * 2048 + l * 512 + hm * 64; const size_t row0 = (size_t)b * T + blk * 256;
                att::mem_unit(Pb + row0 * NP + QM_OFF + hm * 64, NP, MKV, MKV + 256, 2048, MIX + row0 * DM + MIXW + hm * 64, DM, (att::lds_ptr)(F.lds + RING_OFF)); } }
            SEAM(pb + 1);
        }
        if (isA) {
            if (IN(pb + 2)) {
                ENTER(F); unsigned char* ws = F.ws;
                pg8::Gemm g{(const bf16*)(ws + WS_SCR + SC_U), (const bf16*)(ws + WS_WLORA + l * SZ_WLORA), 512, 512, 512};
                Order S; S.G = F.G; S.c = (int)blockIdx.x; S.tile_e = nullptr; S.nM = M / 256; S.nN = 12;
                const float* vec = inp(6) + (size_t)l * 6 * MIXW;
                pg8::EpiLora E{(float*)(ws + WS_SCR + SC_WDEC), (SC_AI - SC_WDEC) / 4, ((size_t)WS_SCR + SC_VG - (WS_SCR + SC_WDEC)) / 4, (SC_G - SC_WDEC) / 4, vec, l == 1 ? inp(10) : nullptr};
                pg8::gemm_phase<pg8::EpiLora, Order>(F.lds + RING_OFF, g, S, E);
                SEAM(pb + 2);
            }
            if (IN(pb + 4)) { ck::ph_s1(F, l, args.var); SEAM(pb + 4); }
            if (IN(pb + 5)) { ck::ph_s2(F, args.var); SEAM(pb + 5); }
            if (IN(pb + 6)) { ck::ph_s3(F, l); SEAM(pb + 6); }
        }
        if (IN(pb + 8)) {
            ENTER(F); unsigned char* ws = F.ws;
            pg8::Gemm g{(const bf16*)(ws + WS_MIX), (const bf16*)(ws + WS_WO + l * SZ_WO), DM, DM, DM};
            Order S; S.G = F.G; S.c = (int)blockIdx.x; S.tile_e = nullptr; S.nM = M / 256; S.nN = 4;
            pg8::EpiResid E{l == 0 ? inp(0) : (const float*)(ws + WS_XF0), (float*)(ws + WS_PRE), DM, ALPHA};
            pg8::gemm_phase<pg8::EpiResid, Order>(F.lds + RING_OFF, g, S, E);
            SEAM(pb + 8);
        }
        if (IN(pb + 9)) { const float* ln = inp(17) + (size_t)l * 4 * DM; ph_ln(F, 0, ln, ln + DM, WS_XF1, WS_XB1, 0, moe ? 1 : 0, inp(20) + (size_t)(l >> 1) * DM * NE); SEAM(pb + 9); }
        if (moe && IN(pb + 10)) { ph_route2(F); SEAM(pb + 10); }
        if (IN(pb + 11)) {
            ENTER(F); unsigned char* ws = F.ws; const int* TILE = (const int*)(ws + WS_ROUTE + RO_TILE);
            pg8::Gemm g; Order S; S.G = F.G; S.c = (int)blockIdx.x; S.nN = 22;
            if (moe) { g = pg8::Gemm{(const bf16*)(ws + WS_SCR + SC_XG), (const bf16*)(ws + WS_WEGU + (size_t)(l >> 1) * 8 * SZ_WGU), DM, DM, DM}; S.tile_e = TILE; S.nM = __builtin_amdgcn_readfirstlane(ld_relaxed(TILE + 255)); }
            else { g = pg8::Gemm{(const bf16*)(ws + WS_XB1), (const bf16*)(ws + WS_WGU + (size_t)(l >> 1) * SZ_WGU), DM, DM, DM}; S.tile_e = nullptr; S.nM = M / 256; }
            pg8::EpiSwiglu E{(bf16*)(ws + WS_SCR + SC_H), FF};
            pg8::gemm_phase<pg8::EpiSwiglu, Order>(F.lds + RING_OFF, g, S, E);
            SEAM(pb + 11);
        }
        if (IN(pb + 12)) {
            ENTER(F); unsigned char* ws = F.ws; const int* TILE = (const int*)(ws + WS_ROUTE + RO_TILE);
            pg8::Gemm g; Order S; S.G = F.G; S.c = (int)blockIdx.x; S.nN = 4; pg8::EpiResid E;
            if (moe) { g = pg8::Gemm{(const bf16*)(ws + WS_SCR + SC_H), (const bf16*)(ws + WS_WEDN + (size_t)(l >> 1) * 8 * SZ_WDN), FF, FF, FF}; S.tile_e = TILE; S.nM = __builtin_amdgcn_readfirstlane(ld_relaxed(TILE + 255));
                E = pg8::EpiResid{nullptr, (float*)(ws + WS_SCR + SC_YE), DM, 0.f}; }
            else { g = pg8::Gemm{(const bf16*)(ws + WS_SCR + SC_H), (const bf16*)(ws + WS_WDN + (size_t)(l >> 1) * SZ_WDN), FF, FF, FF}; S.tile_e = nullptr; S.nM = M / 256; E = pg8::EpiResid{(const float*)(ws + WS_XF1), (float*)(ws + WS_PRE), DM, ALPHA}; }
            pg8::gemm_phase<pg8::EpiResid, Order>(F.lds + RING_OFF, g, S, E);
            SEAM(pb + 12);
        }
        if (IN(pb + 13)) { const float* ln = inp(17) + (size_t)l * 4 * DM; ph_ln(F, moe ? 1 : 0, ln + 2 * DM, ln + 3 * DM, WS_XF0, WS_XB, l == DEPTH - 1 ? 1 : 0, 0, nullptr); SEAM(pb + 13); }
    }
#undef IN
#undef SEAM
}

#ifndef PROBE_VAR
#define PROBE_VAR 0
#endif
#ifndef PROBE_LIST
#define PROBE_LIST -1
#endif
static const int PROBE_PHS[] = {PROBE_LIST};
#ifndef MK_ONE_LAUNCH
#define MK_ONE_LAUNCH 1
#endif
extern "C" void kernel_launch(void* const* d_in, const int* in_sizes, int n_in, void* d_out, int out_size, void* d_ws, size_t ws_size, hipStream_t stream) {
    static int grid = 0;
    if (grid == 0) {
        if (n_in != 23 || in_sizes[0] != M * DM || out_size != M * DM || ws_size < WS_END) { fprintf(stderr, "kernel_launch: shape/workspace mismatch (n_in %d, ws %zu, need %zu)\n", n_in, ws_size, (size_t)WS_END); grid = -1; return; }
        int dev = 0, cus = 0, per_cu = 0;
        if (hipGetDevice(&dev) != hipSuccess || hipDeviceGetAttribute(&cus, hipDeviceAttributeMultiprocessorCount, dev) != hipSuccess) { grid = -1; return; }
        if (hipFuncSetAttribute((const void*)fwd, hipFuncAttributeMaxDynamicSharedMemorySize, LDS_BYTES) != hipSuccess) { fprintf(stderr, "kernel_launch: hipFuncSetAttribute failed\n"); grid = -1; return; }
        if (hipOccupancyMaxActiveBlocksPerMultiprocessor(&per_cu, (const void*)fwd, NWAVES * 64, LDS_BYTES) != hipSuccess || per_cu < 1) fprintf(stderr, "kernel_launch: occupancy query reports %d\n", per_cu);
        (void)hipGetLastError();
        grid = cus;
    }
    if (grid < 0) return;
    if (hipMemsetAsync((char*)d_ws + WS_CTL, 0, CTL_ZERO_BYTES, stream) != hipSuccess) return;
    Args a{};
    for (int i = 0; i < 23; ++i) a.in[i] = (const float*)d_in[i];
    a.out = (float*)d_out; a.ws = (unsigned char*)d_ws;
    if (MK_ONE_LAUNCH) { a.ph_lo = 0; a.ph_hi = NPHASE; hipLaunchKernelGGL(fwd, dim3(grid), dim3(NWAVES * 64), LDS_BYTES, stream, a); }
    else for (int ph = 0; ph < NPHASE; ++ph) { if (!phase_exists(ph)) continue; a.ph_lo = ph; a.ph_hi = ph + 1;
        int reps = 1; for (int q : PROBE_PHS) if (q == ph) reps = 2;
        for (int r = 0; r < reps; ++r) { if (r) (void)hipMemsetAsync((char*)d_ws + WS_CTL, 0, CTL_ZERO_BYTES, stream); a.var = (reps == 2 && r == 0) ? PROBE_VAR : 0; hipLaunchKernelGGL(fwd, dim3(grid), dim3(NWAVES * 64), LDS_BYTES, stream, a); } }
}
```

```cpp
#include <hip/hip_runtime.h>
#include <cstdio>
#include <cstdint>
#include <cmath>
#define MK_ONE_LAUNCH 1
#define PROBE_LIST -1
#define PROBE_VAR 0
namespace pg8 {
#define PG8_LAS __attribute__((address_space(3)))
typedef unsigned short bf16_t;
typedef short bf16x8 __attribute__((ext_vector_type(8)));
typedef float f32x4 __attribute__((ext_vector_type(4)));
typedef float f32x2 __attribute__((ext_vector_type(2)));
typedef unsigned u32x4 __attribute__((ext_vector_type(4)));
typedef unsigned u32x2 __attribute__((ext_vector_type(2)));
constexpr int BM = 256, BK = 64, HALF = 128, HTB = HALF * BK * 2, STAGE_BYTES = 8 * HTB, NXCD = 8, WGM = 8;

__host__ __device__ __forceinline__ int lds_byte(int r, int c) { const int st = (r >> 4) * 2 + (c >> 5), rr = r & 15, cc = c & 31, ob = rr * 64 + cc * 2; return st * 1024 + (ob ^ (((ob >> 9) & 1) << 5)); }
__host__ __device__ __forceinline__ void stage_rc(int b, int& R, int& C) { const int st = b / 1024, sb = b % 1024, swz = sb ^ (((sb >> 9) & 1) << 5); R = (st >> 1) * 16 + swz / 64; C = (st & 1) * 32 + (swz % 64) / 2; }
__host__ __device__ __forceinline__ int perm32(int rho) { const int n = rho >> 4, i = rho & 15; return 8 * (i >> 2) + 4 * n + (i & 3); }

struct Unit { int pm, pn, bt; };
struct Gemm { const bf16_t* A; const bf16_t* Bt; int lda, ldb, K; };

__device__ __forceinline__ bool order_map(long L, int nM, int nN, int& pm, int& pn) {
    const int nwg = nM * nN; if (L >= nwg) return false;
    int wgid = (int)L; { const int q = nwg / NXCD, r = nwg % NXCD, xcd = wgid % NXCD, off = wgid / NXCD; wgid = (xcd < r ? xcd * (q + 1) : r * (q + 1) + (xcd - r) * q) + off; }
    const int nig = WGM * nN, gid = wgid / nig, fm = gid * WGM, gsz = (nM - fm) < WGM ? (nM - fm) : WGM;
    pm = fm + ((wgid % nig) % gsz); pn = (wgid % nig) / gsz; return true;
}
struct StaticOrder {
    int nM, nN, G, c;
    __device__ void init(int M, int N, int G_, int c_) { nM = M / BM; nN = N / BM; G = G_; c = c_; }
    __device__ __forceinline__ bool next(int i, Unit& u) const { if (!order_map((long)i * G + c, nM, nN, u.pm, u.pn)) return false; u.bt = u.pn; return true; }
};
struct MoeOrder {
    int nM, nN, G, c; const int* tile_e;
    __device__ __forceinline__ bool next(int i, Unit& u) const { if (!order_map((long)i * G + c, nM, nN, u.pm, u.pn)) return false;
        const int e = __builtin_amdgcn_readfirstlane(__hip_atomic_load(tile_e + u.pm, __ATOMIC_RELAXED, __HIP_MEMORY_SCOPE_AGENT)); u.bt = e * nN + u.pn; return true; }
};

__device__ __forceinline__ unsigned cvt_pk_bf16(float lo, float hi) { unsigned r; asm volatile("v_cvt_pk_bf16_f32 %0, %1, %2" : "=v"(r) : "v"(lo), "v"(hi)); return r; }

struct EpiStore {
    static constexpr bool PERM = true;
    bf16_t* O; int ldc; unsigned scale_mask; float scale;
    __device__ __forceinline__ void operator()(const f32x4 (&acc)[2][2][4][2], const Unit& u, int wr, int wc, int fr, int fq) const {
        const int row0 = u.pm * BM + wr * 64 + fr, col0 = u.pn * BM + wc * 32 + 8 * fq;
        const float sc = ((scale_mask >> u.pn) & 1u) ? scale : 1.f;
#pragma unroll
        for (int ai = 0; ai < 2; ++ai)
#pragma unroll
            for (int m = 0; m < 4; ++m) { bf16_t* rowp = O + (size_t)(row0 + ai * HALF + m * 16) * ldc + col0;
#pragma unroll
                for (int bj = 0; bj < 2; ++bj) { const f32x4 v0 = acc[ai][bj][m][0] * sc, v1 = acc[ai][bj][m][1] * sc;
                    u32x4 w; w.x = cvt_pk_bf16(v0[0], v0[1]); w.y = cvt_pk_bf16(v0[2], v0[3]); w.z = cvt_pk_bf16(v1[0], v1[1]); w.w = cvt_pk_bf16(v1[2], v1[3]);
                    *(u32x4*)(rowp + bj * HALF) = w; } }
    }
};
__device__ __forceinline__ float silu_mul(float g, float u) { return g * u * __builtin_amdgcn_rcpf(1.0f + __builtin_amdgcn_exp2f(-1.4426950408889634f * g)); }
struct EpiSwiglu {
    static constexpr bool PERM = true;
    bf16_t* H; int ldc;
    __device__ __forceinline__ void operator()(const f32x4 (&acc)[2][2][4][2], const Unit& u, int wr, int wc, int fr, int fq) const {
        const int row0 = u.pm * BM + wr * 64 + fr, col0 = u.pn * HALF + wc * 32 + 8 * fq;
#pragma unroll
        for (int ai = 0; ai < 2; ++ai)
#pragma unroll
            for (int m = 0; m < 4; ++m) { bf16_t* rowp = H + (size_t)(row0 + ai * HALF + m * 16) * ldc + col0;
                const f32x4 g0 = acc[ai][0][m][0], g1 = acc[ai][0][m][1], u0 = acc[ai][1][m][0], u1 = acc[ai][1][m][1];
                u32x4 w; w.x = cvt_pk_bf16(silu_mul(g0[0], u0[0]), silu_mul(g0[1], u0[1])); w.y = cvt_pk_bf16(silu_mul(g0[2], u0[2]), silu_mul(g0[3], u0[3]));
                w.z = cvt_pk_bf16(silu_mul(g1[0], u1[0]), silu_mul(g1[1], u1[1])); w.w = cvt_pk_bf16(silu_mul(g1[2], u1[2]), silu_mul(g1[3], u1[3]));
                *(u32x4*)rowp = w; }
    }
};
struct EpiResid {
    static constexpr bool PERM = false;
    const float* base; float* out; int ldc; float alpha;
    __device__ __forceinline__ void operator()(const f32x4 (&acc)[2][2][4][2], const Unit& u, int wr, int wc, int fr, int fq) const {
        const int row0 = u.pm * BM + wr * 64 + fr, col0 = u.pn * BM + wc * 32 + 4 * fq;
#pragma unroll
        for (int ai = 0; ai < 2; ++ai)
#pragma unroll
            for (int m = 0; m < 4; ++m) { const size_t off = (size_t)(row0 + ai * HALF + m * 16) * ldc + col0;
#pragma unroll
                for (int bj = 0; bj < 2; ++bj)
#pragma unroll
                    for (int n = 0; n < 2; ++n) { f32x4 o = acc[ai][bj][m][n];
                        if (base) { const f32x4 bs = *(const f32x4*)(base + off + bj * HALF + n * 16); o = o + bs * alpha; }
                        *(f32x4*)(out + off + bj * HALF + n * 16) = o; } }
    }
};
struct EpiLora {
    static constexpr bool PERM = false;
    float* out0; size_t off1, off2, off3; const float* vec; const float* v0;
    __device__ __forceinline__ void operator()(const f32x4 (&acc)[2][2][4][2], const Unit& u, int wr, int wc, int fr, int fq) const {
        const int blk = u.pn / 3, cb0 = (u.pn - 3 * blk) * BM + wc * 32 + 4 * fq, row0 = u.pm * BM + wr * 64 + fr;
        if (blk == 2 && v0 == nullptr) return;
        float* outp = out0 + (blk == 0 ? (size_t)0 : blk == 1 ? off1 : blk == 2 ? off2 : off3);
        const float* bias = blk == 2 ? v0 : vec + (blk & 1) * 768;
#pragma unroll
        for (int bj = 0; bj < 2; ++bj)
#pragma unroll
            for (int n = 0; n < 2; ++n) { const int cb = cb0 + bj * HALF + n * 16;
                f32x4 bv = (f32x4){0.f, 0.f, 0.f, 0.f}; if (blk < 3) bv = *(const f32x4*)(bias + cb);
#pragma unroll
                for (int ai = 0; ai < 2; ++ai)
#pragma unroll
                    for (int m = 0; m < 4; ++m) { f32x4 v = acc[ai][bj][m][n] + bv, o;
#pragma unroll
                        for (int j = 0; j < 4; ++j) { const float d = v[j]; float r;
                            if (blk == 0) { const float sp = fmaxf(-d, 0.f) + __logf(1.0f + __expf(-fabsf(d)));
                                r = -__expf(-sp - 0.5f); }
                            else if (blk == 3) r = d;
                            else r = 1.0f / (1.0f + __expf(-d));
                            o[j] = r; }
                        *(f32x4*)(outp + (size_t)(row0 + ai * HALF + m * 16) * 768 + cb) = o; } }
    }
};

template <class Epi, class Sched>
__device__ __forceinline__ void gemm_phase(PG8_LAS unsigned char* lds, const Gemm g, const Sched& S, const Epi& E) {
    int tid = threadIdx.x; asm volatile("" : "+v"(tid));
    const int wid = __builtin_amdgcn_readfirstlane(tid >> 6), lane = tid & 63, wr = wid >> 2, wc = wid & 3, fr = lane & 15, fq = lane >> 4;
    const int K = g.K, nt = K / BK;
    unsigned voffA[2], voffB[2];
#pragma unroll
    for (int i = 0; i < 2; ++i) { int R, C; stage_rc(tid * 16 + i * 8192, R, C); const int Rb = Epi::PERM ? ((R & ~31) + perm32(R & 31)) : R;
        voffA[i] = (unsigned)(R * g.lda + C) * 2u; voffB[i] = (unsigned)(Rb * g.ldb + C) * 2u; }
    const size_t kstep = (size_t)(BK * 2);
    const size_t hstepA = (size_t)HALF * g.lda * 2, hstepB = (size_t)HALF * g.ldb * 2;
    const size_t tstepA = 2 * hstepA, tstepB = 2 * hstepB;
    const unsigned ldsw = (unsigned)wid * 1024u;
    const int aoff = lds_byte(wr * 64 + fr, fq * 8), boff = lds_byte(wc * 32 + fr, fq * 8);
#define PG8_SA(b, h) (((b) * 2 + (h)) * HTB)
#define PG8_SB(b, h) ((4 + (b) * 2 + (h)) * HTB)
#define PG8_STAGE(bufoff, gbase, voff) do { _Pragma("unroll") for (int _i = 0; _i < 2; ++_i) \
        __builtin_amdgcn_global_load_lds((const unsigned*)((const char*)(gbase) + (voff)[_i]), (PG8_LAS unsigned*)(lds + (bufoff) + ldsw + _i * 8192), 16, 0, 0); } while (0)
#define PG8_LDA(dst, b, h) do { _Pragma("unroll") for (int m = 0; m < 4; ++m) _Pragma("unroll") for (int k = 0; k < 2; ++k) dst[m][k] = *(const PG8_LAS bf16x8*)(lds + PG8_SA(b, h) + aoff + m * 2048 + k * 1024); } while (0)
#define PG8_LDB(dst, b, h) do { _Pragma("unroll") for (int n = 0; n < 2; ++n) _Pragma("unroll") for (int k = 0; k < 2; ++k) dst[n][k] = *(const PG8_LAS bf16x8*)(lds + PG8_SB(b, h) + boff + n * 2048 + k * 1024); } while (0)
#define PG8_MMA(ai, bj, At, Bt) do { __builtin_amdgcn_s_setprio(1); _Pragma("unroll") for (int m = 0; m < 4; ++m) _Pragma("unroll") for (int n = 0; n < 2; ++n) _Pragma("unroll") for (int k = 0; k < 2; ++k) \
        acc[ai][bj][m][n] = __builtin_amdgcn_mfma_f32_16x16x32_bf16(Bt[n][k], At[m][k], acc[ai][bj][m][n], 0, 0, 0); __builtin_amdgcn_s_setprio(0); } while (0)
#define PG8_WAIT_V(n) asm volatile("s_waitcnt vmcnt(" #n ")" ::: "memory")
#define PG8_WAIT_L(n) asm volatile("s_waitcnt lgkmcnt(" #n ")" ::: "memory")
#define PG8_BAR __builtin_amdgcn_s_barrier()
#define PG8_SCHED __builtin_amdgcn_sched_barrier(0)
    Unit cur, nxt; int ui = 0;
    if (!S.next(0, cur)) return;
    f32x4 acc[2][2][4][2];
#pragma unroll
    for (int a = 0; a < 2; ++a)
#pragma unroll
        for (int b = 0; b < 2; ++b)
#pragma unroll
            for (int m = 0; m < 4; ++m)
#pragma unroll
                for (int n = 0; n < 2; ++n) acc[a][b][m][n] = (f32x4){0.f, 0.f, 0.f, 0.f};
    bf16x8 At[4][2], B0[2][2], B1[2][2];
    const char* cA = (const char*)g.A + (size_t)cur.pm * tstepA; const char* cB = (const char*)g.Bt + (size_t)cur.bt * tstepB;
    PG8_STAGE(PG8_SB(0, 0), cB, voffB); PG8_STAGE(PG8_SB(0, 1), cB + hstepB, voffB); PG8_STAGE(PG8_SA(0, 0), cA, voffA); PG8_STAGE(PG8_SA(0, 1), cA + hstepA, voffA);
    if (wr == 1) PG8_BAR;
    PG8_WAIT_V(2); PG8_BAR;
    PG8_STAGE(PG8_SB(1, 0), cB + kstep, voffB); PG8_STAGE(PG8_SA(1, 0), cA + kstep, voffA); PG8_STAGE(PG8_SB(1, 1), cB + hstepB + kstep, voffB);
    PG8_WAIT_V(6); PG8_BAR;
    for (;;) {
        const bool has_next = S.next(ui + 1, nxt);
        const char* nA = has_next ? (const char*)g.A + (size_t)nxt.pm * tstepA : cA; const char* nB = has_next ? (const char*)g.Bt + (size_t)nxt.bt * tstepB : cB;
        for (int t = 0; t < nt; t += 2) {
            const bool last = (t == nt - 2);
            const char* a1 = cA + (size_t)(t + 1) * kstep;
            const char* a2 = last ? nA : cA + (size_t)(t + 2) * kstep; const char* b2 = last ? nB : cB + (size_t)(t + 2) * kstep;
            const char* a3 = a2 + kstep; const char* b3 = b2 + kstep;
            PG8_LDB(B0, 0, 0); PG8_LDB(B1, 0, 1); PG8_SCHED; PG8_LDA(At, 0, 0); PG8_STAGE(PG8_SA(1, 1), a1 + hstepA, voffA);
            PG8_WAIT_V(8); PG8_WAIT_L(0); PG8_BAR; PG8_MMA(0, 0, At, B0); PG8_MMA(0, 1, At, B1); PG8_BAR; PG8_SCHED;
            PG8_LDA(At, 0, 1); PG8_STAGE(PG8_SB(0, 0), b2, voffB); PG8_STAGE(PG8_SB(0, 1), b2 + hstepB, voffB); PG8_STAGE(PG8_SA(0, 0), a2, voffA);
            PG8_WAIT_V(8); PG8_WAIT_L(0); PG8_BAR; PG8_MMA(1, 0, At, B0); PG8_MMA(1, 1, At, B1); PG8_BAR; PG8_SCHED;
            PG8_LDB(B0, 1, 0); PG8_LDB(B1, 1, 1); PG8_SCHED; PG8_LDA(At, 1, 0); PG8_STAGE(PG8_SA(0, 1), a2 + hstepA, voffA);
            PG8_WAIT_V(8); PG8_WAIT_L(0); PG8_BAR; PG8_MMA(0, 0, At, B0); PG8_MMA(0, 1, At, B1); PG8_BAR; PG8_SCHED;
            PG8_LDA(At, 1, 1); PG8_STAGE(PG8_SB(1, 0), b3, voffB); PG8_STAGE(PG8_SB(1, 1), b3 + hstepB, voffB); PG8_STAGE(PG8_SA(1, 0), a3, voffA);
            PG8_WAIT_V(8); PG8_WAIT_L(0); PG8_BAR; PG8_MMA(1, 0, At, B0); PG8_MMA(1, 1, At, B1); PG8_BAR; PG8_SCHED;
        }
        if (wr == 0) PG8_BAR;
        E(acc, cur, wr, wc, fr, fq);
        if (!has_next) break;
#pragma unroll
        for (int a = 0; a < 2; ++a)
#pragma unroll
            for (int b = 0; b < 2; ++b)
#pragma unroll
                for (int m = 0; m < 4; ++m)
#pragma unroll
                    for (int n = 0; n < 2; ++n) acc[a][b][m][n] = (f32x4){0.f, 0.f, 0.f, 0.f};
        cur = nxt; cA = nA; cB = nB; ++ui;
        if (wr == 1) PG8_BAR;
    }
    PG8_WAIT_V(0);
    PG8_BAR;
#undef PG8_SA
#undef PG8_SB
#undef PG8_STAGE
#undef PG8_LDA
#undef PG8_LDB
#undef PG8_MMA
#undef PG8_WAIT_V
#undef PG8_WAIT_L
#undef PG8_BAR
#undef PG8_SCHED
}
}
namespace att {
using bf16 = unsigned short;
using bf16x8 = __attribute__((ext_vector_type(8))) short;
using s16x4 = __attribute__((ext_vector_type(4))) short;
using f32x16 = __attribute__((ext_vector_type(16))) float;
using u32x4 = __attribute__((ext_vector_type(4))) unsigned;
typedef short v4i16_t __attribute__((ext_vector_type(4)));
typedef __attribute__((address_space(3))) const char* lds_cptr;
typedef __attribute__((address_space(3))) char* lds_ptr;
typedef float f32x2_t __attribute__((ext_vector_type(2))); typedef __bf16 bf16x2_t __attribute__((ext_vector_type(2)));
__device__ __forceinline__ int crow(int r, int hi) { return (r & 3) + 8 * (r >> 2) + 4 * hi; }
__device__ __forceinline__ unsigned cvtpk_s(float lo, float hi) { f32x2_t v = {lo, hi}; bf16x2_t b = __builtin_convertvector(v, bf16x2_t); return __builtin_bit_cast(unsigned, b); }
#define ATT_SBAR() __builtin_amdgcn_sched_barrier(0)
#define ATT_WAIT_BAR(N) asm volatile("s_waitcnt vmcnt(" #N ") lgkmcnt(0)\n\ts_barrier" ::: "memory")
constexpr int SLOTB = 8192;
__device__ __forceinline__ void glds16(const void* gsrc, unsigned lds_dst) { unsigned keep;
    asm volatile("s_mov_b32 %0, m0\n\ts_mov_b32 m0, %2\n\ts_nop 0\n\tglobal_load_lds_dwordx4 %1, off\n\ts_mov_b32 m0, %0" : "=&s"(keep) : "v"(gsrc), "s"(lds_dst) : "memory"); }
__device__ __forceinline__ void dma_k(const bf16* ktile, int pitch, unsigned slot_lds, int wid, int lane) {
    glds16(ktile + (long)lane * pitch + wid * 8, (unsigned)__builtin_amdgcn_readfirstlane(slot_lds + wid * 1024)); }
__device__ __forceinline__ void dma_v(const bf16* vtile, int pitch, unsigned slot_lds, int wid, int lane) {
    glds16(vtile + (long)(16 * (wid & 3) + (lane >> 2)) * pitch + (wid >> 2) * 32 + (lane & 3) * 8, (unsigned)__builtin_amdgcn_readfirstlane(slot_lds + wid * 1024)); }
__device__ __forceinline__ void qkt(f32x16& p0, f32x16& p1, lds_cptr Kslot, const bf16x8* qr, int r32, int hi) {
    lds_cptr kb = Kslot + hi * 1024 + r32 * 16;
    const f32x16 z = {};
#pragma unroll
    for (int d0 = 0; d0 < 4; ++d0) {
        const bf16x8 b0 = *(const __attribute__((address_space(3))) bf16x8*)(kb + d0 * 2048);
        const bf16x8 b1 = *(const __attribute__((address_space(3))) bf16x8*)(kb + d0 * 2048 + 512);
        if (d0 == 0) { p0 = __builtin_amdgcn_mfma_f32_32x32x16_bf16(b0, qr[0], z, 0, 0, 0); p1 = __builtin_amdgcn_mfma_f32_32x32x16_bf16(b1, qr[0], z, 0, 0, 0); }
        else { p0 = __builtin_amdgcn_mfma_f32_32x32x16_bf16(b0, qr[d0], p0, 0, 0, 0); p1 = __builtin_amdgcn_mfma_f32_32x32x16_bf16(b1, qr[d0], p1, 0, 0, 0); } }
}
__device__ __forceinline__ s16x4 vtr(lds_cptr p) { return __builtin_bit_cast(s16x4, __builtin_amdgcn_ds_read_tr16_b64_v4i16((__attribute__((address_space(3))) v4i16_t*)p)); }
__device__ __forceinline__ void pv(f32x16* o, lds_cptr vp, bf16x8 pa0, bf16x8 pa1, bf16x8 pa2, bf16x8 pa3) {
#pragma unroll
    for (int d0 = 0; d0 < 2; ++d0) { s16x4 lo[4], hi[4];
#pragma unroll
        for (int ks = 0; ks < 4; ++ks) { lo[ks] = vtr(vp + d0 * 4096 + ks * 1024); hi[ks] = vtr(vp + d0 * 4096 + ks * 1024 + 512); }
#define ATT_PK(k) (bf16x8){lo[k][0], lo[k][1], lo[k][2], lo[k][3], hi[k][0], hi[k][1], hi[k][2], hi[k][3]}
        o[d0] = __builtin_amdgcn_mfma_f32_32x32x16_bf16(pa0, ATT_PK(0), o[d0], 0, 0, 0);
        o[d0] = __builtin_amdgcn_mfma_f32_32x32x16_bf16(pa1, ATT_PK(1), o[d0], 0, 0, 0);
        o[d0] = __builtin_amdgcn_mfma_f32_32x32x16_bf16(pa2, ATT_PK(2), o[d0], 0, 0, 0);
        o[d0] = __builtin_amdgcn_mfma_f32_32x32x16_bf16(pa3, ATT_PK(3), o[d0], 0, 0, 0);
#undef ATT_PK
    }
}
__device__ __forceinline__ float swap_lo(float x, float& hi_out) { auto rr = __builtin_amdgcn_permlane32_swap(__float_as_uint(x), __float_as_uint(x), false, false); hi_out = __uint_as_float(rr[1]); return __uint_as_float(rr[0]); }
#define ATT_PKW(P, B) cvtpk_s(P[B], P[B + 1])
#define ATT_PACK4(P0, P1, w0, w1, w2, w3) do { w0 = (u32x4){ATT_PKW(P0, 0), ATT_PKW(P0, 2), ATT_PKW(P0, 4), ATT_PKW(P0, 6)}; w1 = (u32x4){ATT_PKW(P0, 8), ATT_PKW(P0, 10), ATT_PKW(P0, 12), ATT_PKW(P0, 14)}; \
    w2 = (u32x4){ATT_PKW(P1, 0), ATT_PKW(P1, 2), ATT_PKW(P1, 4), ATT_PKW(P1, 6)}; w3 = (u32x4){ATT_PKW(P1, 8), ATT_PKW(P1, 10), ATT_PKW(P1, 12), ATT_PKW(P1, 14)}; } while (0)
__device__ __forceinline__ void store_o(const f32x16* o, const float* rscale, lds_ptr stg, bf16* Ow, int pitch, int lane, int r32, int hi) {
    __attribute__((address_space(3))) bf16* s = (__attribute__((address_space(3))) bf16*)stg;
#pragma unroll
    for (int r = 0; r < 16; ++r) { const int orow = crow(r, hi);
#pragma unroll
        for (int d0 = 0; d0 < 2; ++d0) { const float v = o[d0][r] * rscale[r]; s[orow * 64 + d0 * 32 + r32] = (bf16)(cvtpk_s(v, v) & 0xffffu); } }
    asm volatile("s_waitcnt lgkmcnt(0)" ::: "memory");
#pragma unroll
    for (int i = 0; i < 4; ++i) { const int row = i * 8 + (lane >> 3), ch = lane & 7; const u32x4 v = *(const __attribute__((address_space(3))) u32x4*)(s + row * 64 + ch * 8); *(u32x4*)(Ow + (long)row * pitch + ch * 8) = v; }
}

constexpr int LDS_K = 0, LDS_V = 4 * SLOTB, LDS_WS = 8 * SLOTB, LDS_OST = LDS_WS + 8 * 256, ATT_LDS_BYTES = LDS_OST + 8 * 4096;

__device__ __forceinline__ void sb_unit(int qb, const bf16* Qh, int qp, const bf16* Kh, const bf16* Vh, int kp, bf16* Oh, int op, lds_ptr shm, int var) {
    int tid = threadIdx.x; asm volatile("" : "+v"(tid)); const int lane = tid & 63, r32 = lane & 31, hi = lane >> 5; const int wid = __builtin_amdgcn_readfirstlane(tid >> 6);
    const unsigned lds0 = (unsigned)(size_t)shm;
    const int q0w = qb * 256 + wid * 32;
    const int NT = 4 * qb + 4;
    const int tmax = (q0w + 30) >> 6;
    const lds_cptr kp0 = (lds_cptr)shm + LDS_K, vp0 = (lds_cptr)shm + LDS_V + ((lane >> 4) & 1) * 32 + (lane & 3) * 8 + (4 * hi + ((lane & 15) >> 2)) * 64;
#define SB_DMA_K(t) dma_k(Kh + (long)(t) * 64 * kp, kp, lds0 + LDS_K + ((t) % 3) * SLOTB, wid, lane)
#define SB_DMA_V(t) dma_v(Vh + (long)(t) * 64 * kp, kp, lds0 + LDS_V + ((t) & 1) * SLOTB, wid, lane)
    SB_DMA_K(NT - 1); SB_DMA_V(NT - 1); SB_DMA_K(NT - 2);
    bf16x8 qr[4];
#pragma unroll
    for (int d0 = 0; d0 < 4; ++d0) qr[d0] = *(const bf16x8*)(Qh + (long)(q0w + r32) * qp + d0 * 16 + hi * 8);
    f32x16 o[2]; o[0] = f32x16{}; o[1] = f32x16{};
    float carry = 1.0f;
    const int qabs = q0w + r32;
    f32x16 pA0, pA1, pB0, pB1; pA0 = f32x16{}; pA1 = f32x16{}; pB0 = f32x16{}; pB1 = f32x16{};
    ATT_WAIT_BAR(0);
    if (NT - 1 <= tmax) qkt(pA0, pA1, kp0 + ((NT - 1) % 3) * SLOTB, qr, r32, hi);
#define SB_STEP(C0, C1, N0, N1, t) do { \
        ATT_WAIT_BAR(0);                                         \
        if ((t) >= 2) SB_DMA_K((t) - 2); if ((t) >= 1) SB_DMA_V((t) - 1); \
        if ((t) >= 1 && (t) - 1 <= tmax && !(var & 2)) qkt(N0, N1, kp0 + (((t) - 1) % 3) * SLOTB, qr, r32, hi); \
        if ((t) <= tmax && !(var & 2)) { if (!(var & 1)) { \
            f32x16 x0, x1; \
            if (64 * (t) + 63 >= q0w) {                          \
                const int kb = 64 * (t) + 4 * hi; \
                _Pragma("unroll") for (int r = 0; r < 16; ++r) { \
                    const float e0 = __builtin_amdgcn_exp2f(C0[r]), e1 = __builtin_amdgcn_exp2f(C1[r]); \
                    float a0 = __builtin_amdgcn_rcpf(1.0f + e0), a1 = __builtin_amdgcn_rcpf(1.0f + e1); \
                    const int kv = kb + (r & 3) + 8 * (r >> 2); if (kv >= qabs) a0 = 1.f; if (kv + 32 >= qabs) a1 = 1.f; \
                    x0[r] = a0; x1[r] = a1; } \
            } else { \
                _Pragma("unroll") for (int r = 0; r < 16; ++r) { x0[r] = __builtin_amdgcn_rcpf(1.0f + __builtin_amdgcn_exp2f(C0[r])); x1[r] = __builtin_amdgcn_rcpf(1.0f + __builtin_amdgcn_exp2f(C1[r])); } \
            } \
            float gp[8], lo[8], hv[8], T[8]; \
            _Pragma("unroll") for (int m = 0; m < 4; ++m) { gp[m] = (x0[4 * m] * x0[4 * m + 1]) * (x0[4 * m + 2] * x0[4 * m + 3]); gp[4 + m] = (x1[4 * m] * x1[4 * m + 1]) * (x1[4 * m + 2] * x1[4 * m + 3]); } \
            _Pragma("unroll") for (int m = 0; m < 8; ++m) lo[m] = swap_lo(gp[m], hv[m]); \
            T[7] = carry; \
            _Pragma("unroll") for (int m = 6; m >= 0; --m) T[m] = T[m + 1] * (lo[m + 1] * hv[m + 1]); \
            carry = T[0] * (lo[0] * hv[0]); \
              \
            _Pragma("unroll") for (int m = 0; m < 8; ++m) { \
                float c3 = T[m]; if (hi == 0) c3 *= hv[m]; \
                if (m < 4) { const float c2 = c3 * x0[4 * m + 3], c1 = c2 * x0[4 * m + 2], c0 = c1 * x0[4 * m + 1], ce = c0 * x0[4 * m]; C0[4 * m + 3] = c3 - c2; C0[4 * m + 2] = c2 - c1; C0[4 * m + 1] = c1 - c0; C0[4 * m] = c0 - ce; } \
                else { const int q = m - 4; const float c2 = c3 * x1[4 * q + 3], c1 = c2 * x1[4 * q + 2], c0 = c1 * x1[4 * q + 1], ce = c0 * x1[4 * q]; C1[4 * q + 3] = c3 - c2; C1[4 * q + 2] = c2 - c1; C1[4 * q + 1] = c1 - c0; C1[4 * q] = c0 - ce; } } \
            } \
            u32x4 w0, w1, w2, w3; ATT_PACK4(C0, C1, w0, w1, w2, w3); \
            pv(o, vp0 + ((t) & 1) * SLOTB, __builtin_bit_cast(bf16x8, w0), __builtin_bit_cast(bf16x8, w1), __builtin_bit_cast(bf16x8, w2), __builtin_bit_cast(bf16x8, w3)); } \
    } while (0)
    for (int t = NT - 1; t >= 1; t -= 2) { SB_STEP(pA0, pA1, pB0, pB1, t); SB_STEP(pB0, pB1, pA0, pA1, t - 1); }
#undef SB_STEP
#undef SB_DMA_K
#undef SB_DMA_V
    float one[16];
#pragma unroll
    for (int r = 0; r < 16; ++r) one[r] = 1.0f;
    store_o(o, one, shm + LDS_OST + wid * 4096, Oh + (long)q0w * op, op, lane, r32, hi);
    asm volatile("s_waitcnt lgkmcnt(0)\n\ts_barrier" ::: "memory");
}

__device__ __forceinline__ void mem_unit(const bf16* Qh, int qp, const bf16* Kh, const bf16* Vh, int kp, bf16* Oh, int op, lds_ptr shm) {
    int tid = threadIdx.x; asm volatile("" : "+v"(tid)); const int lane = tid & 63, r32 = lane & 31, hi = lane >> 5; const int wid = __builtin_amdgcn_readfirstlane(tid >> 6);
    const unsigned lds0 = (unsigned)(size_t)shm;
    const lds_cptr kp0 = (lds_cptr)shm + LDS_K, vp0 = (lds_cptr)shm + LDS_V + ((lane >> 4) & 1) * 32 + (lane & 3) * 8 + (4 * hi + ((lane & 15) >> 2)) * 64;
#pragma unroll
    for (int t = 0; t < 4; ++t) { dma_k(Kh + (long)t * 64 * kp, kp, lds0 + LDS_K + t * SLOTB, wid, lane); dma_v(Vh + (long)t * 64 * kp, kp, lds0 + LDS_V + t * SLOTB, wid, lane); }
    bf16x8 qr[4];
#pragma unroll
    for (int d0 = 0; d0 < 4; ++d0) qr[d0] = *(const bf16x8*)(Qh + (long)(wid * 32 + r32) * qp + d0 * 16 + hi * 8);
    ATT_WAIT_BAR(0);
    f32x16 p[8];
#pragma unroll
    for (int t = 0; t < 4; ++t) qkt(p[2 * t], p[2 * t + 1], kp0 + t * SLOTB, qr, r32, hi);
    float mx = -INFINITY;
#pragma unroll
    for (int t = 0; t < 8; ++t)
#pragma unroll
        for (int r = 0; r < 16; ++r) mx = fmaxf(mx, p[t][r]);
    { float h2; const float l2 = swap_lo(mx, h2); mx = fmaxf(l2, h2); }
    float sum = 0.f;
#pragma unroll
    for (int t = 0; t < 8; ++t)
#pragma unroll
        for (int r = 0; r < 16; ++r) { const float e = __builtin_amdgcn_exp2f(p[t][r] - mx); p[t][r] = e; sum += e; }
    { float h2; const float l2 = swap_lo(sum, h2); sum = l2 + h2; }
    f32x16 o[2]; o[0] = f32x16{}; o[1] = f32x16{};
#pragma unroll
    for (int t = 0; t < 4; ++t) { u32x4 w0, w1, w2, w3; ATT_PACK4(p[2 * t], p[2 * t + 1], w0, w1, w2, w3);
        pv(o, vp0 + t * SLOTB, __builtin_bit_cast(bf16x8, w0), __builtin_bit_cast(bf16x8, w1), __builtin_bit_cast(bf16x8, w2), __builtin_bit_cast(bf16x8, w3)); }
    __attribute__((address_space(3))) float* wsf = (__attribute__((address_space(3))) float*)(shm + LDS_WS) + wid * 64;
    if (hi == 0) wsf[r32] = sum;
    asm volatile("s_waitcnt lgkmcnt(0)" ::: "memory");
    float rli[16];
#pragma unroll
    for (int r = 0; r < 16; ++r) rli[r] = __builtin_amdgcn_rcpf(wsf[crow(r, hi)]);
    store_o(o, rli, shm + LDS_OST + wid * 4096, Oh + (long)(wid * 32) * op, op, lane, r32, hi);
    asm volatile("s_waitcnt lgkmcnt(0)\n\ts_barrier" ::: "memory");
}
}
constexpr int NWAVES = 8;
constexpr int DM = 1024, NB = 4, T = 4096, M = NB * T, DEPTH = 4, HD = 64, MIXH = 12, MIXW = 768, MEMH = 4, MEMW = 256, MEMT = 256;
constexpr int FF = 2816, NE = 8, NC0 = 2560, NC1 = 2592, NP0 = 2816, NP1 = 3072;
constexpr int MAXSLOT = 2 * M + NE * 256;
constexpr float LN_EPS = 1e-5f, GN_EPS = 64e-5f, ALPHA = 1.681792830507429f;
constexpr float C2 = 0.125f * 1.4426950408889634f;
typedef unsigned short bf16;

constexpr size_t al256(size_t x) { return (x + 255) & ~(size_t)255; }
constexpr size_t WS_CTL = 0, CTL_ZERO_BYTES = 1u << 20;
constexpr size_t SZ_WIN0 = (size_t)NP0 * DM * 2, SZ_WIN1 = (size_t)NP1 * DM * 2, SZ_WINB = (size_t)DM * DM * 2, SZ_WKV = (size_t)1536 * DM * 2, SZ_WMKV = (size_t)2048 * DM * 2, SZ_WO = (size_t)DM * DM * 2;
constexpr size_t SZ_WGU = (size_t)2 * FF * DM * 2, SZ_WDN = (size_t)DM * FF * 2, SZ_WLORA = (size_t)3072 * 512 * 2;
constexpr size_t WS_WIN0 = CTL_ZERO_BYTES, WS_WIN1 = WS_WIN0 + SZ_WIN0, WS_WIN2 = WS_WIN1 + SZ_WIN1, WS_WIN3 = WS_WIN2 + SZ_WINB, WS_WKV = WS_WIN3 + SZ_WINB, WS_WMKV = WS_WKV + SZ_WKV;
constexpr size_t WS_WO = WS_WMKV + SZ_WMKV, WS_WGU = WS_WO + 4 * SZ_WO, WS_WDN = WS_WGU + 2 * SZ_WGU, WS_WEGU = WS_WDN + 2 * SZ_WDN, WS_WEDN = WS_WEGU + 16 * SZ_WGU, WS_WLORA = WS_WEDN + 16 * SZ_WDN;
constexpr size_t WS_XB = WS_WLORA + 2 * SZ_WLORA, WS_XB1 = WS_XB + (size_t)M * DM * 2, WS_MEMB = WS_XB1 + (size_t)M * DM * 2, WS_MKV = WS_MEMB + (size_t)1024 * DM * 2;
constexpr size_t WS_XF0 = WS_MKV + (size_t)1024 * 2048 * 2, WS_XF1 = WS_XF0 + (size_t)M * DM * 4, WS_PRE = WS_XF1 + (size_t)M * DM * 4, WS_VFIRST = WS_PRE + (size_t)M * DM * 4;
constexpr size_t WS_MIX = WS_VFIRST + (size_t)M * MIXW * 4, WS_KV = WS_MIX + (size_t)M * DM * 2, WS_ROUTE = WS_KV + (size_t)M * 1536 * 2;
constexpr size_t RO_E = 0, RO_W = RO_E + (size_t)M * 4, RO_SLOT = RO_W + (size_t)M * 8, RO_CNTC = RO_SLOT + (size_t)M * 8, RO_TILE = RO_CNTC + 256 * 8 * 4, RO_END = RO_TILE + 256 * 4;
constexpr size_t WS_SCR = al256(WS_ROUTE + RO_END);
constexpr size_t SC_P = 0, SC_U = SC_P + (size_t)M * NP1 * 2, SC_WDEC = SC_U + (size_t)M * 512 * 2;
constexpr size_t SC_AI = SC_WDEC + (size_t)M * MIXW * 4, SC_VG = SC_AI + (size_t)M * MIXW * 4, SC_G = SC_VG + (size_t)M * MIXW * 4, SC_V = SC_G + (size_t)M * MIXW * 4, SC_SRK = SC_V + (size_t)M * MIXW * 4;
static_assert(SC_WDEC < SC_AI && SC_AI < SC_VG && SC_VG < SC_G, "EpiLora offsets are unsigned");
constexpr size_t CK_NUNIT = (size_t)NB * MIXH * (T / 64);
constexpr size_t SC_S2IN = al256(SC_SRK + (size_t)M * MIXH * 4), SC_S3IN = SC_S2IN + CK_NUNIT * 41216, SC_SU = SC_S3IN + CK_NUNIT * 24576, SC_MIXEND = SC_SU + CK_NUNIT * 16384;
constexpr size_t SC_H = 0, SC_XG = SC_H + (size_t)MAXSLOT * FF * 2, SC_YE = SC_XG + (size_t)MAXSLOT * DM * 2, SC_FFNEND = SC_YE + (size_t)MAXSLOT * DM * 4;
constexpr size_t WS_END = WS_SCR + (SC_MIXEND > SC_FFNEND ? SC_MIXEND : SC_FFNEND);
constexpr int CW_BAR = 4096;
constexpr int RING_OFF = 0, RING_BYTES = 131072, LDSCTL_OFF = RING_BYTES, MISC_OFF = LDSCTL_OFF + 320, LDS_BYTES = 147456;

#define GAS __attribute__((address_space(1)))
#define LAS __attribute__((address_space(3)))
typedef unsigned v4u __attribute__((ext_vector_type(4)));
typedef float f32x4 __attribute__((ext_vector_type(4)));
typedef GAS unsigned gu32;
#define RLX_AGENT __ATOMIC_RELAXED, __HIP_MEMORY_SCOPE_AGENT
#define LDS_WAIT() asm volatile("s_waitcnt lgkmcnt(0)" ::: "memory")
__device__ __forceinline__ unsigned f2bf(float f) { unsigned u = __builtin_bit_cast(unsigned, f); return (u + 0x7fffu + ((u >> 16) & 1u)) >> 16; }
__device__ __forceinline__ unsigned pk2(float lo, float hi) { return f2bf(lo) | (f2bf(hi) << 16); }
__device__ __forceinline__ float bf2f(unsigned short b) { return __builtin_bit_cast(float, (unsigned)b << 16); }
__device__ __forceinline__ float bflo(unsigned w) { return __builtin_bit_cast(float, w << 16); }
__device__ __forceinline__ float bfhi(unsigned w) { return __builtin_bit_cast(float, w & 0xffff0000u); }
__device__ __forceinline__ int ld_relaxed(const int* p) { return __hip_atomic_load(p, __ATOMIC_RELAXED, __HIP_MEMORY_SCOPE_AGENT); }

#define XB_TMO      128
#define XB_XCNT(j)  (256  + 64 * (j))
#define XB_XSUB(j)  (1280 + 64 * (j))
#define XB_XGEN(j)  (2304 + 64 * (j))
#define XB_TOP      3328
#define XB_TOPGEN   3392
#define XCD_BAR_WORDS 3456
#define XB_SPIN_CAP (1u << 18)
__device__ __forceinline__ unsigned xb_ld(unsigned* p)              { return __hip_atomic_load(p, __ATOMIC_RELAXED, __HIP_MEMORY_SCOPE_AGENT); }
__device__ __forceinline__ unsigned xb_add(unsigned* p, unsigned v) { return __hip_atomic_fetch_add(p, v, __ATOMIC_RELAXED, __HIP_MEMORY_SCOPE_AGENT); }
__device__ __forceinline__ unsigned xb_xcc_id() { return (unsigned)__builtin_amdgcn_s_getreg((3 << 11) | 20) & 0xFu; }
#define XB_SPIN(cond, bar) do { unsigned _sp = 0; while (cond) { __builtin_amdgcn_s_sleep(1); \
    if ((++_sp & 255u) == 0u) { if (xb_ld(&(bar)[XB_TMO])) break; if (_sp > XB_SPIN_CAP) { atomicAdd(&(bar)[XB_TMO], 1u); break; } } } } while (0)
struct XcdBarrier { unsigned* bar; unsigned x; volatile LAS unsigned* st; };
__device__ __forceinline__ XcdBarrier xcd_barrier_post(unsigned* bar, volatile LAS unsigned* st) {
    XcdBarrier b; b.bar = bar; b.x = xb_xcc_id(); b.st = st;
    if (threadIdx.x == 0) (void)xb_add(&bar[XB_XCNT(b.x)], 1u);
    return b;
}
__device__ __forceinline__ void xcd_barrier_complete(unsigned* bar, unsigned x, unsigned& nloc, unsigned& nx) {
    const unsigned G = gridDim.x * gridDim.y * gridDim.z;
    unsigned sum, cnt, mine, sp = 0u;
    for (;;) {
        sum = 0u; cnt = 0u; mine = 0u;
#pragma unroll
        for (unsigned j = 0; j < 16; ++j) { const unsigned c = xb_ld(&bar[XB_XCNT(j)]); sum += c; cnt += (c > 0u) ? 1u : 0u; mine = (j == x) ? c : mine; }
        if (sum == G) break;
        __builtin_amdgcn_s_sleep(1);
        if ((++sp & 255u) == 0u) { if (xb_ld(&bar[XB_TMO])) break; if (sp > XB_SPIN_CAP) { atomicAdd(&bar[XB_TMO], 1u); break; } }
    }
    nloc = mine > 0u ? mine : 1u; nx = cnt > 0u ? cnt : 1u;
}
__device__ __forceinline__ void xcd_barrier(const XcdBarrier& b) {
    asm volatile("s_waitcnt vmcnt(0)" ::: "memory");
    __syncthreads();
    if (threadIdx.x == 0) {
        unsigned* bar = b.bar;
        __builtin_amdgcn_s_waitcnt(0);
        unsigned nloc = b.st[0], nx = b.st[1];
        if (nloc == 0u) { xcd_barrier_complete(bar, b.x, nloc, nx); b.st[0] = nloc; b.st[1] = nx; }
        const unsigned old = xb_add(&bar[XB_XSUB(b.x)], 1u);
        const unsigned gen = old / nloc;
        if (old + 1u == (gen + 1u) * nloc) {
            __builtin_amdgcn_fence(__ATOMIC_RELEASE, "agent");
            asm volatile("s_waitcnt vmcnt(0)" ::: "memory");
            const unsigned og = xb_add(&bar[XB_TOP], 1u);
            const unsigned tg = og / nx;
            if (og + 1u == (tg + 1u) * nx) xb_add(&bar[XB_TOPGEN], 1u);
            else XB_SPIN(xb_ld(&bar[XB_TOPGEN]) == tg, bar);
            __builtin_amdgcn_fence(__ATOMIC_ACQUIRE, "agent");
            xb_add(&bar[XB_XGEN(b.x)], 1u);
            asm volatile("s_waitcnt vmcnt(0)" ::: "memory");
        } else {
            XB_SPIN(xb_ld(&bar[XB_XGEN(b.x)]) == gen, bar);
            __builtin_amdgcn_fence(__ATOMIC_ACQUIRE, "agent");
            asm volatile("s_waitcnt vmcnt(0)" ::: "memory");
        }
    }
    __syncthreads();
}

struct Frame {
    LAS unsigned char* lds;
    unsigned char* ws;
    int tid, lane, wave, vcu, G;
};
typedef __attribute__((address_space(4))) const unsigned char* kptr_t;
__device__ __forceinline__ const float* inp(int k) { kptr_t ka = (kptr_t)__builtin_amdgcn_kernarg_segment_ptr(); asm volatile("" : "+s"(ka)); return *(const float* const __attribute__((address_space(4)))*)(ka + 8 * k); }
#define ENTER(F) do { int t_ = threadIdx.x; asm volatile("" : "+v"(t_)); (F).tid = t_; (F).lane = t_ & 63; (F).wave = __builtin_amdgcn_readfirstlane(t_ >> 6); unsigned char* w_ = (unsigned char*)inp(24); (F).ws = w_; } while (0)
__device__ __forceinline__ float wave_sum(float v) {
#pragma unroll
    for (int o = 1; o < 64; o <<= 1) v += __shfl_xor(v, o);
    return v;
}
template <int CTRL> __device__ __forceinline__ float dpp(float x) { return __builtin_bit_cast(float, __builtin_amdgcn_mov_dpp(__builtin_bit_cast(int, x), CTRL, 0xf, 0xf, true)); }
__device__ __forceinline__ float red16(float x) { x += dpp<0xB1>(x); x += dpp<0x4E>(x); x += dpp<0x141>(x); x += dpp<0x128>(x); return x; }
static_assert(WS_END <= 1476395008ull, "workspace map exceeds the guaranteed d_ws size");
__device__ __forceinline__ void conv_item(const float* W, int K, int N, bf16* WT, int ldt, int drow0, LAS float* scr, int kb, int nb, int lane) {
    const int k0 = 64 * kb, n0 = 32 * nb;
#pragma unroll 8
    for (int i = 0; i < 32; ++i) { const int kk = 2 * i + (lane >> 5); scr[kk * 33 + (lane & 31)] = W[(size_t)(k0 + kk) * N + n0 + (lane & 31)]; }
    LDS_WAIT(); asm volatile("" ::: "memory");
    const int c = lane & 7;
#pragma unroll
    for (int j = 0; j < 4; ++j) { const int n = (lane >> 3) + 8 * j; const LAS float* s = scr + (8 * c) * 33 + n;
        v4u o; o.x = pk2(s[0 * 33], s[1 * 33]); o.y = pk2(s[2 * 33], s[3 * 33]); o.z = pk2(s[4 * 33], s[5 * 33]); o.w = pk2(s[6 * 33], s[7 * 33]);
        *(GAS v4u*)(WT + (size_t)(drow0 + n) * ldt + k0 + 8 * c) = o; }
    LDS_WAIT(); asm volatile("" ::: "memory");
}
__device__ __forceinline__ int swiglu_row(int n0) { const int up = n0 >= FF, h = up ? n0 - FF : n0; return 256 * (h >> 7) + (up ? 128 : 0) + (h & 127); }
__device__ __forceinline__ void conv_mat(const float* W, int K, int N, bf16* WT, int mode, int row_off, LAS float* scr, int r, int lane) {
    const int nblk = N / 32, kb = r / nblk, nb = r % nblk, n0 = 32 * nb;
    const int d0 = mode == 1 ? swiglu_row(n0) : mode == 2 ? (n0 < NC1 ? n0 : n0 - NC1 + NP0) : row_off + n0;
    conv_item(W, K, N, WT, K, d0, scr, kb, nb, lane);
}
__device__ __forceinline__ void p0_prologue(Frame& F) {
    ENTER(F);
    LAS float* scr = (LAS float*)(F.lds + RING_OFF + F.wave * 16384);
    const int gw = F.vcu * NWAVES + F.wave, NGW = F.G * NWAVES;
    unsigned char* ws = F.ws;
    constexpr int I_IN0 = 16 * (NP0 / 32), I_IN1 = 16 * (2848 / 32), I_SQ = 16 * 32, I_KV = 16 * 48, I_MKV = 16 * 16, I_GU = 16 * (2 * FF / 32), I_DN = (FF / 64) * 32;
    constexpr int NITEMS = I_IN0 + I_IN1 + 2 * I_SQ + I_KV + 4 * I_MKV + 4 * I_SQ + 2 * I_GU + 2 * I_DN + 16 * I_GU + 16 * I_DN;
    for (int it = gw; it < NITEMS; it += NGW) {
        int r = it;
        if (r < I_IN0) { conv_mat(inp(2), DM, NP0, (bf16*)(ws + WS_WIN0), 0, 0, scr, r, F.lane); continue; } r -= I_IN0;
        if (r < I_IN1) { conv_mat(inp(3), DM, 2848, (bf16*)(ws + WS_WIN1), 2, 0, scr, r, F.lane); continue; } r -= I_IN1;
        if (r < 2 * I_SQ) { const int j = r / I_SQ; conv_mat(inp(13) + (size_t)j * DM * DM, DM, DM, (bf16*)(ws + WS_WIN2 + j * SZ_WINB), 0, 0, scr, r % I_SQ, F.lane); continue; } r -= 2 * I_SQ;
        if (r < I_KV) { conv_mat(inp(14), DM, 1536, (bf16*)(ws + WS_WKV), 0, 0, scr, r, F.lane); continue; } r -= I_KV;
        if (r < 4 * I_MKV) { const int j = r / I_MKV; conv_mat(inp(15) + (size_t)j * DM * 512, DM, 512, (bf16*)(ws + WS_WMKV), 0, j * 512, scr, r % I_MKV, F.lane); continue; } r -= 4 * I_MKV;
        if (r < 4 * I_SQ) { const int j = r / I_SQ; conv_mat(inp(16) + (size_t)j * DM * DM, DM, DM, (bf16*)(ws + WS_WO + j * SZ_WO), 0, 0, scr, r % I_SQ, F.lane); continue; } r -= 4 * I_SQ;
        if (r < 2 * I_GU) { const int j = r / I_GU; conv_mat(inp(18) + (size_t)j * DM * 2 * FF, DM, 2 * FF, (bf16*)(ws + WS_WGU + j * SZ_WGU), 1, 0, scr, r % I_GU, F.lane); continue; } r -= 2 * I_GU;
        if (r < 2 * I_DN) { const int j = r / I_DN; conv_mat(inp(19) + (size_t)j * FF * DM, FF, DM, (bf16*)(ws + WS_WDN + j * SZ_WDN), 0, 0, scr, r % I_DN, F.lane); continue; } r -= 2 * I_DN;
        if (r < 16 * I_GU) { const int j = r / I_GU; conv_mat(inp(21) + (size_t)j * DM * 2 * FF, DM, 2 * FF, (bf16*)(ws + WS_WEGU + j * SZ_WGU), 1, 0, scr, r % I_GU, F.lane); continue; } r -= 16 * I_GU;
        { const int j = r / I_DN; conv_mat(inp(22) + (size_t)j * FF * DM, FF, DM, (bf16*)(ws + WS_WEDN + j * SZ_WDN), 0, 0, scr, r % I_DN, F.lane); }
    }
    const int gt = F.vcu * (NWAVES * 64) + F.tid, NGT = F.G * NWAVES * 64;
    { GAS v4u* z = (GAS v4u*)(ws + WS_WIN1 + (size_t)NC1 * DM * 2); const int n16 = (NP0 - NC1) * DM * 2 / 16; for (int i = gt; i < n16; i += NGT) z[i] = (v4u){0u, 0u, 0u, 0u}; }
    const float* wup = inp(7); const float* aup = inp(8); const float* gup = inp(9); const float* vup = inp(11);
    for (int i = gt; i < 2 * 3072 * 256; i += NGT) { const int l = i / (3072 * 256), rem = i % (3072 * 256), n = rem / 256, k = (rem % 256) * 2, blk = n / 768, c = n % 768;
        float v0 = 0.f, v1 = 0.f;
        if (blk == 0 && k < 64) { v0 = wup[((size_t)l * 64 + k) * 768 + c]; v1 = wup[((size_t)l * 64 + k + 1) * 768 + c]; }
        else if (blk == 1 && k >= 128 && k < 192) { v0 = aup[((size_t)l * 64 + k - 128) * 768 + c]; v1 = aup[((size_t)l * 64 + k - 127) * 768 + c]; }
        else if (blk == 2 && l == 1 && k >= 256 && k < 288) { v0 = vup[(size_t)(k - 256) * 768 + c]; v1 = vup[(size_t)(k - 255) * 768 + c]; }
        else if (blk == 3 && k >= 384) { v0 = gup[((size_t)l * 128 + k - 384) * 768 + c]; v1 = gup[((size_t)l * 128 + k - 383) * 768 + c]; }
        ((GAS unsigned*)(ws + WS_WLORA))[i] = pk2(v0, v1); }
    { const GAS f32x4* x4 = (const GAS f32x4*)inp(0); GAS v4u* o = (GAS v4u*)(ws + WS_XB);
      for (int i = gt; i < M * DM / 8; i += NGT) { const f32x4 a = x4[2 * i], b = x4[2 * i + 1]; o[i] = (v4u){pk2(a.x, a.y), pk2(a.z, a.w), pk2(b.x, b.y), pk2(b.z, b.w)}; } }
    { const GAS f32x4* x4 = (const GAS f32x4*)inp(1); GAS v4u* o = (GAS v4u*)(ws + WS_MEMB);
      for (int i = gt; i < 1024 * DM / 8; i += NGT) { const f32x4 a = x4[2 * i], b = x4[2 * i + 1]; o[i] = (v4u){pk2(a.x, a.y), pk2(a.z, a.w), pk2(b.x, b.y), pk2(b.z, b.w)}; } }
}

__device__ __forceinline__ float sigmoidf_(float x) { return 1.0f / (1.0f + __expf(-x)); }
__device__ __forceinline__ void ph_lora_in(Frame& F, int l) {
    ENTER(F);
    const int NP = l == 0 ? NP0 : NP1, GD0 = l == 0 ? 2432 : 2464;
    const bf16* P = (const bf16*)(F.ws + WS_SCR + SC_P); bf16* U = (bf16*)(F.ws + WS_SCR + SC_U);
    const float* mu = l == 0 ? inp(4) : inp(5);
    const int gw = F.vcu * NWAVES + F.wave, NGW = F.G * NWAVES;
    const int cu = 8 * F.lane, reg = cu >> 7, off = cu & 127;
    int src = -1, mode = 0;
    if (reg == 0 && off < 64) { src = 2304 + off; mode = 1; }
    else if (reg == 1 && off < 64) { src = 2368 + off; mode = 0; }
    else if (reg == 2 && l == 1 && off < 32) { src = 2432 + off; mode = 0; }
    else if (reg == 3) { src = GD0 + off; mode = 2; }
    for (int m = gw; m < M; m += NGW) {
        v4u o = (v4u){0u, 0u, 0u, 0u};
        if (src >= 0) {
            const v4u pc = *(const GAS v4u*)(P + (size_t)m * NP + src);
            v4u pp = (v4u){0u, 0u, 0u, 0u}; if ((m & (T - 1)) != 0) pp = *(const GAS v4u*)(P + (size_t)(m - 1) * NP + src);
            float v[8];
#pragma unroll
            for (int j = 0; j < 4; ++j) { const float c0 = bflo(pc[j]), c1 = bfhi(pc[j]), q0 = bflo(pp[j]), q1 = bfhi(pp[j]);
                v[2 * j] = c0 + mu[src + 2 * j] * (q0 - c0); v[2 * j + 1] = c1 + mu[src + 2 * j + 1] * (q1 - c1); }
#pragma unroll
            for (int j = 0; j < 8; ++j) { if (mode == 1) v[j] = tanhf(v[j]); else if (mode == 2) v[j] = sigmoidf_(v[j]); }
            o = (v4u){pk2(v[0], v[1]), pk2(v[2], v[3]), pk2(v[4], v[5]), pk2(v[6], v[7])};
        }
        *(GAS v4u*)(U + (size_t)m * 512 + cu) = o;
    }
}
__device__ __forceinline__ void ph_ln(Frame& F, int mode, const float* gain, const float* bias, size_t xf_off, size_t xb_off, int to_out, int route, const float* wr) {
    ENTER(F);
    float* XF = to_out ? (float*)inp(23) : (float*)(F.ws + xf_off); bf16* XB = (bf16*)(F.ws + xb_off);
    const float* PRE = (const float*)(F.ws + WS_PRE); const float* XF1 = (const float*)(F.ws + WS_XF1); const float* YE = (const float*)(F.ws + WS_SCR + SC_YE);
    const int* SLOT = (const int*)(F.ws + WS_ROUTE + RO_SLOT); const float* RW = (const float*)(F.ws + WS_ROUTE + RO_W);
    int* RT_E = (int*)(F.ws + WS_ROUTE + RO_E); float* RT_W = (float*)(F.ws + WS_ROUTE + RO_W); int* CNTC = (int*)(F.ws + WS_ROUTE + RO_CNTC);
    LAS int* cnt = (LAS int*)(F.lds + RING_OFF);
    f32x4 gv[4], bv[4];
#pragma unroll
    for (int j = 0; j < 4; ++j) { gv[j] = *(const f32x4*)(gain + 4 * F.lane + 256 * j); bv[j] = *(const f32x4*)(bias + 4 * F.lane + 256 * j); }
    for (int chunk = blockIdx.x; chunk < M / 64; chunk += F.G) {
        if (route) { if (F.tid < NE) cnt[F.tid] = 0; __syncthreads(); }
        for (int rr = 0; rr < 8; ++rr) { const int m = chunk * 64 + F.wave * 8 + rr;
            f32x4 v[4]; float s = 0.f;
            if (mode == 0) {
#pragma unroll
                for (int j = 0; j < 4; ++j) v[j] = *(const GAS f32x4*)(PRE + (size_t)m * DM + 4 * F.lane + 256 * j);
            } else {
                const int s1 = ld_relaxed(SLOT + 2 * m), s2 = ld_relaxed(SLOT + 2 * m + 1); const float w1 = __builtin_bit_cast(float, ld_relaxed((const int*)RW + 2 * m)), w2 = __builtin_bit_cast(float, ld_relaxed((const int*)RW + 2 * m + 1));
#pragma unroll
                for (int j = 0; j < 4; ++j) { const f32x4 x = *(const GAS f32x4*)(XF1 + (size_t)m * DM + 4 * F.lane + 256 * j), y1 = *(const GAS f32x4*)(YE + (size_t)s1 * DM + 4 * F.lane + 256 * j), y2 = *(const GAS f32x4*)(YE + (size_t)s2 * DM + 4 * F.lane + 256 * j);
                    v[j] = x * ALPHA + y1 * w1 + y2 * w2; }
            }
#pragma unroll
            for (int j = 0; j < 4; ++j) s += (v[j].x + v[j].y) + (v[j].z + v[j].w);
            const float mean = wave_sum(s) * (1.f / DM); float s2 = 0.f;
#pragma unroll
            for (int j = 0; j < 4; ++j) { v[j] = v[j] - mean; s2 += (v[j].x * v[j].x + v[j].y * v[j].y) + (v[j].z * v[j].z + v[j].w * v[j].w); }
            const float rstd = 1.f / sqrtf(wave_sum(s2) * (1.f / DM) + LN_EPS);
#pragma unroll
            for (int j = 0; j < 4; ++j) { v[j] = v[j] * rstd * gv[j] + bv[j];
                *(GAS f32x4*)(XF + (size_t)m * DM + 4 * F.lane + 256 * j) = v[j];
                *(GAS unsigned long long*)(XB + (size_t)m * DM + 4 * F.lane + 256 * j) = (unsigned long long)pk2(v[j].x, v[j].y) | ((unsigned long long)pk2(v[j].z, v[j].w) << 32); }
            if (route) {
                float lg[NE];
#pragma unroll
                for (int e = 0; e < NE; ++e) lg[e] = 0.f;
#pragma unroll
                for (int j = 0; j < 4; ++j)
#pragma unroll
                    for (int q = 0; q < 4; ++q) { const int c = 4 * F.lane + 256 * j + q; const f32x4 wa = *(const f32x4*)(wr + (size_t)c * NE), wb = *(const f32x4*)(wr + (size_t)c * NE + 4); const float xv = v[j][q];
                        lg[0] += xv * wa.x; lg[1] += xv * wa.y; lg[2] += xv * wa.z; lg[3] += xv * wa.w; lg[4] += xv * wb.x; lg[5] += xv * wb.y; lg[6] += xv * wb.z; lg[7] += xv * wb.w; }
#pragma unroll
                for (int e = 0; e < NE; ++e) lg[e] = wave_sum(lg[e]);
                int e1 = 0; float b1 = lg[0];
#pragma unroll
                for (int e = 1; e < NE; ++e) if (lg[e] > b1) { b1 = lg[e]; e1 = e; }
                int e2 = -1; float b2 = -INFINITY;
#pragma unroll
                for (int e = 0; e < NE; ++e) if (e != e1 && lg[e] > b2) { b2 = lg[e]; e2 = e; }
                const float w1 = 1.0f / (1.0f + __expf(b2 - b1));
                if (F.lane == 0) { RT_E[m] = e1 | (e2 << 8); RT_W[2 * m] = w1; RT_W[2 * m + 1] = 1.0f - w1; __hip_atomic_fetch_add(&cnt[e1], 1, __ATOMIC_RELAXED, __HIP_MEMORY_SCOPE_WORKGROUP); __hip_atomic_fetch_add(&cnt[e2], 1, __ATOMIC_RELAXED, __HIP_MEMORY_SCOPE_WORKGROUP); }
            }
        }
        if (route) { __syncthreads(); if (F.tid < NE) CNTC[chunk * NE + F.tid] = cnt[F.tid]; __syncthreads(); }
    }
}
__device__ __forceinline__ void ph_route2(Frame& F) {
    ENTER(F);
    const int* CNTC = (const int*)(F.ws + WS_ROUTE + RO_CNTC); const int* RT_E = (const int*)(F.ws + WS_ROUTE + RO_E); int* SLOT = (int*)(F.ws + WS_ROUTE + RO_SLOT); int* TILE = (int*)(F.ws + WS_ROUTE + RO_TILE);
    const bf16* XB1 = (const bf16*)(F.ws + WS_XB1); bf16* XG = (bf16*)(F.ws + WS_SCR + SC_XG);
    LAS int* sh = (LAS int*)(F.lds + RING_OFF);
    for (int chunk = blockIdx.x; chunk < M / 64; chunk += F.G) {
        { const int e = F.wave; int tot = 0, off = 0;
#pragma unroll
          for (int k = 0; k < 4; ++k) { const int c = F.lane + 64 * k; const int v = ld_relaxed(CNTC + c * NE + e); tot += v; off += (c < chunk) ? v : 0; }
          tot = (int)wave_sum((float)tot); off = (int)wave_sum((float)off);
          if (F.lane == 0) { sh[e] = tot; sh[8 + e] = off; } }
        __syncthreads();
        if (F.tid == 0) { int sb = 0; for (int e = 0; e < NE; ++e) { sh[16 + e] = sb; sb += (sh[e] + 255) & ~255; } sh[24] = sb; }
        __syncthreads();
        if (F.wave == 0) { const int m = chunk * 64 + F.lane; const int ee = ld_relaxed(RT_E + m); const int e1 = ee & 0xff, e2 = (ee >> 8) & 0xff;
            const unsigned long long below = (1ull << F.lane) - 1ull; int s1 = 0, s2 = 0;
#pragma unroll
            for (int e = 0; e < NE; ++e) { const unsigned long long m1 = __ballot(e1 == e), m2 = __ballot(e2 == e); const int prior = __popcll(m1 & below) + __popcll(m2 & below);
                const int base = sh[16 + e] + sh[8 + e] + prior; if (e1 == e) s1 = base; if (e2 == e) s2 = base; }
            SLOT[2 * m] = s1; SLOT[2 * m + 1] = s2; sh[32 + 2 * F.lane] = s1; sh[33 + 2 * F.lane] = s2; }
        __syncthreads();
        for (int a = F.wave; a < 128; a += NWAVES) { const int slot = sh[32 + a], m = chunk * 64 + (a >> 1);
            const GAS v4u* s = (const GAS v4u*)(XB1 + (size_t)m * DM); GAS v4u* d = (GAS v4u*)(XG + (size_t)slot * DM);
            d[F.lane] = s[F.lane]; d[64 + F.lane] = s[64 + F.lane]; }
        if (chunk == 0 && F.tid < 256) { const int nt = sh[24] >> 8; int e = 0; for (int q = 1; q < NE; ++q) if (F.tid * 256 >= sh[16 + q]) e = q; TILE[F.tid] = (F.tid == 255) ? nt : e; }
        __syncthreads();
    }
}
namespace ck {
#define CK_LBAR() asm volatile("s_waitcnt lgkmcnt(0)\n\ts_barrier" ::: "memory")
typedef unsigned short bf16;
typedef short bf16x8 __attribute__((ext_vector_type(8)));
typedef float f32x4 __attribute__((ext_vector_type(4)));
typedef float f32x16 __attribute__((ext_vector_type(16)));
typedef unsigned u32x4 __attribute__((ext_vector_type(4)));
typedef unsigned u32x2 __attribute__((ext_vector_type(2)));
typedef LAS bf16* lmat;
constexpr int LD = 72, MATB = 64 * LD * 2;
constexpr int NCH = T / 64, NUNIT = NB * MIXH * NCH;
constexpr size_t S2_AT = 0, S2_MN = 8192, S2_BB = 16384, S2_HK = 24576, S2_HQ = 32768, S2_GC = 40960, S2_BYTES = 41216;
constexpr size_t S3_RT = 0, S3_ARB = 8192, S3_HY = 16384, S3_BYTES = 24576;
constexpr size_t SU_S0 = 0, SU_U = 8192, SU_BYTES = 16384;
__device__ __forceinline__ unsigned pk(float lo, float hi) { typedef float f2 __attribute__((ext_vector_type(2))); typedef __bf16 b2 __attribute__((ext_vector_type(2))); f2 v = {lo, hi}; b2 b = __builtin_convertvector(v, b2); return __builtin_bit_cast(unsigned, b); }
__device__ __forceinline__ int kperm(int p) { const int blk = p & ~15, h = (p >> 3) & 1, e = p & 7; return blk + 8 * (e >> 2) + 4 * h + (e & 3); }
__device__ __forceinline__ void mm(f32x4 (&acc)[2], lmat L, lmat R, int wave, int lane) {
    const int tm = wave >> 1, l15 = lane & 15, kq = lane >> 4;
#pragma unroll
    for (int kk = 0; kk < 2; ++kk) { const bf16x8 a = *(const LAS bf16x8*)(L + (16 * tm + l15) * LD + 32 * kk + 8 * kq);
#pragma unroll
        for (int q = 0; q < 2; ++q) { const bf16x8 b = *(const LAS bf16x8*)(R + (16 * (2 * (wave & 1) + q) + l15) * LD + 32 * kk + 8 * kq); acc[q] = __builtin_amdgcn_mfma_f32_16x16x32_bf16(a, b, acc[q], 0, 0, 0); } }
}
template <int MASK> __device__ __forceinline__ void maskacc(f32x4 (&acc)[2], int wave, int lane) {
    if (MASK == 0) return;
#pragma unroll
    for (int q = 0; q < 2; ++q) { const int n = 16 * (2 * (wave & 1) + q) + (lane & 15);
#pragma unroll
        for (int r = 0; r < 4; ++r) { const int m = 16 * (wave >> 1) + 4 * (lane >> 4) + r; const bool keep = MASK == 1 ? (n < m) : (n <= m); if (!keep) acc[q][r] = 0.f; } }
}
__device__ __forceinline__ void st_rm(lmat D, const f32x4 (&acc)[2], int wave, int lane) {
#pragma unroll
    for (int q = 0; q < 2; ++q) { const int n = 16 * (2 * (wave & 1) + q) + (lane & 15), m0 = 16 * (wave >> 1) + 4 * (lane >> 4);
#pragma unroll
        for (int r = 0; r < 4; ++r) D[(m0 + r) * LD + n] = (bf16)(pk(acc[q][r], 0.f) & 0xffffu); }
}
__device__ __forceinline__ void st_cm(lmat D, const f32x4 (&acc)[2], int wave, int lane) {
#pragma unroll
    for (int q = 0; q < 2; ++q) { const int n = 16 * (2 * (wave & 1) + q) + (lane & 15), m0 = 16 * (wave >> 1) + 4 * (lane >> 4);
        *(LAS u32x2*)(D + n * LD + m0) = (u32x2){pk(acc[q][0], acc[q][1]), pk(acc[q][2], acc[q][3])}; }
}
__device__ __forceinline__ void gst_cm(bf16* G, const f32x4 (&acc)[2], int wave, int lane) {
    if (G == nullptr) return;
#pragma unroll
    for (int q = 0; q < 2; ++q) { const int n = 16 * (2 * (wave & 1) + q) + (lane & 15), m0 = 16 * (wave >> 1) + 4 * (lane >> 4);
        *(GAS u32x2*)(G + n * 64 + m0) = (u32x2){pk(acc[q][0], acc[q][1]), pk(acc[q][2], acc[q][3])}; }
}
template <bool PERM> __device__ __forceinline__ void copy_out(bf16* G, lmat Smat, int tid) {
    if (G == nullptr) return;
    const int row = tid >> 3, p0 = (tid & 7) * 8;
    if (PERM) { unsigned short v[8];
#pragma unroll
        for (int e = 0; e < 8; ++e) v[e] = Smat[row * LD + kperm(p0 + e)];
        *(GAS u32x4*)(G + row * 64 + p0) = (u32x4){(unsigned)v[0] | ((unsigned)v[1] << 16), (unsigned)v[2] | ((unsigned)v[3] << 16), (unsigned)v[4] | ((unsigned)v[5] << 16), (unsigned)v[6] | ((unsigned)v[7] << 16)}; }
    else *(GAS u32x4*)(G + row * 64 + p0) = *(const LAS u32x4*)(Smat + row * LD + p0);
}
__device__ __forceinline__ void copy_in(lmat D, const bf16* G, int tid) { const int row = tid >> 3, p0 = (tid & 7) * 8; *(LAS u32x4*)(D + row * LD + p0) = *(const GAS u32x4*)(G + row * 64 + p0); }

__device__ __forceinline__ float wsum64(float x) {
    x = red16(x);
    auto s = __builtin_amdgcn_permlane16_swap(__float_as_uint(x), __float_as_uint(x), false, false); x = __uint_as_float(s[0]) + __uint_as_float(s[1]);
    auto t = __builtin_amdgcn_permlane32_swap(__float_as_uint(x), __float_as_uint(x), false, false); return __uint_as_float(t[0]) + __uint_as_float(t[1]);
}
__device__ __forceinline__ void ph_s1(Frame& F, int l, int var) {
    ENTER(F);
    const int NP = l == 0 ? NP0 : NP1;
    const unsigned short* P = (const unsigned short*)(F.ws + WS_SCR + SC_P);
    const float* mu = l == 0 ? inp(4) : inp(5);
    const float* vec = inp(6) + (size_t)l * 6 * MIXW; const float* rkp = inp(12) + (size_t)l * MIXW;
    const float* pAI = (const float*)(F.ws + WS_SCR + SC_AI); const float* pLW = (const float*)(F.ws + WS_SCR + SC_WDEC); const float* pVG = (const float*)(F.ws + WS_SCR + SC_VG);
    float* pV = (float*)(F.ws + WS_SCR + SC_V); float* SRK = (float*)(F.ws + WS_SCR + SC_SRK); float* VF = (float*)(F.ws + WS_VFIRST);
    unsigned char* s2in = F.ws + WS_SCR + SC_S2IN; unsigned char* s3in = F.ws + WS_SCR + SC_S3IN;
    LAS unsigned char* base = F.lds + RING_OFF;
#define CKB(k) ((lmat)(base + (k) * MATB))
#define GP(p) ((var & 4) ? (bf16*)nullptr : (bf16*)(p))
    lmat At = CKB(0), Rt = CKB(1), Bh = CKB(2), Kh = CKB(3), VC = CKB(4), KbC = CKB(5), PXr = CKB(6), PXc = CKB(7), AkT = CKB(8), ArkT = CKB(9), ArbT = CKB(10), PYr = CKB(0), PYc = CKB(1), MA = CKB(2), MB = CKB(3);
    LAS float* seg = (LAS float*)(base + 11 * MATB);
    const int j = F.tid & 63, sg = F.wave;
    for (int u = blockIdx.x; u < NUNIT; u += F.G) {
        const int c = u & (NCH - 1), bh = u >> 6, b = bh / MIXH, h = bh % MIXH, jc = h * 64 + j;
        const size_t mrow = (size_t)b * T + c * 64 + 8 * sg;
        const size_t g0 = mrow * MIXW + jc;
        unsigned char* o2 = s2in + (size_t)u * S2_BYTES; unsigned char* o3 = s3in + (size_t)u * S3_BYTES;
        float lw[8], kk[8], ai[8], k2[8], rr[8], vv[8];
        { const float mur = mu[jc], muk = mu[768 + jc], muv = mu[1536 + jc], kkc = vec[2 * MIXW + jc], kac = vec[3 * MIXW + jc], rkc = rkp[jc];
          unsigned short pr[9], pk_[9], pv_[9];
          const bool first = (c == 0 && sg == 0);
#pragma unroll
          for (int q = 0; q < 9; ++q) { const unsigned short* row = P + (mrow + q - 1) * NP; const bool ok = !(first && q == 0);
              pr[q] = ok ? row[jc] : (unsigned short)0; pk_[q] = ok ? row[768 + jc] : (unsigned short)0; pv_[q] = ok ? row[1536 + jc] : (unsigned short)0; }
#pragma unroll
          for (int q = 0; q < 8; ++q) { const size_t o = g0 + (size_t)q * MIXW; lw[q] = pLW[o]; ai[q] = pAI[o]; }
          float vgt[8], vft[8];
          if (l == 1) {
#pragma unroll
              for (int q = 0; q < 8; ++q) { const size_t o = g0 + (size_t)q * MIXW; vgt[q] = pVG[o]; vft[q] = VF[o]; } }
#pragma unroll
          for (int q = 0; q < 8; ++q) { const size_t o = g0 + (size_t)q * MIXW;
              float r = bf2f(pr[q + 1]), k = bf2f(pk_[q + 1]), v = bf2f(pv_[q + 1]);
              r += mur * (bf2f(pr[q]) - r); k += muk * (bf2f(pk_[q]) - k); v += muv * (bf2f(pv_[q]) - v);
              float kq = k * kkc; const float nrm = sqrtf(wsum64(kq * kq)); kq = kq / fmaxf(nrm, 1e-12f);
              const float k2q = k * (1.0f + (ai[q] - 1.0f) * kac);
              if (l == 0) VF[o] = v; else v = v + (vft[q] - v) * vgt[q];
              const float sr = wsum64(r * k2q * rkc);
              if (j == 0) SRK[(mrow + q) * MIXH + h] = sr;
              pV[o] = v;
              rr[q] = r; kk[q] = kq; k2[q] = k2q; vv[q] = v; } }
        float pl[8]; { float a = 0.f;
#pragma unroll
            for (int q = 0; q < 8; ++q) { a += lw[q]; pl[q] = a; } }
        seg[sg * 64 + j] = pl[7];
        CK_LBAR();
        float off = 0.f, LC = 0.f;
#pragma unroll
        for (int s = 0; s < 8; ++s) { const float x = seg[s * 64 + j]; LC += x; off += (s < sg) ? x : 0.f; }
        unsigned short at[8], rt[8], bhh[8], khh[8], vb[8], kb[8], bbv[8];
#pragma unroll
        for (int q = 0; q < 8; ++q) { const float L = off + pl[q], Lm1 = L - lw[q]; const float en = __expf(-L), ec = __expf(LC - L), kb_ = kk[q] * ai[q];
            at[q] = (unsigned short)(pk(-kk[q] * __expf(Lm1), 0.f) & 0xffffu); rt[q] = (unsigned short)(pk(rr[q] * __expf(L), 0.f) & 0xffffu);
            bhh[q] = (unsigned short)(pk(kb_ * en, 0.f) & 0xffffu); khh[q] = (unsigned short)(pk(k2[q] * en, 0.f) & 0xffffu);
            bbv[q] = (unsigned short)(pk(kb_ * ec, 0.f) & 0xffffu); kb[q] = (unsigned short)(pk(k2[q] * ec, 0.f) & 0xffffu); vb[q] = (unsigned short)(pk(vv[q], 0.f) & 0xffffu); }
#pragma unroll
        for (int q = 0; q < 8; ++q) { const int t = 8 * sg + q; At[t * LD + j] = at[q]; Rt[t * LD + j] = rt[q]; Bh[t * LD + j] = bhh[q]; Kh[t * LD + j] = khh[q]; }
        *(LAS u32x4*)(VC + j * LD + 8 * sg) = (u32x4){(unsigned)vb[0] | ((unsigned)vb[1] << 16), (unsigned)vb[2] | ((unsigned)vb[3] << 16), (unsigned)vb[4] | ((unsigned)vb[5] << 16), (unsigned)vb[6] | ((unsigned)vb[7] << 16)};
        *(LAS u32x4*)(KbC + j * LD + 8 * sg) = (u32x4){(unsigned)kb[0] | ((unsigned)kb[1] << 16), (unsigned)kb[2] | ((unsigned)kb[3] << 16), (unsigned)kb[4] | ((unsigned)kb[5] << 16), (unsigned)kb[6] | ((unsigned)kb[7] << 16)};
        if (!(var & 4)) {
            bf16* gb = (bf16*)(o2 + S2_BB) + j * 64 + 16 * (sg >> 1) + 4 * (sg & 1);
            *(GAS u32x2*)(gb) = (u32x2){(unsigned)bbv[0] | ((unsigned)bbv[1] << 16), (unsigned)bbv[2] | ((unsigned)bbv[3] << 16)};
            *(GAS u32x2*)(gb + 8) = (u32x2){(unsigned)bbv[4] | ((unsigned)bbv[5] << 16), (unsigned)bbv[6] | ((unsigned)bbv[7] << 16)}; }
        if (sg == 0) ((float*)(o2 + S2_GC))[j] = __expf(LC);
        CK_LBAR();
        if (var & 1) { CK_LBAR(); continue; }
        copy_out<true>(GP(o2 + S2_AT), At, F.tid);
        copy_out<false>(GP(o3 + S3_RT), Rt, F.tid);
        f32x4 mn[2];
        { f32x4 a[2] = {{0.f, 0.f, 0.f, 0.f}, {0.f, 0.f, 0.f, 0.f}}; mm(a, At, Bh, F.wave, F.lane); maskacc<1>(a, F.wave, F.lane); st_rm(PXr, a, F.wave, F.lane); st_cm(PXc, a, F.wave, F.lane); mn[0] = a[0]; mn[1] = a[1]; }
        { f32x4 a[2] = {{0.f, 0.f, 0.f, 0.f}, {0.f, 0.f, 0.f, 0.f}}; mm(a, At, Kh, F.wave, F.lane); maskacc<1>(a, F.wave, F.lane); st_rm(AkT, a, F.wave, F.lane); }
        { f32x4 a[2] = {{0.f, 0.f, 0.f, 0.f}, {0.f, 0.f, 0.f, 0.f}}; mm(a, Rt, Kh, F.wave, F.lane); maskacc<2>(a, F.wave, F.lane); st_rm(ArkT, a, F.wave, F.lane); }
        { f32x4 a[2] = {{0.f, 0.f, 0.f, 0.f}, {0.f, 0.f, 0.f, 0.f}}; mm(a, Rt, Bh, F.wave, F.lane); maskacc<2>(a, F.wave, F.lane); st_rm(ArbT, a, F.wave, F.lane); }
        CK_LBAR();
        copy_out<false>(GP(o3 + S3_ARB), ArbT, F.tid);
        { f32x4 a[2] = {{0.f, 0.f, 0.f, 0.f}, {0.f, 0.f, 0.f, 0.f}}; mm(a, AkT, VC, F.wave, F.lane); gst_cm(GP(o2 + S2_HK), a, F.wave, F.lane); }
        { f32x4 a[2] = {{0.f, 0.f, 0.f, 0.f}, {0.f, 0.f, 0.f, 0.f}}; mm(a, ArkT, VC, F.wave, F.lane); gst_cm(GP(o3 + S3_HY), a, F.wave, F.lane); }
        { f32x4 a[2] = {{0.f, 0.f, 0.f, 0.f}, {0.f, 0.f, 0.f, 0.f}}; mm(a, KbC, VC, F.wave, F.lane); gst_cm(GP(o2 + S2_HQ), a, F.wave, F.lane); }
        lmat Pr_old = PXr, Pc_old = PXc, Pr_new = PYr, Pc_new = PYc, M_old = PXr, M_new = MA;
        if (!(var & 2))
#pragma unroll
        for (int it = 1; it <= 5; ++it) {
            f32x4 p[2] = {{0.f, 0.f, 0.f, 0.f}, {0.f, 0.f, 0.f, 0.f}}; mm(p, Pr_old, Pc_old, F.wave, F.lane);
            st_rm(Pr_new, p, F.wave, F.lane); st_cm(Pc_new, p, F.wave, F.lane);
            CK_LBAR();
            f32x4 a[2] = {mn[0] + p[0], mn[1] + p[1]}; mm(a, M_old, Pc_new, F.wave, F.lane); mn[0] = a[0]; mn[1] = a[1];
            st_rm(M_new, a, F.wave, F.lane);
            CK_LBAR();
            { lmat t1 = Pr_old; Pr_old = Pr_new; Pr_new = t1; t1 = Pc_old; Pc_old = Pc_new; Pc_new = t1; }
            M_old = M_new; M_new = (M_new == MA) ? MB : MA;
        }
        copy_out<true>(GP(o2 + S2_MN), M_old, F.tid);
        CK_LBAR();
    }
#undef CKB
#undef GP
}

__device__ __forceinline__ bf16x8 pack8(const f32x16& x, int s) { const u32x4 w = (u32x4){pk(x[8 * s], x[8 * s + 1]), pk(x[8 * s + 2], x[8 * s + 3]), pk(x[8 * s + 4], x[8 * s + 5]), pk(x[8 * s + 6], x[8 * s + 7])}; return __builtin_bit_cast(bf16x8, w); }
__device__ __forceinline__ void ph_s2(Frame& F, int var) {
    ENTER(F);
    const unsigned char* s2in = F.ws + WS_SCR + SC_S2IN; unsigned char* su = F.ws + WS_SCR + SC_SU;
    LAS unsigned char* base = F.lds + RING_OFF;
    constexpr int BUFB = 5 * MATB + 256;
    const int r32 = F.lane & 31, hi = F.lane >> 5;
    for (int bh = blockIdx.x; bh < NB * MIXH; bh += F.G) {
        f32x16 st[2]; st[0] = f32x16{}; st[1] = f32x16{};
        const int lt = F.tid - 128;
        u32x4 stg[7];
#define S2_IDX(k_) ((lt + 384 * (k_)) < 5 * 512 + 15 ? (lt + 384 * (k_)) : 5 * 512 + 15)
#define S2_LOAD(cc) do { const unsigned char* g_ = s2in + (size_t)(bh * NCH + (cc)) * S2_BYTES; _Pragma("unroll") for (int k_ = 0; k_ < 7; ++k_) stg[k_] = *(const GAS u32x4*)(g_ + (size_t)S2_IDX(k_) * 16); } while (0)
#define S2_WRITE(cc) do { LAS unsigned char* d_ = base + ((cc) & 1) * BUFB; _Pragma("unroll") for (int k_ = 0; k_ < 7; ++k_) { const int idx_ = S2_IDX(k_); const int mtx_ = idx_ >> 9, rem_ = idx_ & 511; \
            const int off_ = idx_ < 5 * 512 ? mtx_ * MATB + (rem_ >> 3) * (LD * 2) + (rem_ & 7) * 16 : 5 * MATB + (idx_ - 5 * 512) * 16; *(LAS u32x4*)(d_ + off_) = stg[k_]; } } while (0)
        if (F.wave >= 2) S2_LOAD(0);
        for (int c = -1; c <= NCH; ++c) {
            if (F.wave >= 2) { if (c + 1 < NCH) S2_WRITE(c + 1); if (c + 2 < NCH) S2_LOAD(c + 2);
                if (c >= 1 && !(var & 1)) {
                    const LAS unsigned char* ob = base + 2 * BUFB + ((c - 1) & 1) * 2 * MATB; unsigned char* so = su + (size_t)(bh * NCH + c - 1) * SU_BYTES;
#pragma unroll
                    for (int k = 0; k < 3; ++k) { const int idx = (lt + 384 * k) < 1023 ? (lt + 384 * k) : 1023; const int mtx = idx >> 9, rem = idx & 511;
                        *(GAS u32x4*)(so + (size_t)idx * 16) = *(const LAS u32x4*)(ob + mtx * MATB + (rem >> 3) * (LD * 2) + (rem & 7) * 16); } } }
            if (F.wave < 2 && c >= 0 && c < NCH && !(var & 2)) {
                const LAS unsigned char* d = base + (c & 1) * BUFB; const int ih = F.wave; const int icol = 32 * ih + r32;
                const lmat AtP = (lmat)d, MnP = (lmat)(d + MATB), BbP = (lmat)(d + 2 * MATB), HkT = (lmat)(d + 3 * MATB), HqT = (lmat)(d + 4 * MATB); const LAS float* gC = (const LAS float*)(d + 5 * MATB);
                LAS unsigned char* ob = base + 2 * BUFB + (c & 1) * 2 * MATB;
#pragma unroll
                for (int jt = 0; jt < 2; ++jt)
#pragma unroll
                    for (int g4 = 0; g4 < 4; ++g4) *(LAS u32x2*)((lmat)ob + icol * LD + 32 * jt + 8 * g4 + 4 * hi) = (u32x2){pk(st[jt][4 * g4], st[jt][4 * g4 + 1]), pk(st[jt][4 * g4 + 2], st[jt][4 * g4 + 3])};
                bf16x8 bs[4];
#pragma unroll
                for (int ks = 0; ks < 4; ++ks) bs[ks] = pack8(st[ks >> 1], ks & 1);
                f32x16 rh[2];
#pragma unroll
                for (int mt = 0; mt < 2; ++mt)
#pragma unroll
                    for (int g4 = 0; g4 < 4; ++g4) { const u32x2 w = *(const LAS u32x2*)(HkT + icol * LD + 32 * mt + 8 * g4 + 4 * hi); rh[mt][4 * g4] = bflo(w.x); rh[mt][4 * g4 + 1] = bfhi(w.x); rh[mt][4 * g4 + 2] = bflo(w.y); rh[mt][4 * g4 + 3] = bfhi(w.y); }
                bf16x8 af[8];
#define S2_AF(Mat) do { _Pragma("unroll") for (int q_ = 0; q_ < 8; ++q_) af[q_] = *(const LAS bf16x8*)((Mat) + (32 * (q_ >> 2) + r32) * LD + 16 * (q_ & 3) + 8 * hi); __builtin_amdgcn_sched_barrier(0); } while (0)
                S2_AF(AtP);
#pragma unroll
                for (int mt = 0; mt < 2; ++mt)
#pragma unroll
                    for (int ks = 0; ks < 4; ++ks) rh[mt] = __builtin_amdgcn_mfma_f32_32x32x16_bf16(af[4 * mt + ks], bs[ks], rh[mt], 0, 0, 0);
                bf16x8 br[4];
#pragma unroll
                for (int ks = 0; ks < 4; ++ks) br[ks] = pack8(rh[ks >> 1], ks & 1);
                f32x16 uu[2]; uu[0] = rh[0]; uu[1] = rh[1];
                S2_AF(MnP);
#pragma unroll
                for (int mt = 0; mt < 2; ++mt)
#pragma unroll
                    for (int ks = 0; ks < 4; ++ks) uu[mt] = __builtin_amdgcn_mfma_f32_32x32x16_bf16(af[4 * mt + ks], br[ks], uu[mt], 0, 0, 0);
#pragma unroll
                for (int mt = 0; mt < 2; ++mt)
#pragma unroll
                    for (int g4 = 0; g4 < 4; ++g4) *(LAS u32x2*)((lmat)(ob + MATB) + icol * LD + 32 * mt + 8 * g4 + 4 * hi) = (u32x2){pk(uu[mt][4 * g4], uu[mt][4 * g4 + 1]), pk(uu[mt][4 * g4 + 2], uu[mt][4 * g4 + 3])};
                bf16x8 bu[4];
#pragma unroll
                for (int ks = 0; ks < 4; ++ks) bu[ks] = pack8(uu[ks >> 1], ks & 1);
#pragma unroll
                for (int jt = 0; jt < 2; ++jt)
#pragma unroll
                    for (int g4 = 0; g4 < 4; ++g4) { const u32x2 w = *(const LAS u32x2*)(HqT + icol * LD + 32 * jt + 8 * g4 + 4 * hi); const f32x4 gc = *(const LAS f32x4*)(gC + 32 * jt + 8 * g4 + 4 * hi);
                        st[jt][4 * g4] = st[jt][4 * g4] * gc.x + bflo(w.x); st[jt][4 * g4 + 1] = st[jt][4 * g4 + 1] * gc.y + bfhi(w.x); st[jt][4 * g4 + 2] = st[jt][4 * g4 + 2] * gc.z + bflo(w.y); st[jt][4 * g4 + 3] = st[jt][4 * g4 + 3] * gc.w + bfhi(w.y); }
                S2_AF(BbP);
#pragma unroll
                for (int jt = 0; jt < 2; ++jt)
#pragma unroll
                    for (int ks = 0; ks < 4; ++ks) st[jt] = __builtin_amdgcn_mfma_f32_32x32x16_bf16(af[4 * jt + ks], bu[ks], st[jt], 0, 0, 0);
#undef S2_AF
            }
            CK_LBAR();
        }
#undef S2_LOAD
#undef S2_WRITE
#undef S2_IDX
    }
}
__device__ __forceinline__ void ph_s3(Frame& F, int l) {
    ENTER(F);
    const unsigned char* s3in = F.ws + WS_SCR + SC_S3IN; const unsigned char* su = F.ws + WS_SCR + SC_SU;
    const float* vec = inp(6) + (size_t)l * 6 * MIXW; const float* lg = vec + 4 * MIXW; const float* lb = vec + 5 * MIXW;
    const float* V = (const float*)(F.ws + WS_SCR + SC_V); const float* Gt = (const float*)(F.ws + WS_SCR + SC_G); const float* SRK = (const float*)(F.ws + WS_SCR + SC_SRK);
    unsigned short* MIX = (unsigned short*)(F.ws + WS_MIX);
    LAS unsigned char* base = F.lds + RING_OFF;
    lmat Rt = (lmat)base, S0 = (lmat)(base + MATB), Arb = (lmat)(base + 2 * MATB), Ub = (lmat)(base + 3 * MATB), HyT = (lmat)(base + 4 * MATB);
    LAS float* Yb = (LAS float*)(base + 5 * MATB);
    for (int u = blockIdx.x; u < NUNIT; u += F.G) {
        const int c = u & (NCH - 1), bh = u >> 6, b = bh / MIXH, h = bh % MIXH;
        const unsigned char* g3 = s3in + (size_t)u * S3_BYTES; const unsigned char* gu = su + (size_t)u * SU_BYTES;
        copy_in(Rt, (const bf16*)(g3 + S3_RT), F.tid); copy_in(Arb, (const bf16*)(g3 + S3_ARB), F.tid); copy_in(HyT, (const bf16*)(g3 + S3_HY), F.tid);
        copy_in(S0, (const bf16*)(gu + SU_S0), F.tid); copy_in(Ub, (const bf16*)(gu + SU_U), F.tid);
        const int tt = F.tid >> 3, i0 = 8 * (F.tid & 7); const size_t m = (size_t)b * T + c * 64 + tt; const int cc = h * 64 + i0;
        const f32x4 v0 = *(const GAS f32x4*)(V + m * MIXW + cc), v1 = *(const GAS f32x4*)(V + m * MIXW + cc + 4), g0 = *(const GAS f32x4*)(Gt + m * MIXW + cc), g1 = *(const GAS f32x4*)(Gt + m * MIXW + cc + 4);
        const float srk = SRK[m * MIXH + h];
        CK_LBAR();
        f32x4 a[2];
#pragma unroll
        for (int q = 0; q < 2; ++q) { const int n = 16 * (2 * (F.wave & 1) + q) + (F.lane & 15), m0 = 16 * (F.wave >> 1) + 4 * (F.lane >> 4); const u32x2 w = *(const LAS u32x2*)(HyT + n * LD + m0); a[q] = (f32x4){bflo(w.x), bfhi(w.x), bflo(w.y), bfhi(w.y)}; }
        mm(a, Rt, S0, F.wave, F.lane); mm(a, Arb, Ub, F.wave, F.lane);
#pragma unroll
        for (int q = 0; q < 2; ++q) { const int n = 16 * (2 * (F.wave & 1) + q) + (F.lane & 15), m0 = 16 * (F.wave >> 1) + 4 * (F.lane >> 4);
#pragma unroll
            for (int r = 0; r < 4; ++r) Yb[(m0 + r) * 68 + n] = a[q][r]; }
        CK_LBAR();
        const f32x4 y0 = *(const LAS f32x4*)(Yb + tt * 68 + i0), y1 = *(const LAS f32x4*)(Yb + tt * 68 + i0 + 4);
        float s = (y0.x + y0.y) + (y0.z + y0.w) + (y1.x + y1.y) + (y1.z + y1.w);
        s += dpp<0xB1>(s); s += dpp<0x4E>(s); s += dpp<0x141>(s);
        const float mean = s * (1.0f / 64.0f);
        const f32x4 d0 = y0 - mean, d1 = y1 - mean;
        float qv = (d0.x * d0.x + d0.y * d0.y) + (d0.z * d0.z + d0.w * d0.w) + (d1.x * d1.x + d1.y * d1.y) + (d1.z * d1.z + d1.w * d1.w);
        qv += dpp<0xB1>(qv); qv += dpp<0x4E>(qv); qv += dpp<0x141>(qv);
        const float rstd = 1.0f / sqrtf(qv * (1.0f / 64.0f) + GN_EPS);
        const f32x4 lg0 = *(const f32x4*)(lg + cc), lg1 = *(const f32x4*)(lg + cc + 4), lb0 = *(const f32x4*)(lb + cc), lb1 = *(const f32x4*)(lb + cc + 4);
        const f32x4 o0 = (d0 * rstd * lg0 + lb0 + v0 * srk) * g0, o1 = (d1 * rstd * lg1 + lb1 + v1 * srk) * g1;
        *(GAS u32x4*)(MIX + m * DM + cc) = (u32x4){pk(o0.x, o0.y), pk(o0.z, o0.w), pk(o1.x, o1.y), pk(o1.z, o1.w)};
        CK_LBAR();
    }
}
}
constexpr int PPL = 14, NPHASE = 1 + PPL * DEPTH;
__host__ __device__ inline bool phase_exists(int ph) {
    if (ph == 0) return true;
    const int l = (ph - 1) / PPL, k = (ph - 1) % PPL; const bool isA = l < 2, moe = l & 1;
    if (k == 3 || k == 7) return false;
    if (k >= 2 && k <= 6) return isA;
    if (k == 10) return moe;
    return true;
}
struct Args { const float* in[23]; float* out; unsigned char* ws; int ph_lo, ph_hi, var, pad; };
struct Order {
    int nM, nN, G, c; const int* tile_e;
    __device__ __forceinline__ bool next(int i, pg8::Unit& u) const { if (!pg8::order_map((long)i * G + c, nM, nN, u.pm, u.pn)) return false;
        int e = 0; if (tile_e) e = __builtin_amdgcn_readfirstlane(ld_relaxed(tile_e + u.pm)); u.bt = e * nN + u.pn; return true; }
};
__global__ void __launch_bounds__(NWAVES * 64, 2) fwd(Args args) {
    extern __shared__ __attribute__((aligned(16))) unsigned char lds[];
    Frame F;
    F.lds = (LAS unsigned char*)lds;
    volatile LAS unsigned* MISC = (volatile LAS unsigned*)(F.lds + MISC_OFF);
    ENTER(F);
    F.G = gridDim.x; { const int bx = blockIdx.x; F.vcu = (F.G % 8 == 0) ? (bx % 8) * (F.G / 8) + bx / 8 : bx; }
    for (int u = F.tid; u < (LDS_BYTES - LDSCTL_OFF) / 4; u += NWAVES * 64) ((LAS unsigned*)(F.lds + LDSCTL_OFF))[u] = 0u;
    __syncthreads();
    const int lo = args.ph_lo, hi = args.ph_hi;
    XcdBarrier bar; bar.bar = (unsigned*)(F.ws + WS_CTL) + CW_BAR; bar.x = 0; bar.st = MISC + 8;
    if (hi - lo > 1) bar = xcd_barrier_post((unsigned*)(F.ws + WS_CTL) + CW_BAR, MISC + 8);
#define IN(k) (lo <= (k) && (k) < hi)
#define SEAM(k) do { if ((k) + 1 < hi) xcd_barrier(bar); } while (0)

    if (IN(0)) { p0_prologue(F); SEAM(0); }

    for (int l = 0; l < DEPTH; ++l) {
        const int pb = 1 + PPL * l; const bool isA = l < 2, moe = (l & 1) != 0;
        const int NP = l == 0 ? NP0 : l == 1 ? NP1 : DM;
        const int QM_OFF = l == 0 ? NC0 : l == 1 ? NP0 : MIXW;
        if (IN(pb)) {
            for (int gi = 0; gi < 2; ++gi) {
                if (gi == 1 && !(l == 0 || l == 2)) break;
                ENTER(F); unsigned char* ws = F.ws;
                pg8::Gemm g; pg8::EpiStore E; Order S; S.G = F.G; S.c = (int)blockIdx.x; S.tile_e = nullptr;
                if (gi == 0) { const size_t wo = l == 0 ? WS_WIN0 : l == 1 ? WS_WIN1 : l == 2 ? WS_WIN2 : WS_WIN3;
                    g = pg8::Gemm{(const bf16*)(ws + WS_XB), (const bf16*)(ws + wo), DM, DM, DM}; S.nM = M / 256; S.nN = NP / 256;
                    E = pg8::EpiStore{(bf16*)(ws + WS_SCR + SC_P), NP, l == 0 ? (1u << 10) : l == 1 ? (1u << 11) : 0xFu, C2}; }
                else if (l == 0) { g = pg8::Gemm{(const bf16*)(ws + WS_MEMB), (const bf16*)(ws + WS_WMKV), DM, DM, DM}; S.nM = 4; S.nN = 8; E = pg8::EpiStore{(bf16*)(ws + WS_MKV), 2048, 0u, 1.f}; }
                else { g = pg8::Gemm{(const bf16*)(ws + WS_XB), (const bf16*)(ws + WS_WKV), DM, DM, DM}; S.nM = M / 256; S.nN = 6; E = pg8::EpiStore{(bf16*)(ws + WS_KV), 1536, 0u, 1.f}; }
                pg8::gemm_phase<pg8::EpiStore, Order>(F.lds + RING_OFF, g, S, E);
            }
            SEAM(pb);
        }
        if (IN(pb + 1)) {
            if (isA) ph_lora_in(F, l);
            else {
                ENTER(F); unsigned char* ws = F.ws;
                unsigned* ctr = (unsigned*)(ws + WS_CTL) + 64 * (8 + l);
                const bf16* KV = (const bf16*)(ws + WS_KV); const bf16* Pb = (const bf16*)(ws + WS_SCR + SC_P); bf16* MIX = (bf16*)(ws + WS_MIX);
                for (;;) {
                    if (F.tid == 0) MISC[16] = atomicAdd(ctr, 1u);
                    __syncthreads(); const int u = (int)MISC[16]; __syncthreads();
                    if (u >= NB * MIXH * 16) break;
                    const int qb = 15 - u / (NB * MIXH), bh = u % (NB * MIXH), b = bh / MIXH, h = bh % MIXH;
                    att::sb_unit(qb, Pb + (size_t)b * T * DM + h * 64, DM, KV + (size_t)b * T * 1536 + h * 64, KV + (size_t)b * T * 1536 + MIXW + h * 64, 1536, MIX + (size_t)b * T * DM + h * 64, DM, (att::lds_ptr)(F.lds + RING_OFF), args.var);
                }
            }
            { ENTER(F); unsigned char* ws = F.ws; const bf16* Pb = (const bf16*)(ws + WS_SCR + SC_P); bf16* MIX = (bf16*)(ws + WS_MIX);
              for (int u = blockIdx.x; u < NB * MEMH * 16; u += F.G) { const int b = u >> 6, hm = (u >> 4) & 3, blk = u & 15;
                const bf16* MKV = (const bf16*)(ws + WS_MKV) + (size_t)b * MEMT * 2048 + l * 512 + hm * 64; const size_t row0 = (size_t)b * T + blk * 256;
                att::mem_unit(Pb + row0 * NP + QM_OFF + hm * 64, NP, MKV, MKV + 256, 2048, MIX + row0 * DM + MIXW + hm * 64, DM, (att::lds_ptr)(F.lds + RING_OFF)); } }
            SEAM(pb + 1);
        }
        if (isA) {
            if (IN(pb + 2)) {
                ENTER(F); unsigned char* ws = F.ws;
                pg8::Gemm g{(const bf16*)(ws + WS_SCR + SC_U), (const bf16*)(ws + WS_WLORA + l * SZ_WLORA), 512, 512, 512};
                Order S; S.G = F.G; S.c = (int)blockIdx.x; S.tile_e = nullptr; S.nM = M / 256; S.nN = 12;
                const float* vec = inp(6) + (size_t)l * 6 * MIXW;
                pg8::EpiLora E{(float*)(ws + WS_SCR + SC_WDEC), (SC_AI - SC_WDEC) / 4, ((size_t)WS_SCR + SC_VG - (WS_SCR + SC_WDEC)) / 4, (SC_G - SC_WDEC) / 4, vec, l == 1 ? inp(10) : nullptr};
                pg8::gemm_phase<pg8::EpiLora, Order>(F.lds + RING_OFF, g, S, E);
                SEAM(pb + 2);
            }
            if (IN(pb + 4)) { ck::ph_s1(F, l, args.var); SEAM(pb + 4); }
            if (IN(pb + 5)) { ck::ph_s2(F, args.var); SEAM(pb + 5); }
            if (IN(pb + 6)) { ck::ph_s3(F, l); SEAM(pb + 6); }
        }
        if (IN(pb + 8)) {
            ENTER(F); unsigned char* ws = F.ws;
            pg8::Gemm g{(const bf16*)(ws + WS_MIX), (const bf16*)(ws + WS_WO + l * SZ_WO), DM, DM, DM};
            Order S; S.G = F.G; S.c = (int)blockIdx.x; S.tile_e = nullptr; S.nM = M / 256; S.nN = 4;
            pg8::EpiResid E{l == 0 ? inp(0) : (const float*)(ws + WS_XF0), (float*)(ws + WS_PRE), DM, ALPHA};
            pg8::gemm_phase<pg8::EpiResid, Order>(F.lds + RING_OFF, g, S, E);
            SEAM(pb + 8);
        }
        if (IN(pb + 9)) { const float* ln = inp(17) + (size_t)l * 4 * DM; ph_ln(F, 0, ln, ln + DM, WS_XF1, WS_XB1, 0, moe ? 1 : 0, inp(20) + (size_t)(l >> 1) * DM * NE); SEAM(pb + 9); }
        if (moe && IN(pb + 10)) { ph_route2(F); SEAM(pb + 10); }
        if (IN(pb + 11)) {
            ENTER(F); unsigned char* ws = F.ws; const int* TILE = (const int*)(ws + WS_ROUTE + RO_TILE);
            pg8::Gemm g; Order S; S.G = F.G; S.c = (int)blockIdx.x; S.nN = 22;
            if (moe) { g = pg8::Gemm{(const bf16*)(ws + WS_SCR + SC_XG), (const bf16*)(ws + WS_WEGU + (size_t)(l >> 1) * 8 * SZ_WGU), DM, DM, DM}; S.tile_e = TILE; S.nM = __builtin_amdgcn_readfirstlane(ld_relaxed(TILE + 255)); }
            else { g = pg8::Gemm{(const bf16*)(ws + WS_XB1), (const bf16*)(ws + WS_WGU + (size_t)(l >> 1) * SZ_WGU), DM, DM, DM}; S.tile_e = nullptr; S.nM = M / 256; }
            pg8::EpiSwiglu E{(bf16*)(ws + WS_SCR + SC_H), FF};
            pg8::gemm_phase<pg8::EpiSwiglu, Order>(F.lds + RING_OFF, g, S, E);
            SEAM(pb + 11);
        }
        if (IN(pb + 12)) {
            ENTER(F); unsigned char* ws = F.ws; const int* TILE = (const int*)(ws + WS_ROUTE + RO_TILE);
            pg8::Gemm g; Order S; S.G = F.G; S.c = (int)blockIdx.x; S.nN = 4; pg8::EpiResid E;
            if (moe) { g = pg8::Gemm{(const bf16*)(ws + WS_SCR + SC_H), (const bf16*)(ws + WS_WEDN + (size_t)(l >> 1) * 8 * SZ_WDN), FF, FF, FF}; S.tile_e = TILE; S.nM = __builtin_amdgcn_readfirstlane(ld_relaxed(TILE + 255));
                E = pg8::EpiResid{nullptr, (float*)(ws + WS_SCR + SC_YE), DM, 0.f}; }
            else { g = pg8::Gemm{(const bf16*)(ws + WS_SCR + SC_H), (const bf16*)(ws + WS_WDN + (size_t)(l >> 1) * SZ_WDN), FF, FF, FF}; S.tile_e = nullptr; S.nM = M / 256; E = pg8::EpiResid{(const float*)(ws + WS_XF1), (float*)(ws + WS_PRE), DM, ALPHA}; }
            pg8::gemm_phase<pg8::EpiResid, Order>(F.lds + RING_OFF, g, S, E);
            SEAM(pb + 12);
        }
        if (IN(pb + 13)) { const float* ln = inp(17) + (size_t)l * 4 * DM; ph_ln(F, moe ? 1 : 0, ln + 2 * DM, ln + 3 * DM, WS_XF0, WS_XB, l == DEPTH - 1 ? 1 : 0, 0, nullptr); SEAM(pb + 13); }
    }
#undef IN
#undef SEAM
}

#ifndef PROBE_VAR
#define PROBE_VAR 0
#endif
#ifndef PROBE_LIST
#define PROBE_LIST -1
#endif
static const int PROBE_PHS[] = {PROBE_LIST};
#ifndef MK_ONE_LAUNCH
#define MK_ONE_LAUNCH 1
#endif
extern "C" void kernel_launch(void* const* d_in, const int* in_sizes, int n_in, void* d_out, int out_size, void* d_ws, size_t ws_size, hipStream_t stream) {
    static int grid = 0;
    if (grid == 0) {
        if (n_in != 23 || in_sizes[0] != M * DM || out_size != M * DM || ws_size < WS_END) { fprintf(stderr, "kernel_launch: shape/workspace mismatch (n_in %d, ws %zu, need %zu)\n", n_in, ws_size, (size_t)WS_END); grid = -1; return; }
        int dev = 0, cus = 0, per_cu = 0;
        if (hipGetDevice(&dev) != hipSuccess || hipDeviceGetAttribute(&cus, hipDeviceAttributeMultiprocessorCount, dev) != hipSuccess) { grid = -1; return; }
        if (hipFuncSetAttribute((const void*)fwd, hipFuncAttributeMaxDynamicSharedMemorySize, LDS_BYTES) != hipSuccess) { fprintf(stderr, "kernel_launch: hipFuncSetAttribute failed\n"); grid = -1; return; }
        if (hipOccupancyMaxActiveBlocksPerMultiprocessor(&per_cu, (const void*)fwd, NWAVES * 64, LDS_BYTES) != hipSuccess || per_cu < 1) fprintf(stderr, "kernel_launch: occupancy query reports %d\n", per_cu);
        (void)hipGetLastError();
        grid = cus;
    }
    if (grid < 0) return;
    if (hipMemsetAsync((char*)d_ws + WS_CTL, 0, CTL_ZERO_BYTES, stream) != hipSuccess) return;
    Args a{};
    for (int i = 0; i < 23; ++i) a.in[i] = (const float*)d_in[i];
    a.out = (float*)d_out; a.ws = (unsigned char*)d_ws;
    if (MK_ONE_LAUNCH) { a.ph_lo = 0; a.ph_hi = NPHASE; hipLaunchKernelGGL(fwd, dim3(grid), dim3(NWAVES * 64), LDS_BYTES, stream, a); }
    else for (int ph = 0; ph < NPHASE; ++ph) { if (!phase_exists(ph)) continue; a.ph_lo = ph; a.ph_hi = ph + 1;
        int reps = 1; for (int q : PROBE_PHS) if (q == ph) reps = 2;
        for (int r = 0; r < reps; ++r) { if (r) (void)hipMemsetAsync((char*)d_ws + WS_CTL, 0, CTL_ZERO_BYTES, stream); a.var = (reps == 2 && r == 0) ? PROBE_VAR : 0; hipLaunchKernelGGL(fwd, dim3(grid), dim3(NWAVES * 64), LDS_BYTES, stream, a); } }
}
```
